# Optimizing an MI355X kernel written in HIP

```python
import jax, jax.numpy as jnp
from jax import lax
import numpy as np

D_MODEL = 1024
BATCH = 16
SEQ = 4096
DEPTH = 1

GRID_W = 64
WIN_H_MAX = 8
WIN_W = 16
ATTN_HEADS = 8
ATTN_HEAD_DIM = 64
ATTN_WIDTH = ATTN_HEADS * ATTN_HEAD_DIM
DN_HEADS = 4
DN_HEAD_DIM = 128
DN_WIDTH = DN_HEADS * DN_HEAD_DIM
DN_CONV = 5
DN_CHUNK = 64
D_MIX = ATTN_WIDTH + DN_WIDTH
IN_COLS = 3 * ATTN_WIDTH + 4 * DN_WIDTH + 4 * DN_HEADS
N_GROUPS = 8
EXPERTS_PER_GROUP = 8
N_EXPERTS = N_GROUPS * EXPERTS_PER_GROUP
TOP_K_IN_GROUP = 2
D_EXPERT = D_MODEL // 4
MOE_BLOCK = 256
EPS = 1e-6

kernel_name = 'hybrid_na_gdn_hmoe_block'


def rms_norm(x, g):
    xf = x.astype(jnp.float32)
    y = xf * lax.rsqrt(jnp.mean(xf * xf, axis=-1, keepdims=True) + EPS)
    return (y * g.astype(jnp.float32)).astype(x.dtype)


def l2_norm(x):
    xf = x.astype(jnp.float32)
    return xf * lax.rsqrt(jnp.sum(xf * xf, axis=-1, keepdims=True) + EPS)


def neighbourhood_attention(q, k, v, rpb):
    b_, s_, h_, dh = q.shape
    rows = s_ // GRID_W
    kh = min(WIN_H_MAX, rows)
    to_grid = lambda t: t.reshape(b_, rows, GRID_W, h_, dh).transpose(1, 0, 3, 2, 4)
    qg, kg, vg = to_grid(q), to_grid(k), to_grid(v)
    cols = jnp.arange(GRID_W)
    col_start = jnp.clip(cols - WIN_W // 2, 0, GRID_W - WIN_W)
    col_idx = col_start[:, None] + jnp.arange(WIN_W)[None, :]
    col_off = col_idx - cols[:, None] + (WIN_W - 1)
    scale = dh ** -0.5

    def row_block(args):
        r, q_row = args
        r0 = jnp.clip(r - kh // 2, 0, rows - kh)
        k_band = lax.dynamic_slice_in_dim(kg, r0, kh, axis=0)
        v_band = lax.dynamic_slice_in_dim(vg, r0, kh, axis=0)
        k_win = k_band[:, :, :, col_idx]
        v_win = v_band[:, :, :, col_idx]
        row_off = r0 + jnp.arange(kh) - r + (WIN_H_MAX - 1)
        bias = rpb[:, row_off[None, :, None], col_off[:, None, :]]
        logits = jnp.einsum('bhqd,rbhqcd->bhqrc', q_row, k_win).astype(jnp.float32) * scale
        logits = logits + bias.astype(jnp.float32)[None]
        p = jax.nn.softmax(logits.reshape(b_, h_, GRID_W, kh * WIN_W), axis=-1)
        p = p.reshape(b_, h_, GRID_W, kh, WIN_W).astype(v.dtype)
        return jnp.einsum('bhqrc,rbhqce->bqhe', p, v_win)

    out = lax.map(row_block, (jnp.arange(rows), qg))
    return out.transpose(1, 0, 2, 3, 4).reshape(b_, s_, h_ * dh)


def gated_delta_rule(q, k, v, g, beta):
    f32 = jnp.float32
    bn, hn, t_, dk = q.shape
    dv = v.shape[-1]
    c = DN_CHUNK
    nc = t_ // c
    q = q.astype(f32).reshape(bn, hn, nc, c, dk)
    k = k.astype(f32).reshape(bn, hn, nc, c, dk)
    v = v.astype(f32).reshape(bn, hn, nc, c, dv)
    beta = beta.astype(f32).reshape(bn, hn, nc, c)
    gc = jnp.cumsum(g.astype(f32).reshape(bn, hn, nc, c), axis=-1)
    incl = jnp.tril(jnp.ones((c, c), bool))
    strict = jnp.tril(jnp.ones((c, c), bool), -1)
    diff = gc[..., :, None] - gc[..., None, :]
    decay = jnp.where(incl, jnp.exp(jnp.where(incl, diff, 0.0)), 0.0)
    kb = k * beta[..., None]
    lower = jnp.where(strict, jnp.einsum('bhnid,bhnjd->bhnij', kb, k) * decay, 0.0)
    a_mat = jnp.eye(c, dtype=f32) + lower
    rhs = jnp.concatenate([v * beta[..., None], kb * jnp.exp(gc)[..., None]], axis=-1)
    sol = lax.linalg.triangular_solve(a_mat, rhs, left_side=True, lower=True, unit_diagonal=True)
    u, w = sol[..., :dv], sol[..., dv:]
    qk = jnp.einsum('bhnid,bhnjd->bhnij', q, k) * decay

    def step(state, inp):
        q_c, k_c, u_c, w_c, g_c, qk_c = inp
        v_new = u_c - jnp.einsum('bhck,bhkv->bhcv', w_c, state)
        o_c = (jnp.einsum('bhck,bhkv->bhcv', q_c * jnp.exp(g_c)[..., None], state)
               + jnp.einsum('bhij,bhjv->bhiv', qk_c, v_new))
        g_last = g_c[..., -1:]
        state = (state * jnp.exp(g_last)[..., None]
                 + jnp.einsum('bhck,bhcv->bhkv', k_c * jnp.exp(g_last - g_c)[..., None], v_new))
        return state, o_c

    xs = tuple(jnp.moveaxis(t, 2, 0) for t in (q, k, u, w, gc, qk))
    state0 = jnp.zeros((bn, hn, dk, dv), f32)
    _, o = lax.scan(step, state0, xs)
    return jnp.moveaxis(o, 0, 2).reshape(bn, hn, t_, dv)


def bidirectional_gated_deltanet(qkv_raw, z, a, b, conv_w, a_log, dt_bias, out_norm_g):
    b_, s_, _ = qkv_raw.shape
    qkv = lax.conv_general_dilated(qkv_raw, conv_w[:, None, :].astype(qkv_raw.dtype),
                                   window_strides=(1,), padding=[(DN_CONV // 2, DN_CONV // 2)],
                                   dimension_numbers=('NWC', 'WIO', 'NWC'),
                                   feature_group_count=3 * DN_WIDTH)
    qkv = jax.nn.silu(qkv)
    q, k, v = jnp.split(qkv.reshape(b_, s_, 3, DN_HEADS, DN_HEAD_DIM), 3, axis=2)
    q = l2_norm(q[:, :, 0]) * (DN_HEAD_DIM ** -0.5)
    k = l2_norm(k[:, :, 0])
    v = v[:, :, 0].astype(jnp.float32)
    g = -jnp.exp(a_log.astype(jnp.float32)) * jax.nn.softplus(a.astype(jnp.float32) + dt_bias.astype(jnp.float32))
    beta = jax.nn.sigmoid(b.astype(jnp.float32))
    bht = lambda t: t.transpose(0, 2, 1, 3)
    both = lambda t: jnp.concatenate([t, jnp.flip(t, axis=2)], axis=1)
    q2, k2, v2 = both(bht(q)), both(bht(k)), both(bht(v))
    g2 = jnp.concatenate([g[:, :, 0].transpose(0, 2, 1), jnp.flip(g[:, :, 1].transpose(0, 2, 1), axis=-1)], axis=1)
    beta2 = jnp.concatenate([beta[:, :, 0].transpose(0, 2, 1), jnp.flip(beta[:, :, 1].transpose(0, 2, 1), axis=-1)], axis=1)
    o2 = gated_delta_rule(q2, k2, v2, g2, beta2)
    o = o2[:, :DN_HEADS] + jnp.flip(o2[:, DN_HEADS:], axis=2)
    o = o.transpose(0, 2, 1, 3)
    zf = z.reshape(b_, s_, DN_HEADS, DN_HEAD_DIM).astype(jnp.float32)
    o = rms_norm(o, out_norm_g) * jax.nn.silu(zf)
    return o.reshape(b_, s_, DN_WIDTH).astype(qkv_raw.dtype)


def hierarchical_moe(h, wg_r, bg_r, we_r, be_r, w_gate, w_up, w_down):
    b_, s_, d_ = h.shape
    n = b_ * s_
    hf = h.reshape(n, d_)
    group_logits = (hf @ wg_r + bg_r).astype(jnp.float32)
    group_prob = jax.nn.softmax(group_logits, axis=-1)
    gsel = jnp.argmax(group_logits, axis=-1)
    gp = jnp.take_along_axis(group_prob, gsel[:, None], axis=-1)
    exp_logits = (hf @ we_r + be_r).astype(jnp.float32).reshape(n, N_GROUPS, EXPERTS_PER_GROUP)
    in_group = jnp.take_along_axis(exp_logits, gsel[:, None, None], axis=1)[:, 0]
    top_val, top_idx = lax.top_k(in_group, TOP_K_IN_GROUP)
    gates = gp * jax.nn.softmax(top_val, axis=-1)
    eid = (gsel[:, None] * EXPERTS_PER_GROUP + top_idx).reshape(-1).astype(jnp.int32)
    gate_flat = gates.reshape(-1)
    tok_flat = jnp.repeat(jnp.arange(n, dtype=jnp.int32), TOP_K_IN_GROUP)
    nk = n * TOP_K_IN_GROUP
    p_rows = -(-nk // MOE_BLOCK) * MOE_BLOCK + N_EXPERTS * MOE_BLOCK
    nb = p_rows // MOE_BLOCK
    order = jnp.argsort(eid)
    e_sorted = eid[order]
    counts = jnp.bincount(eid, length=N_EXPERTS)
    starts = jnp.cumsum(counts) - counts
    padded = -(-counts // MOE_BLOCK) * MOE_BLOCK
    pends = jnp.cumsum(padded)
    pstarts = pends - padded
    dest = pstarts[e_sorted] + (jnp.arange(nk) - starts[e_sorted])
    buf_tok = jnp.full((p_rows,), n, jnp.int32).at[dest].set(tok_flat[order])
    buf_gate = jnp.zeros((p_rows,), jnp.float32).at[dest].set(gate_flat[order])
    block_expert = jnp.clip(jnp.searchsorted(pends, jnp.arange(nb) * MOE_BLOCK, side='right'),
                            0, N_EXPERTS - 1).astype(jnp.int32)
    h_pad = jnp.concatenate([hf, jnp.zeros((1, d_), hf.dtype)], axis=0)

    def expert_block(args):
        tok, e = args
        xb = h_pad[tok]
        hid = jax.nn.silu(xb @ w_gate[e]) * (xb @ w_up[e])
        return hid @ w_down[e]

    out = lax.map(expert_block, (buf_tok.reshape(nb, MOE_BLOCK), block_expert))
    out = (out.reshape(p_rows, d_).astype(jnp.float32) * buf_gate[:, None]).astype(h.dtype)
    y = jnp.zeros((n + 1, d_), h.dtype).at[buf_tok].add(out)[:n]
    return y.reshape(b_, s_, d_)


def hybrid_layer(x, ln1_g, w_in, q_norm_g, k_norm_g, rpb, attn_out_g, conv_w, a_log, dt_bias,
                 dn_out_g, w_out, ln2_g, wg_r, bg_r, we_r, be_r, w_gate, w_up, w_down):
    b_, s_, _ = x.shape
    h = rms_norm(x, ln1_g)
    proj = h @ w_in
    a3 = 3 * ATTN_WIDTH
    aq, ak, av, dqkv, dz, dab = jnp.split(
        proj, [ATTN_WIDTH, 2 * ATTN_WIDTH, a3, a3 + 3 * DN_WIDTH, a3 + 4 * DN_WIDTH], axis=-1)
    hs = lambda t: t.reshape(b_, s_, ATTN_HEADS, ATTN_HEAD_DIM)
    aq = rms_norm(hs(aq), q_norm_g)
    ak = rms_norm(hs(ak), k_norm_g)
    attn = rms_norm(neighbourhood_attention(aq, ak, hs(av), rpb), attn_out_g)
    dab = dab.reshape(b_, s_, 2, 2, DN_HEADS)
    dn = bidirectional_gated_deltanet(dqkv, dz, dab[:, :, 0], dab[:, :, 1], conv_w, a_log,
                                      dt_bias, dn_out_g)
    x = x + jnp.concatenate([attn, dn], axis=-1) @ w_out
    x = x + hierarchical_moe(rms_norm(x, ln2_g), wg_r, bg_r, we_r, be_r, w_gate, w_up, w_down)
    return x


def setup_inputs(seed: int = 0) -> dict:
    key = jax.random.key(seed)
    ks = jax.random.split(key, 24)
    f32 = jnp.float32
    nrm = lambda k, shape, s: jax.random.normal(k, shape, f32) * s
    gain = lambda k, shape: 1.0 + 0.01 * jax.random.normal(k, shape, f32)
    L = DEPTH
    dt = jnp.exp(jax.random.uniform(ks[9], (L, 2, DN_HEADS), f32, np.log(1e-3), np.log(1e-1)))
    return {
        'x': nrm(ks[0], (BATCH, SEQ, D_MODEL), 1.0),
        'ln1_g': gain(ks[1], (L, D_MODEL)),
        'w_in': nrm(ks[2], (L, D_MODEL, IN_COLS), D_MODEL ** -0.5),
        'attn_q_norm_g': gain(ks[3], (L, ATTN_HEAD_DIM)),
        'attn_k_norm_g': gain(ks[4], (L, ATTN_HEAD_DIM)),
        'attn_rpb': nrm(ks[5], (L, ATTN_HEADS, 2 * WIN_H_MAX - 1, 2 * WIN_W - 1), 0.1),
        'attn_out_norm_g': gain(ks[6], (L, ATTN_WIDTH)),
        'dn_conv_w': nrm(ks[7], (L, DN_CONV, 3 * DN_WIDTH), DN_CONV ** -0.5),
        'dn_a_log': jnp.log(jax.random.uniform(ks[8], (L, 2, DN_HEADS), f32, 1.0, 16.0)),
        'dn_dt_bias': dt + jnp.log(-jnp.expm1(-dt)),
        'dn_out_norm_g': gain(ks[10], (L, DN_HEAD_DIM)),
        'w_out': nrm(ks[11], (L, D_MIX, D_MODEL), D_MIX ** -0.5),
        'ln2_g': gain(ks[12], (L, D_MODEL)),
        'router_group_w': nrm(ks[13], (L, D_MODEL, N_GROUPS), D_MODEL ** -0.5),
        'router_group_b': nrm(ks[14], (L, N_GROUPS), 0.01),
        'router_expert_w': nrm(ks[15], (L, D_MODEL, N_EXPERTS), D_MODEL ** -0.5),
        'router_expert_b': nrm(ks[16], (L, N_EXPERTS), 0.01),
        'expert_w_gate': nrm(ks[17], (L, N_EXPERTS, D_MODEL, D_EXPERT), D_MODEL ** -0.5),
        'expert_w_up': nrm(ks[18], (L, N_EXPERTS, D_MODEL, D_EXPERT), D_MODEL ** -0.5),
        'expert_w_down': nrm(ks[19], (L, N_EXPERTS, D_EXPERT, D_MODEL), D_EXPERT ** -0.5),
    }


def reference(x, ln1_g, w_in, attn_q_norm_g, attn_k_norm_g, attn_rpb, attn_out_norm_g, dn_conv_w,
              dn_a_log, dn_dt_bias, dn_out_norm_g, w_out, ln2_g, router_group_w, router_group_b,
              router_expert_w, router_expert_b, expert_w_gate, expert_w_up, expert_w_down):
    for l in range(DEPTH):
        x = hybrid_layer(x, ln1_g[l], w_in[l], attn_q_norm_g[l], attn_k_norm_g[l], attn_rpb[l],
                         attn_out_norm_g[l], dn_conv_w[l], dn_a_log[l], dn_dt_bias[l],
                         dn_out_norm_g[l], w_out[l], ln2_g[l], router_group_w[l], router_group_b[l],
                         router_expert_w[l], router_expert_b[l], expert_w_gate[l], expert_w_up[l],
                         expert_w_down[l])
    return x
```

```cpp
#include <hip/hip_runtime.h>
#include <cstdio>
#include <cstdint>

typedef unsigned short bf16;
typedef unsigned u32x4 __attribute__((ext_vector_type(4)));
typedef float f32x4 __attribute__((ext_vector_type(4)));

constexpr int BATCH = 16, SEQ = 4096, DM = 1024, NT = BATCH * SEQ;
constexpr int GW = 64, ROWS = SEQ / GW, KH = 8, KW = 16;
constexpr int AH = 8, ADH = 64, AW = 512;
constexpr int DH = 4, DHD = 128, DW = 512, DCONV = 5, DCHUNK = 64;
constexpr int INC = 3600, PC = 3584;
constexpr int NG = 8, EPG = 8, NE = 64, DE = 256;
constexpr float EPS = 1e-6f;
constexpr float LOG2E = 1.4426950408889634f;
constexpr int C_AQ = 0, C_AK = 512, C_AV = 1024, C_DQ = 1536, C_DK = 2048, C_DV = 2560, C_DZ = 3072;

constexpr size_t MiB = 1ull << 20;
constexpr size_t WS_CTL   = 0;
constexpr size_t WS_WIN   = 1 * MiB;
constexpr size_t WS_WO    = 8 * MiB + 512 * 1024;
constexpr size_t WS_WR    = 10 * MiB + 512 * 1024;
constexpr size_t WS_WGU   = 11 * MiB;
constexpr size_t WS_WD    = 75 * MiB;
constexpr size_t WS_A     = 107 * MiB;
constexpr size_t WS_PROJ  = 235 * MiB;
constexpr size_t WS_MIX   = 683 * MiB;
constexpr size_t WS_TQK   = 811 * MiB;
constexpr size_t WS_DAB   = 939 * MiB;
constexpr size_t WS_G     = 943 * MiB;
constexpr size_t WS_BETA  = 945 * MiB;
constexpr size_t WS_TOKE  = 947 * MiB;
constexpr size_t WS_TOKG  = 948 * MiB;
constexpr size_t WS_RSTD2 = 949 * MiB;
constexpr size_t WS_BIDX  = 950 * MiB;
constexpr size_t WS_END   = 966 * MiB;
constexpr size_t WS_HID   = WS_PROJ;
constexpr size_t WS_Y     = WS_PROJ + 80 * MiB;
constexpr int CW_CNT = 1024;

__device__ __forceinline__ float bf2f(bf16 v) { return __builtin_bit_cast(float, (unsigned)v << 16); }
__device__ __forceinline__ bf16 f2bf(float f) { unsigned u = __builtin_bit_cast(unsigned, f); return (bf16)((u + 0x7fffu + ((u >> 16) & 1u)) >> 16); }
template <int CTRL> __device__ __forceinline__ float dpp_f(float v) { return __builtin_bit_cast(float, __builtin_amdgcn_update_dpp(0, __builtin_bit_cast(int, v), CTRL, 0xf, 0xf, false)); }
__device__ __forceinline__ float row16_sum(float v) {
    v += dpp_f<0xB1>(v);
    v += dpp_f<0x4E>(v);
    v += dpp_f<0x141>(v);
    v += dpp_f<0x140>(v);
    return v;
}
__device__ __forceinline__ float wave_sum(float v) {
    const int b = __builtin_bit_cast(int, row16_sum(v));
    return (__builtin_bit_cast(float, __builtin_amdgcn_readlane(b, 0)) + __builtin_bit_cast(float, __builtin_amdgcn_readlane(b, 16))) + (__builtin_bit_cast(float, __builtin_amdgcn_readlane(b, 32)) + __builtin_bit_cast(float, __builtin_amdgcn_readlane(b, 48)));
}
__device__ __forceinline__ float silu_f(float x) { return x / (1.f + __expf(-x)); }
__device__ __forceinline__ float sigmoid_f(float x) { return 1.f / (1.f + __expf(-x)); }
__device__ __forceinline__ float softplus_f(float x) { return fmaxf(x, 0.f) + log1pf(__expf(-fabsf(x))); }

#define LAS __attribute__((address_space(3)))
#define GAS __attribute__((address_space(1)))
typedef short bf16x8 __attribute__((ext_vector_type(8)));
typedef GAS unsigned gu32;
constexpr int NWAVES = 8, NTHR = 512;
constexpr int LDS_BYTES = 163840, RING_BYTES = 131072, LDSCTL_OFF = 163328, MISC_OFF = LDSCTL_OFF + 64, TAB_OFF = 132096;
constexpr size_t WS_SSQ2 = 966 * MiB;
constexpr size_t WS_END2 = 970 * MiB;
constexpr int CW_TMO = 0, CW_BAR = 4096;
constexpr int CW_PCNT = 1280;
constexpr size_t WS_R2T = WS_CTL + 256 * 1024;
constexpr size_t WS_TOKP = WS_TOKE;
#define RLX_AGENT __ATOMIC_RELAXED, __HIP_MEMORY_SCOPE_AGENT
#define LDS_WAIT() asm volatile("s_waitcnt lgkmcnt(0)" ::: "memory")
#define VM_WAIT() asm volatile("s_waitcnt vmcnt(0)" ::: "memory")
#define LDS_BAR() do { asm volatile("s_waitcnt lgkmcnt(0)" ::: "memory"); __builtin_amdgcn_s_barrier(); asm volatile("" ::: "memory"); } while (0)
__device__ __forceinline__ unsigned pk2(float lo, float hi) { return (unsigned)f2bf(lo) | ((unsigned)f2bf(hi) << 16); }
typedef float f32x2_t __attribute__((ext_vector_type(2)));
typedef __bf16 bf16x2_t __attribute__((ext_vector_type(2)));
__device__ __forceinline__ unsigned cvt_pk_bf16_asm(float lo, float hi) { unsigned r; asm volatile("v_cvt_pk_bf16_f32 %0, %1, %2" : "=v"(r) : "v"(lo), "v"(hi)); return r; }
__device__ __forceinline__ unsigned cvt_pk_bf16(float lo, float hi) { const f32x2_t v = {lo, hi}; const bf16x2_t b = __builtin_convertvector(v, bf16x2_t); return __builtin_bit_cast(unsigned, b); }

#define XB_TMO      128
#define XB_XCNT(j)  (256  + 64 * (j))
#define XB_XSUB(j)  (1280 + 64 * (j))
#define XB_XGEN(j)  (2304 + 64 * (j))
#define XB_TOP      3328
#define XB_TOPGEN   3392
#define XCD_BAR_WORDS 3456
#define XB_SPIN_CAP (1u << 22)
__device__ __forceinline__ unsigned xb_ld(unsigned* p)              { return __hip_atomic_load(p, __ATOMIC_RELAXED, __HIP_MEMORY_SCOPE_AGENT); }
__device__ __forceinline__ unsigned xb_add(unsigned* p, unsigned v) { return __hip_atomic_fetch_add(p, v, __ATOMIC_RELAXED, __HIP_MEMORY_SCOPE_AGENT); }
__device__ __forceinline__ unsigned xb_xcc_id() { return (unsigned)__builtin_amdgcn_s_getreg((3 << 11) | 20) & 0xFu; }
#define XB_SPIN(cond, bar) do { unsigned _sp = 0; while (cond) { __builtin_amdgcn_s_sleep(1); \
    if ((++_sp & 255u) == 0u) { if (xb_ld(&(bar)[XB_TMO])) break; if (_sp > XB_SPIN_CAP) { atomicAdd(&(bar)[XB_TMO], 1u); break; } } } } while (0)
struct XcdBarrier { unsigned* bar; unsigned x; volatile LAS unsigned* st; };
__device__ __forceinline__ XcdBarrier xcd_barrier_post(unsigned* bar, volatile LAS unsigned* st) {
    XcdBarrier b; b.bar = bar; b.x = xb_xcc_id(); b.st = st;
    if (threadIdx.x == 0) (void)xb_add(&bar[XB_XCNT(b.x)], 1u);
    return b;
}
__device__ __forceinline__ void xcd_barrier_complete(unsigned* bar, unsigned x, unsigned& nloc, unsigned& nx) {
    const unsigned G = gridDim.x * gridDim.y * gridDim.z;
    unsigned sum, cnt, mine, sp = 0u;
    for (;;) {
        sum = 0u; cnt = 0u; mine = 0u;
#pragma unroll
        for (unsigned j = 0; j < 16; ++j) { const unsigned c = xb_ld(&bar[XB_XCNT(j)]); sum += c; cnt += (c > 0u) ? 1u : 0u; mine = (j == x) ? c : mine; }
        if (sum == G) break;
        __builtin_amdgcn_s_sleep(1);
        if ((++sp & 255u) == 0u) { if (xb_ld(&bar[XB_TMO])) break; if (sp > XB_SPIN_CAP) { atomicAdd(&bar[XB_TMO], 1u); break; } }
    }
    nloc = mine > 0u ? mine : 1u; nx = cnt > 0u ? cnt : 1u;
}
__device__ __forceinline__ void xcd_barrier(const XcdBarrier& b) {
    asm volatile("s_waitcnt vmcnt(0)" ::: "memory");
    __syncthreads();
    if (threadIdx.x == 0) {
        unsigned* bar = b.bar;
        __builtin_amdgcn_s_waitcnt(0);
        unsigned nloc = b.st[0], nx = b.st[1];
        if (nloc == 0u) { xcd_barrier_complete(bar, b.x, nloc, nx); b.st[0] = nloc; b.st[1] = nx; }
        const unsigned old = xb_add(&bar[XB_XSUB(b.x)], 1u);
        const unsigned gen = old / nloc;
        if (old + 1u == (gen + 1u) * nloc) {
            __builtin_amdgcn_fence(__ATOMIC_RELEASE, "agent");
            asm volatile("s_waitcnt vmcnt(0)" ::: "memory");
            const unsigned og = xb_add(&bar[XB_TOP], 1u);
            const unsigned tg = og / nx;
            if (og + 1u == (tg + 1u) * nx) xb_add(&bar[XB_TOPGEN], 1u);
            else XB_SPIN(xb_ld(&bar[XB_TOPGEN]) == tg, bar);
            __builtin_amdgcn_fence(__ATOMIC_ACQUIRE, "agent");
            xb_add(&bar[XB_XGEN(b.x)], 1u);
            asm volatile("s_waitcnt vmcnt(0)" ::: "memory");
        } else {
            XB_SPIN(xb_ld(&bar[XB_XGEN(b.x)]) == gen, bar);
            __builtin_amdgcn_fence(__ATOMIC_ACQUIRE, "agent");
            asm volatile("s_waitcnt vmcnt(0)" ::: "memory");
        }
    }
    __syncthreads();
}

namespace pg8 {
constexpr int BM = 256, BK = 64, HALF = 128, HTB = HALF * BK * 2, NXCD = 8, WGM = 8;
__host__ __device__ __forceinline__ int lds_byte(int r, int c) { const int st = (r >> 4) * 2 + (c >> 5), rr = r & 15, cc = c & 31, ob = rr * 64 + cc * 2; return st * 1024 + (ob ^ (((ob >> 9) & 1) << 5)); }
__host__ __device__ __forceinline__ void stage_rc(int b, int& R, int& C) { const int st = b / 1024, sb = b % 1024, swz = sb ^ (((sb >> 9) & 1) << 5); R = (st >> 1) * 16 + swz / 64; C = (st & 1) * 32 + (swz % 64) / 2; }
__host__ __device__ __forceinline__ int perm32(int rho) { const int n = rho >> 4, i = rho & 15; return 8 * (i >> 2) + 4 * n + (i & 3); }
struct Unit { int pm, pn, e, ts, e2; };
struct Gemm { const bf16* A; const bf16* Bt; int K; size_t bstride; int ldb, bsplit; };
struct StaticOrder {
    int nM, nN, nwg, G, c;
    __device__ void init(int M, int N, int G_, int c_) { nM = M / BM; nN = N / BM; nwg = nM * nN; G = G_; c = c_; }
    __device__ bool next(int i, Unit& u) const {
        const long L = (long)i * G + c; if (L >= nwg) return false;
        int wgid = (int)L; { const int q = nwg / NXCD, r = nwg % NXCD, xcd = wgid % NXCD, off = wgid / NXCD; wgid = (xcd < r ? xcd * (q + 1) : r * (q + 1) + (xcd - r) * q) + off; }
        const int nig = WGM * nN, gid = wgid / nig, fm = gid * WGM, gsz = (nM - fm) < WGM ? (nM - fm) : WGM;
        u.pm = fm + ((wgid % nig) % gsz); u.pn = (wgid % nig) / gsz; u.e = 0; u.ts = 0; u.e2 = 0; return true;
    }
};
struct DenseA { int K; __device__ __forceinline__ unsigned rowoff(const Unit& u, int h, int R) const { return (unsigned)(u.pm * BM + h * HALF + R) * (unsigned)(K * 2); } };
struct GatherA { const LAS unsigned* tab; __device__ __forceinline__ unsigned rowoff(const Unit& u, int h, int R) const { return tab[u.ts * BM + h * HALF + R]; } };

template <class Epi, class Sched, class AMap, bool ALIGN_EPI>
__device__ __forceinline__ void gemm_phase(LAS unsigned char* lds, const Gemm g, const Sched& S, const AMap& AM, const Epi& E) {
    const int tid = threadIdx.x, wid = __builtin_amdgcn_readfirstlane(tid >> 6), lane = tid & 63, wr = wid >> 2, wc = wid & 3, fr = lane & 15, fq = lane >> 4;
    const int K = g.K, nt = K / BK;
    unsigned voffB[2];
#pragma unroll
    for (int i = 0; i < 2; ++i) { int R, C; stage_rc(tid * 16 + i * 8192, R, C); const int Rb = Epi::PERM ? ((R & ~31) + perm32(R & 31)) : R;
        voffB[i] = (unsigned)(Rb * g.ldb + C) * 2u; }
    const size_t kstep = (size_t)(BK * 2);
    const size_t hstep = (size_t)HALF * g.ldb * 2;
    const int bsplit = g.bsplit;
    const size_t tstep = 2 * hstep;
    const unsigned ldsw = (unsigned)wid * 1024u;
    const int aoff = lds_byte(wr * 64 + fr, fq * 8), boff = lds_byte(wc * 32 + fr, fq * 8);
    const char* const Ab = (const char*)g.A;
#define PG8_SA(b, h) (((b) * 2 + (h)) * HTB)
#define PG8_SB(b, h) ((4 + (b) * 2 + (h)) * HTB)
#define PG8_STAGE(bufoff, gbase, voff) do { _Pragma("unroll") for (int _i = 0; _i < 2; ++_i) \
        __builtin_amdgcn_global_load_lds((const unsigned*)((const char*)(gbase) + (voff)[_i]), (LAS unsigned*)(lds + (bufoff) + ldsw + _i * 8192), 16, 0, 0); } while (0)
#define PG8_LDA(dst, b, h) do { _Pragma("unroll") for (int m = 0; m < 4; ++m) _Pragma("unroll") for (int k = 0; k < 2; ++k) dst[m][k] = *(const LAS bf16x8*)(lds + PG8_SA(b, h) + aoff + m * 2048 + k * 1024); } while (0)
#define PG8_LDB(dst, b, h) do { _Pragma("unroll") for (int n = 0; n < 2; ++n) _Pragma("unroll") for (int k = 0; k < 2; ++k) dst[n][k] = *(const LAS bf16x8*)(lds + PG8_SB(b, h) + boff + n * 2048 + k * 1024); } while (0)
#define PG8_MMA(ai, bj, At, Bt) do { __builtin_amdgcn_s_setprio(1); _Pragma("unroll") for (int m = 0; m < 4; ++m) _Pragma("unroll") for (int n = 0; n < 2; ++n) _Pragma("unroll") for (int k = 0; k < 2; ++k) \
        acc[ai][bj][m][n] = __builtin_amdgcn_mfma_f32_16x16x32_bf16(Bt[n][k], At[m][k], acc[ai][bj][m][n], 0, 0, 0); __builtin_amdgcn_s_setprio(0); } while (0)
#define PG8_WAIT_V(n) asm volatile("s_waitcnt vmcnt(" #n ")" ::: "memory")
#define PG8_WAIT_L(n) asm volatile("s_waitcnt lgkmcnt(" #n ")" ::: "memory")
#define PG8_BAR __builtin_amdgcn_s_barrier()
#define PG8_SCHED __builtin_amdgcn_sched_barrier(0)
    Unit cur, nxt; int ui = 0;
    if (!S.next(0, cur)) return;
    f32x4 acc[2][2][4][2];
#pragma unroll
    for (int a = 0; a < 2; ++a)
#pragma unroll
        for (int b = 0; b < 2; ++b)
#pragma unroll
            for (int m = 0; m < 4; ++m)
#pragma unroll
                for (int n = 0; n < 2; ++n) acc[a][b][m][n] = (f32x4){0.f, 0.f, 0.f, 0.f};
    bf16x8 At[4][2], B0[2][2], B1[2][2];
    unsigned ca[2][2];
#pragma unroll
    for (int i = 0; i < 2; ++i) { int R, C; stage_rc(tid * 16 + i * 8192, R, C);
#pragma unroll
        for (int h = 0; h < 2; ++h) ca[h][i] = AM.rowoff(cur, h, R) + (unsigned)C * 2u; }
    const char* cB = (const char*)g.Bt + (size_t)cur.e * g.bstride + (size_t)cur.pn * tstep;
    const char* cB2 = (const char*)g.Bt + (size_t)cur.e2 * g.bstride + (size_t)cur.pn * tstep;
    PG8_STAGE(PG8_SB(0, 0), cB, voffB); PG8_STAGE(PG8_SB(0, 1), cB + hstep, voffB); PG8_STAGE(PG8_SA(0, 0), Ab, ca[0]); PG8_STAGE(PG8_SA(0, 1), Ab, ca[1]);
    if (wr == 1) PG8_BAR;
    PG8_WAIT_V(2); PG8_BAR;
    PG8_STAGE(PG8_SB(1, 0), cB + kstep, voffB); PG8_STAGE(PG8_SA(1, 0), Ab + kstep, ca[0]); PG8_STAGE(PG8_SB(1, 1), cB + hstep + kstep, voffB);
    PG8_WAIT_V(6); PG8_BAR;
    for (;;) {
        const bool has_next = S.next(ui + 1, nxt);
        const char* nB = has_next ? (const char*)g.Bt + (size_t)nxt.e * g.bstride + (size_t)nxt.pn * tstep : cB;
        for (int t = 0; t < nt; t += 2) {
            const bool last = (t == nt - 2);
            unsigned a2[2][2];
#pragma unroll
            for (int h = 0; h < 2; ++h)
#pragma unroll
                for (int i = 0; i < 2; ++i) a2[h][i] = ca[h][i];
            if (last && has_next) {
                int tq = tid; asm volatile("" : "+v"(tq));
#pragma unroll
                for (int i = 0; i < 2; ++i) { int R, C; stage_rc(tq * 16 + i * 8192, R, C);
#pragma unroll
                    for (int h = 0; h < 2; ++h) a2[h][i] = AM.rowoff(nxt, h, R) + (unsigned)C * 2u; }
            }
            const char* a1 = Ab + (size_t)(t + 1) * kstep;
            const char* a2b = last ? Ab : Ab + (size_t)(t + 2) * kstep;
            const char* b2 = last ? nB : ((bsplit > 0 && t + 2 >= bsplit) ? cB2 + (size_t)(t + 2 - bsplit) * kstep : cB + (size_t)(t + 2) * kstep);
            const char* a3b = a2b + kstep; const char* b3 = b2 + kstep;
            PG8_LDB(B0, 0, 0); PG8_LDB(B1, 0, 1); PG8_SCHED; PG8_LDA(At, 0, 0); PG8_STAGE(PG8_SA(1, 1), a1, ca[1]);
            PG8_WAIT_V(8); PG8_WAIT_L(0); PG8_BAR; PG8_MMA(0, 0, At, B0); PG8_MMA(0, 1, At, B1); PG8_BAR; PG8_SCHED;
            PG8_LDA(At, 0, 1); PG8_STAGE(PG8_SB(0, 0), b2, voffB); PG8_STAGE(PG8_SB(0, 1), b2 + hstep, voffB); PG8_STAGE(PG8_SA(0, 0), a2b, a2[0]);
            PG8_WAIT_V(8); PG8_WAIT_L(0); PG8_BAR; PG8_MMA(1, 0, At, B0); PG8_MMA(1, 1, At, B1); PG8_BAR; PG8_SCHED;
            PG8_LDB(B0, 1, 0); PG8_LDB(B1, 1, 1); PG8_SCHED; PG8_LDA(At, 1, 0); PG8_STAGE(PG8_SA(0, 1), a2b, a2[1]);
            PG8_WAIT_V(8); PG8_WAIT_L(0); PG8_BAR; PG8_MMA(0, 0, At, B0); PG8_MMA(0, 1, At, B1); PG8_BAR; PG8_SCHED;
            PG8_LDA(At, 1, 1); PG8_STAGE(PG8_SB(1, 0), b3, voffB); PG8_STAGE(PG8_SB(1, 1), b3 + hstep, voffB); PG8_STAGE(PG8_SA(1, 0), a3b, a2[0]);
            PG8_WAIT_V(8); PG8_WAIT_L(0); PG8_BAR; PG8_MMA(1, 0, At, B0); PG8_MMA(1, 1, At, B1); PG8_BAR; PG8_SCHED;
            if (last) {
#pragma unroll
                for (int h = 0; h < 2; ++h)
#pragma unroll
                    for (int i = 0; i < 2; ++i) ca[h][i] = a2[h][i];
            }
        }
        if constexpr (ALIGN_EPI) { if (wr == 0) PG8_BAR; }
        if constexpr (!Epi::AFTER_DRAIN) { E(acc, cur, wr, wc, fr, fq); }
        if (!has_next) break;
#pragma unroll
        for (int a = 0; a < 2; ++a)
#pragma unroll
            for (int b = 0; b < 2; ++b)
#pragma unroll
                for (int m = 0; m < 4; ++m)
#pragma unroll
                    for (int n = 0; n < 2; ++n) acc[a][b][m][n] = (f32x4){0.f, 0.f, 0.f, 0.f};
        cur = nxt; cB = nB; cB2 = (const char*)g.Bt + (size_t)cur.e2 * g.bstride + (size_t)cur.pn * tstep; ++ui;
        if constexpr (ALIGN_EPI) { if (wr == 1) PG8_BAR; }
    }
    PG8_WAIT_V(0);
    if constexpr (!ALIGN_EPI) { if (wr == 0) PG8_BAR; }
    PG8_BAR;
    if constexpr (Epi::AFTER_DRAIN) { E.fused(acc, cur, wr, wc, fr, fq, lds, wid, lane); }
#undef PG8_SA
#undef PG8_SB
#undef PG8_STAGE
#undef PG8_LDA
#undef PG8_LDB
#undef PG8_MMA
#undef PG8_WAIT_V
#undef PG8_WAIT_L
#undef PG8_BAR
#undef PG8_SCHED
}
}

struct EpiInProjF { static constexpr bool PERM = true, AFTER_DRAIN = false;
    bf16* proj; const LAS float* gains; float* dab;
    __device__ __forceinline__ void operator()(const f32x4 (&acc)[2][2][4][2], const pg8::Unit& u, int wr, int wc, int fr, int fq) const {
        if (u.pn == 14) {
            if (wc == 0) {
#pragma unroll
                for (int ai = 0; ai < 2; ++ai)
#pragma unroll
                    for (int m = 0; m < 4; ++m) { const int row = u.pm * 256 + ai * 128 + wr * 64 + m * 16 + fr;
#pragma unroll
                        for (int n = 0; n < 2; ++n) { f32x4 t = acc[ai][0][m][n];
#pragma unroll
                            for (int i = 0; i < 4; ++i) t[i] += __shfl_xor(t[i], 32);
                            if (fq < 2) *(f32x4*)(dab + (size_t)row * 16 + 8 * fq + 4 * n) = t; } }
            }
            return;
        }
        const int mode = u.pn < 2 ? 0 : (u.pn < 4 ? 1 : 2);
        float one = 1.f; asm volatile("" : "+v"(one));
        f32x4 gv[2][2];
        if (mode < 2) {
#pragma unroll
            for (int bj = 0; bj < 2; ++bj)
#pragma unroll
                for (int n = 0; n < 2; ++n) gv[bj][n] = *(const LAS f32x4*)(gains + mode * 64 + 32 * bj + 8 * fq + 4 * n);
        }
#pragma unroll
        for (int ai = 0; ai < 2; ++ai)
#pragma unroll
            for (int m = 0; m < 4; ++m) {
                const int row = u.pm * 256 + ai * 128 + wr * 64 + m * 16 + fr;
                f32x4 v[2][2];
#pragma unroll
                for (int bj = 0; bj < 2; ++bj)
#pragma unroll
                    for (int n = 0; n < 2; ++n) v[bj][n] = acc[ai][bj][m][n];
                if (mode >= 2) {
#pragma unroll
                    for (int bj = 0; bj < 2; ++bj)
#pragma unroll
                        for (int n = 0; n < 2; ++n) v[bj][n] = v[bj][n] * one;
                }
                if (mode < 2) {
                    float ss = 0.f;
#pragma unroll
                    for (int bj = 0; bj < 2; ++bj)
#pragma unroll
                        for (int n = 0; n < 2; ++n) ss += (v[bj][n][0] * v[bj][n][0] + v[bj][n][1] * v[bj][n][1]) + (v[bj][n][2] * v[bj][n][2] + v[bj][n][3] * v[bj][n][3]);
                    ss += __shfl_xor(ss, 16); ss += __shfl_xor(ss, 32);
                    const float rstd = rsqrtf(ss * (1.f / 64) + EPS);
#pragma unroll
                    for (int bj = 0; bj < 2; ++bj)
#pragma unroll
                        for (int n = 0; n < 2; ++n) v[bj][n] = v[bj][n] * rstd * gv[bj][n];
                }
                bf16* rp = proj + (size_t)row * PC + u.pn * 256 + wc * 64 + 8 * fq;
#pragma unroll
                for (int bj = 0; bj < 2; ++bj) { u32x4 w; w.x = cvt_pk_bf16_asm(v[bj][0][0], v[bj][0][1]); w.y = cvt_pk_bf16_asm(v[bj][0][2], v[bj][0][3]); w.z = cvt_pk_bf16_asm(v[bj][1][0], v[bj][1][1]); w.w = cvt_pk_bf16_asm(v[bj][1][2], v[bj][1][3]);
                    *(u32x4*)(rp + 32 * bj) = w; }
            }
    }
};
struct EpiOutF { static constexpr bool PERM = true, AFTER_DRAIN = false;
    const float* x; float* out; bf16* x2b; float* ssq2;
    __device__ __forceinline__ void operator()(const f32x4 (&acc)[2][2][4][2], const pg8::Unit& u, int wr, int wc, int fr, int fq) const {
#pragma unroll
        for (int ai = 0; ai < 2; ++ai)
#pragma unroll
            for (int m = 0; m < 4; ++m) {
                const int row = u.pm * 256 + ai * 128 + wr * 64 + m * 16 + fr; float ss = 0.f;
#pragma unroll
                for (int bj = 0; bj < 2; ++bj) { const size_t off = (size_t)row * DM + u.pn * 256 + bj * 128 + wc * 32 + 8 * fq;
                    const f32x4 r0 = *(const f32x4*)(x + off) + acc[ai][bj][m][0], r1 = *(const f32x4*)(x + off + 4) + acc[ai][bj][m][1];
                    ss += (r0[0] * r0[0] + r0[1] * r0[1]) + (r0[2] * r0[2] + r0[3] * r0[3]) + (r1[0] * r1[0] + r1[1] * r1[1]) + (r1[2] * r1[2] + r1[3] * r1[3]);
                    u32x4 w; w.x = cvt_pk_bf16_asm(r0[0], r0[1]); w.y = cvt_pk_bf16_asm(r0[2], r0[3]); w.z = cvt_pk_bf16_asm(r1[0], r1[1]); w.w = cvt_pk_bf16_asm(r1[2], r1[3]);
                    *(u32x4*)(x2b + off) = w; }
                ss += __shfl_xor(ss, 16); ss += __shfl_xor(ss, 32);
                if (fq == 0) ssq2[(size_t)(u.pn * 4 + wc) * NT + row] = ss;
            }
    }
};
struct EpiRouterF { static constexpr bool PERM = true, AFTER_DRAIN = true;
    const float* ssq2; const float* bg; const float* be; int* toke; float* tokg; float* rstd2; int* bidx; unsigned* cnt;
    __device__ __forceinline__ void fused(const f32x4 (&acc)[2][2][4][2], const pg8::Unit& u, int wr, int wc, int fr, int fq, LAS unsigned char* lds, int wid, int lane) const {
        LAS float* LG = (LAS float*)lds;
        LAS unsigned* cl = (LAS unsigned*)(lds + 80 * 1024);
        LAS unsigned* clp = cl + 128;
        const int tid = threadIdx.x;
        if (tid < 128) cl[tid] = 0u;
        if (tid < 448) clp[tid] = 0u;
        if (wc == 0) {
#pragma unroll
            for (int ai = 0; ai < 2; ++ai)
#pragma unroll
                for (int m = 0; m < 4; ++m) { const int r = ai * 128 + wr * 64 + m * 16 + fr;
#pragma unroll
                    for (int bj = 0; bj < 2; ++bj)
#pragma unroll
                        for (int n = 0; n < 2; ++n)
#pragma unroll
                            for (int i = 0; i < 4; ++i) LG[r * 73 + 32 * bj + 8 * fq + 4 * n + i] = acc[ai][bj][m][n][i]; }
        } else if (wc == 1 && fq == 0) {
#pragma unroll
            for (int ai = 0; ai < 2; ++ai)
#pragma unroll
                for (int m = 0; m < 4; ++m) { const int r = ai * 128 + wr * 64 + m * 16 + fr;
#pragma unroll
                    for (int n = 0; n < 2; ++n)
#pragma unroll
                        for (int i = 0; i < 4; ++i) LG[r * 73 + 64 + 4 * n + i] = acc[ai][0][m][n][i]; }
        }
        __syncthreads();
        int e0 = 0, e1 = 0, pb = 0, slo = 0; unsigned r0 = 0, r1 = 0, rp = 0; const int tok = u.pm * 256 + tid;
        if (tid < 256) {
            float ss = 0.f;
#pragma unroll
            for (int p = 0; p < 16; ++p) ss += ssq2[(size_t)p * NT + tok];
            const float rstd = rsqrtf(ss * (1.f / DM) + EPS);
            const LAS float* lg = LG + tid * 73;
            float gl[8];
#pragma unroll
            for (int n = 0; n < 8; ++n) gl[n] = lg[64 + n] * rstd + bg[n];
            int gs = 0; float gm = gl[0];
#pragma unroll
            for (int n = 1; n < 8; ++n) if (gl[n] > gm) { gm = gl[n]; gs = n; }
            float den = 0.f;
#pragma unroll
            for (int n = 0; n < 8; ++n) den += __expf(gl[n] - gm);
            const float gp = 1.f / den;
            float el[8];
#pragma unroll
            for (int n = 0; n < 8; ++n) el[n] = lg[gs * 8 + n] * rstd + be[gs * 8 + n];
            int i1 = 0; float v1 = el[0];
#pragma unroll
            for (int n = 1; n < 8; ++n) if (el[n] > v1) { v1 = el[n]; i1 = n; }
            int i2 = 0; float v2 = -3.0e38f;
#pragma unroll
            for (int n = 0; n < 8; ++n) if (n != i1 && el[n] > v2) { v2 = el[n]; i2 = n; }
            const float ex = __expf(v2 - v1), p1 = 1.f / (1.f + ex), p2 = ex * p1;
            e0 = gs * 8 + i1; e1 = gs * 8 + i2;
            tokg[tok * 2] = gp * p1; tokg[tok * 2 + 1] = gp * p2; rstd2[tok] = rstd;
            r0 = __hip_atomic_fetch_add(cl + e0, 1u, __ATOMIC_RELAXED, __HIP_MEMORY_SCOPE_WORKGROUP);
            r1 = __hip_atomic_fetch_add(cl + e1, 1u, __ATOMIC_RELAXED, __HIP_MEMORY_SCOPE_WORKGROUP);
            { const int lo = i1 < i2 ? i1 : i2, hi = i1 < i2 ? i2 : i1; slo = i1 < i2 ? 0 : 1; pb = gs * 28 + (lo * (15 - lo)) / 2 + (hi - lo - 1); }
            rp = __hip_atomic_fetch_add(clp + pb, 1u, __ATOMIC_RELAXED, __HIP_MEMORY_SCOPE_WORKGROUP);
        }
        __syncthreads();
        if (tid < 64) { const unsigned c = cl[tid]; cl[64 + tid] = c ? __hip_atomic_fetch_add(cnt + tid, c, __ATOMIC_RELAXED, __HIP_MEMORY_SCOPE_AGENT) : 0u; }
        else if (tid >= 256 && tid < 256 + 224) { const int q = tid - 256; const unsigned c = clp[q]; clp[224 + q] = c ? __hip_atomic_fetch_add(cnt + (CW_PCNT - CW_CNT) + q, c, __ATOMIC_RELAXED, __HIP_MEMORY_SCOPE_AGENT) : 0u; }
        __syncthreads();
        if (tid < 256) { bidx[(size_t)e0 * 65536 + cl[64 + e0] + r0] = tok; bidx[(size_t)e1 * 65536 + cl[64 + e1] + r1] = tok | (1 << 16);
            toke[tok] = (int)(clp[224 + pb] + rp) | (pb << 16) | (slo << 24); }
    }
};
struct EpiMoe1F { static constexpr bool PERM = true, AFTER_DRAIN = false;
    bf16* hid2; const LAS float* rscale; const LAS unsigned* dest; const LAS float* gate;
    __device__ __forceinline__ void operator()(const f32x4 (&acc)[2][2][4][2], const pg8::Unit& u, int wr, int wc, int fr, int fq) const {
#pragma unroll
        for (int ai = 0; ai < 2; ++ai)
#pragma unroll
            for (int m = 0; m < 4; ++m) { const int r = ai * 128 + wr * 64 + m * 16 + fr; const float rs = rscale[u.ts * 256 + r], gt = gate[u.ts * 256 + r]; const unsigned d = dest[u.ts * 256 + r];
                float h[8];
#pragma unroll
                for (int n = 0; n < 2; ++n)
#pragma unroll
                    for (int i = 0; i < 4; ++i) { const float gv = acc[ai][0][m][n][i] * rs, up = acc[ai][1][m][n][i] * rs; h[4 * n + i] = gv * up * gt * __builtin_amdgcn_rcpf(1.f + __expf(-gv)); }
                u32x4 w; w.x = cvt_pk_bf16_asm(h[0], h[1]); w.y = cvt_pk_bf16_asm(h[2], h[3]); w.z = cvt_pk_bf16_asm(h[4], h[5]); w.w = cvt_pk_bf16_asm(h[6], h[7]);
                if (d != 0xffffffffu) *(u32x4*)((char*)hid2 + d + (unsigned)((u.pn * 128 + wc * 32 + 8 * fq) * 2)) = w;
                __builtin_amdgcn_sched_barrier(0); }
    }
};
struct EpiMoe2F { static constexpr bool PERM = true, AFTER_DRAIN = false;
    const bf16* x2b; float* out; const LAS unsigned* tokp1;
    __device__ __forceinline__ void operator()(const f32x4 (&acc)[2][2][4][2], const pg8::Unit& u, int wr, int wc, int fr, int fq) const {
#pragma unroll
        for (int ai = 0; ai < 2; ++ai) {
            unsigned off0[4]; u32x4 xr[4][2];
#pragma unroll
            for (int m = 0; m < 4; ++m) { const unsigned t1 = tokp1[u.ts * 256 + ai * 128 + wr * 64 + m * 16 + fr];
                off0[m] = t1 ? (t1 - 1u) * (unsigned)DM + (unsigned)(u.pn * 256 + wc * 32 + 8 * fq) : 0xffffffffu;
#pragma unroll
                for (int bj = 0; bj < 2; ++bj) xr[m][bj] = *(const u32x4*)(x2b + (t1 ? off0[m] + bj * 128 : 0u)); }
#pragma unroll
            for (int m = 0; m < 4; ++m) if (off0[m] != 0xffffffffu) {
#pragma unroll
                for (int bj = 0; bj < 2; ++bj) { const unsigned off = off0[m] + bj * 128; const u32x4 x = xr[m][bj];
                    f32x4 o0, o1; o0[0] = __builtin_bit_cast(float, x.x << 16); o0[1] = __builtin_bit_cast(float, x.x & 0xffff0000u); o0[2] = __builtin_bit_cast(float, x.y << 16); o0[3] = __builtin_bit_cast(float, x.y & 0xffff0000u);
                    o1[0] = __builtin_bit_cast(float, x.z << 16); o1[1] = __builtin_bit_cast(float, x.z & 0xffff0000u); o1[2] = __builtin_bit_cast(float, x.w << 16); o1[3] = __builtin_bit_cast(float, x.w & 0xffff0000u);
                    __builtin_nontemporal_store(o0 + acc[ai][bj][m][0], (f32x4*)(out + off)); __builtin_nontemporal_store(o1 + acc[ai][bj][m][1], (f32x4*)(out + off + 4)); } }
            __builtin_amdgcn_sched_barrier(0); }
    }
};
struct MoeSched { const LAS int* tab; int n;
    __device__ __forceinline__ bool next(int i, pg8::Unit& u) const { if (i >= n) return false;
        u.pm = __builtin_amdgcn_readfirstlane(tab[8 * i]); u.pn = __builtin_amdgcn_readfirstlane(tab[8 * i + 1]); u.e = __builtin_amdgcn_readfirstlane(tab[8 * i + 2]); u.ts = __builtin_amdgcn_readfirstlane(tab[8 * i + 3]);
        u.e2 = __builtin_amdgcn_readfirstlane(tab[8 * i + 4]); return true; }
};

struct Args { const float* in[20]; float* out; unsigned char* ws; int ph_lo, ph_hi; };
struct Frame { LAS unsigned char* lds; int tid, lane, wave, vcu, G; unsigned char* ws; };

template <class RowMap>
__device__ __forceinline__ void p0_transpose_item(const float* W, int ldw, int k0, int n0, const float* ksc, bf16* dst, int Kd, const RowMap& rm, LAS float* scr, int lane) {
    const int kr = lane >> 4, nq = lane & 15;
    f32x4 tv[16];
#pragma unroll
    for (int i = 0; i < 16; ++i) tv[i] = *(const f32x4*)(W + (size_t)(k0 + 4 * i + kr) * ldw + n0 + 4 * nq);
    if (ksc) {
#pragma unroll
        for (int i = 0; i < 16; ++i) tv[i] = tv[i] * ksc[k0 + 4 * i + kr]; }
#pragma unroll
    for (int i = 0; i < 16; ++i) { LAS float* d = scr + (4 * i + kr) * 65 + 4 * nq; d[0] = tv[i][0]; d[1] = tv[i][1]; d[2] = tv[i][2]; d[3] = tv[i][3]; }
    LDS_WAIT(); asm volatile("" ::: "memory");
    const int c = lane & 7;
#pragma unroll
    for (int j = 0; j < 8; ++j) { const int n = (lane >> 3) + 8 * j; const LAS float* sp = scr + (8 * c) * 65 + n;
        u32x4 o; o.x = cvt_pk_bf16(sp[0 * 65], sp[1 * 65]); o.y = cvt_pk_bf16(sp[2 * 65], sp[3 * 65]); o.z = cvt_pk_bf16(sp[4 * 65], sp[5 * 65]); o.w = cvt_pk_bf16(sp[6 * 65], sp[7 * 65]);
        *(u32x4*)(dst + (size_t)rm(n0 + n) * Kd + k0 + 8 * c) = o; }
    LDS_WAIT(); asm volatile("" ::: "memory");
}
struct RmIn  { __device__ __forceinline__ int operator()(int n) const { const int pn = n >> 8, lc = n & 255; return pn * 256 + 128 * ((lc >> 5) & 1) + 32 * (lc >> 6) + (lc & 31); } };
struct RmId  { int off; __device__ __forceinline__ int operator()(int n) const { return off + n; } };
struct RmGU  { int e, u; __device__ __forceinline__ int operator()(int n) const { return e * 512 + 256 * (n >> 7) + 128 * u + (n & 127); } };

__device__ __forceinline__ void phase0(const Frame& F, const Args& a) {
    const float* x = a.in[0]; const float* ln1_g = a.in[1]; const float* w_in = a.in[2];
    const float* w_out = a.in[11]; const float* ln2_g = a.in[12]; const float* wg_r = a.in[13]; const float* we_r = a.in[15];
    const float* w_gate = a.in[17]; const float* w_up = a.in[18]; const float* w_down = a.in[19];
    bf16* WinT = (bf16*)(F.ws + WS_WIN); bf16* WoT = (bf16*)(F.ws + WS_WO); bf16* WrT = (bf16*)(F.ws + WS_WR); bf16* WguT = (bf16*)(F.ws + WS_WGU); bf16* WdT = (bf16*)(F.ws + WS_WD);
    bf16* XN = (bf16*)(F.ws + WS_A);
    LAS float* scr = (LAS float*)(F.lds + F.wave * 16640);
    const int gw = F.vcu * NWAVES + F.wave, NGW = F.G * NWAVES;
    constexpr int I_IN = 16 * 56, I_O = 16 * 16, I_G = 64 * 16 * 4, I_D = 64 * 4 * 16, I_R = 512;
    constexpr int NITEMS = I_IN + I_O + 2 * I_G + I_D + I_R;
#ifndef P0_REP_ITEMS
#define P0_REP_ITEMS 1
#endif
#ifndef P0_REP_ROWS
#define P0_REP_ROWS 1
#endif
#ifndef P0_NOITEMS
    for (int rep = 0; rep < P0_REP_ITEMS; ++rep)
    for (int it = gw; it < NITEMS; it += NGW) {
        int r = it;
        if (r < I_IN) { p0_transpose_item(w_in, INC, 64 * (r / 56), 64 * (r % 56), nullptr, WinT, DM, RmIn{}, scr, F.lane); continue; } r -= I_IN;
        if (r < I_O) { p0_transpose_item(w_out, DM, 64 * (r / 16), 64 * (r % 16), nullptr, WoT, DM, RmId{0}, scr, F.lane); continue; } r -= I_O;
        if (r < 2 * I_G) { const int u = r / I_G; r -= u * I_G; const int e = r / 64, q = r % 64;
            p0_transpose_item((u ? w_up : w_gate) + (size_t)e * DM * DE, DE, 64 * (q / 4), 64 * (q % 4), ln2_g, WguT, DM, RmGU{e, u}, scr, F.lane); continue; } r -= 2 * I_G;
        if (r < I_D) { const int e = r / 64, q = r % 64; p0_transpose_item(w_down + (size_t)e * DE * DM, DM, 64 * (q / 16), 64 * (q % 16), nullptr, WdT, DE, RmId{e * DM}, scr, F.lane); continue; } r -= I_D;
        if (r >= 256) {
            r -= 256; unsigned w[8];
#pragma unroll
            for (int j = 0; j < 8; ++j) { float v0 = 0.f, v1 = 0.f; const int k = F.lane * 16 + 2 * j;
                if (r < 32) { v0 = w_in[(size_t)k * INC + PC + (r & 15)]; v1 = w_in[(size_t)(k + 1) * INC + PC + (r & 15)];
                    if (r >= 16) { v0 -= __builtin_bit_cast(float, (unsigned)f2bf(v0) << 16); v1 -= __builtin_bit_cast(float, (unsigned)f2bf(v1) << 16); } }
                w[j] = pk2(v0, v1); }
            u32x4* dp = (u32x4*)(WinT + (size_t)(PC + r) * DM + F.lane * 16);
            dp[0] = (u32x4){w[0], w[1], w[2], w[3]}; dp[1] = (u32x4){w[4], w[5], w[6], w[7]};
            continue; }
        {
            const float* src = nullptr; int ld = 0, col = 0;
            if (r < 32) { src = we_r; ld = 64; col = r; } else if (r >= 128 && r < 160) { src = we_r; ld = 64; col = 32 + (r - 128); } else if (r >= 32 && r < 40) { src = wg_r; ld = 8; col = r - 32; }
            unsigned w[8];
#pragma unroll
            for (int j = 0; j < 8; ++j) { const int k = F.lane * 16 + 2 * j; float v0 = 0.f, v1 = 0.f; if (src) { v0 = src[(size_t)k * ld + col] * ln2_g[k]; v1 = src[(size_t)(k + 1) * ld + col] * ln2_g[k + 1]; } w[j] = pk2(v0, v1); }
            u32x4* dp = (u32x4*)(WrT + (size_t)r * DM + F.lane * 16);
            dp[0] = (u32x4){w[0], w[1], w[2], w[3]}; dp[1] = (u32x4){w[4], w[5], w[6], w[7]};
        }
    }
#endif
#ifndef P0_NOROWS
    {
    const f32x4* gr = (const f32x4*)ln1_g + F.lane;
    f32x4 nx[4], ny[4];
    if (gw < NT) { const f32x4* xr = (const f32x4*)(x + (size_t)gw * DM) + F.lane;
#pragma unroll
        for (int j = 0; j < 4; ++j) nx[j] = xr[64 * j]; }
    if (gw + NGW < NT) { const f32x4* xr = (const f32x4*)(x + (size_t)(gw + NGW) * DM) + F.lane;
#pragma unroll
        for (int j = 0; j < 4; ++j) ny[j] = xr[64 * j]; }
    for (int rep = 0; rep < P0_REP_ROWS; ++rep)
    for (int m = gw; m < NT; m += NGW) {
        f32x4 v[4]; float s = 0.f;
#pragma unroll
        for (int j = 0; j < 4; ++j) { v[j] = nx[j]; s += (v[j].x * v[j].x + v[j].y * v[j].y) + (v[j].z * v[j].z + v[j].w * v[j].w); }
#pragma unroll
        for (int j = 0; j < 4; ++j) nx[j] = ny[j];
        if (m + 2 * NGW < NT) { const f32x4* xr = (const f32x4*)(x + (size_t)(m + 2 * NGW) * DM) + F.lane;
#pragma unroll
            for (int j = 0; j < 4; ++j) ny[j] = xr[64 * j]; }
        const float rstd = rsqrtf(wave_sum(s) * (1.f / DM) + EPS);
        unsigned long long* o8 = (unsigned long long*)(XN + (size_t)m * DM) + F.lane;
#pragma unroll
        for (int j = 0; j < 4; ++j) { v[j] = v[j] * rstd * gr[64 * j];
            o8[64 * j] = (unsigned long long)cvt_pk_bf16(v[j].x, v[j].y) | ((unsigned long long)cvt_pk_bf16(v[j].z, v[j].w) << 32); }
    }
    }
#endif
}

constexpr int TB_PRE = 0  , TB_UT = 512  , TB_PT = 1024  , TB_T = 2048  ;
__device__ __forceinline__ void moe_prefixes(const Frame& F) {
    const unsigned* cnt = (const unsigned*)(F.ws + WS_CTL) + CW_CNT; const unsigned* pcnt = (const unsigned*)(F.ws + WS_CTL) + CW_PCNT;
    LAS int* pre = (LAS int*)(F.lds + TAB_OFF + TB_PRE); LAS int* pt = (LAS int*)(F.lds + TAB_OFF + TB_PT);
    if (F.tid < 64) pre[F.tid] = (int)((__hip_atomic_load(cnt + F.tid, RLX_AGENT) + 255u) >> 8);
    else if (F.tid >= 128 && F.tid < 128 + 224) pt[F.tid - 128] = (int)((__hip_atomic_load(pcnt + (F.tid - 128), RLX_AGENT) + 255u) >> 8);
    __syncthreads();
    if (F.tid == 0) { int s = 0; for (int e = 0; e < 64; ++e) { const int t = pre[e]; pre[e] = s; s += t; } pre[64] = s; }
    if (F.tid == 64) { int s = 0; for (int q = 0; q < 224; ++q) { const int t = pt[q]; pt[q] = s; s += t; } pt[224] = s; }
    __syncthreads();
}
__device__ __forceinline__ int moe_setup1(const Frame& F) {
    const unsigned* cnt = (const unsigned*)(F.ws + WS_CTL) + CW_CNT;
    LAS int* pre = (LAS int*)(F.lds + TAB_OFF + TB_PRE); LAS int* pt = (LAS int*)(F.lds + TAB_OFF + TB_PT); LAS int* ut = (LAS int*)(F.lds + TAB_OFF + TB_UT);
    LAS unsigned* t0 = (LAS unsigned*)(F.lds + TAB_OFF + TB_T); LAS float* t1 = (LAS float*)(t0 + 6 * 256); LAS unsigned* t2 = t0 + 12 * 256; LAS float* t3 = (LAS float*)(t0 + 18 * 256);
    const int* bidx = (const int*)(F.ws + WS_BIDX); const float* rstd2 = (const float*)(F.ws + WS_RSTD2); const float* tokg = (const float*)(F.ws + WS_TOKG); const int* tokp = (const int*)(F.ws + WS_TOKP);
    unsigned* r2t = (unsigned*)(F.ws + WS_R2T);
    moe_prefixes(F);
    for (int tok = F.vcu * NTHR + F.tid; tok < NT; tok += F.G * NTHR) { const int tp = tokp[tok]; r2t[256 * pt[(tp >> 16) & 0xff] + (tp & 0xffff)] = (unsigned)tok + 1u; }
    const int total = pre[64] * 2;
    int n = 0; for (int i = 0; i < 6; ++i) if ((long)i * F.G + F.vcu < total) n = i + 1;
    if (F.tid < n) { const int L = F.tid * F.G + F.vcu; const int rtg = L >> 1, pn = L & 1; int e = 0; for (int q = 0; q < 64; ++q) if (pre[q + 1] <= rtg) e = q + 1;
        ut[8 * F.tid] = rtg; ut[8 * F.tid + 1] = pn; ut[8 * F.tid + 2] = e; ut[8 * F.tid + 3] = F.tid; ut[8 * F.tid + 4] = e; }
    __syncthreads();
    { int ts3[3]; bool val3[3]; int tp3[3]; float rs3[3], g3[3];
#pragma unroll
      for (int k = 0; k < 3; ++k) { const int x = F.tid + NTHR * k; ts3[k] = 0; val3[k] = false;
          if (x < n * 256) { const int i = x >> 8, r = x & 255, rtg = ut[8 * i], e = ut[8 * i + 2]; const int idx = (rtg - pre[e]) * 256 + r; const int c = (int)__hip_atomic_load(cnt + e, RLX_AGENT);
              val3[k] = idx < c; ts3[k] = bidx[(size_t)e * 65536 + (val3[k] ? idx : 0)]; } }
#pragma unroll
      for (int k = 0; k < 3; ++k) { const int tok = ts3[k] & 0xffff, slot = ts3[k] >> 16; tp3[k] = tokp[tok]; rs3[k] = rstd2[tok]; g3[k] = tokg[tok * 2 + slot]; }
#pragma unroll
      for (int k = 0; k < 3; ++k) { const int x = F.tid + NTHR * k;
          if (x < n * 256) { const int tok = ts3[k] & 0xffff, slot = ts3[k] >> 16, tp = tp3[k];
              t0[x] = (unsigned)tok * (unsigned)(DM * 2); t1[x] = val3[k] ? rs3[k] : 0.f;
              t2[x] = val3[k] ? (unsigned)(256 * pt[(tp >> 16) & 0xff] + (tp & 0xffff)) * 1024u + (slot == ((tp >> 24) & 1) ? 0u : 512u) : 0xffffffffu;
              t3[x] = g3[k]; } } }
    __syncthreads();
    return n;
}
__device__ __forceinline__ int moe_setup2(const Frame& F) {
    LAS int* pt = (LAS int*)(F.lds + TAB_OFF + TB_PT); LAS int* ut = (LAS int*)(F.lds + TAB_OFF + TB_UT); LAS unsigned* t0 = (LAS unsigned*)(F.lds + TAB_OFF + TB_T);
    const unsigned* r2t = (const unsigned*)(F.ws + WS_R2T);
    moe_prefixes(F);
    const int total = pt[224] * 4;
    int n = 0; for (int i = 0; i < 8; ++i) if ((long)i * F.G + F.vcu < total) n = i + 1;
    if (F.tid < n) { const int L = F.tid * F.G + F.vcu; const int rtg = L >> 2, pn = L & 3; int pb = 0; for (int q = 0; q < 224; ++q) if (pt[q + 1] <= rtg) pb = q + 1;
        const int gs = pb / 28, pi = pb - 28 * gs; int lo = 0; for (int l = 0; l < 7; ++l) if (pi >= (l * (15 - l)) / 2) lo = l; const int hi = lo + 1 + pi - (lo * (15 - lo)) / 2;
        ut[8 * F.tid] = rtg; ut[8 * F.tid + 1] = pn; ut[8 * F.tid + 2] = gs * 8 + lo; ut[8 * F.tid + 3] = F.tid; ut[8 * F.tid + 4] = gs * 8 + hi; }
    __syncthreads();
    { unsigned v4[4];
#pragma unroll
      for (int k = 0; k < 4; ++k) { const int x = F.tid + NTHR * k; v4[k] = 0u; if (x < n * 256) v4[k] = r2t[(size_t)ut[8 * (x >> 8)] * 256 + (x & 255)]; }
#pragma unroll
      for (int k = 0; k < 4; ++k) { const int x = F.tid + NTHR * k; if (x < n * 256) t0[x] = v4[k]; } }
    __syncthreads();
    return n;
}

typedef short v4i16_t __attribute__((ext_vector_type(4)));
constexpr int NA_SLOT = 16384, NA_NSLOT = 9, NA_MRG = NA_NSLOT * NA_SLOT, NA_MRGL = NA_MRG + 8192, NA_BT = NA_MRGL + 1024;
__device__ __forceinline__ int na_swz(int key) { return ((key >> 1) & 3) << 1; }
__device__ __forceinline__ void na_stage_row(const Frame& F, const bf16* pbh, int bandrow) {
    const int key = 8 * F.wave + (F.lane >> 3), c = (F.lane & 7) ^ na_swz(key);
    const bf16* src = pbh + (size_t)(bandrow * GW + key) * PC + c * 8;
    LAS unsigned char* dst = F.lds + (bandrow % NA_NSLOT) * NA_SLOT + F.wave * 1024;
    __builtin_amdgcn_global_load_lds((const unsigned*)(src + C_AK), (LAS unsigned*)dst, 16, 0, 0);
    __builtin_amdgcn_global_load_lds((const unsigned*)(src + C_AV), (LAS unsigned*)(dst + 8192), 16, 0, 0);
}
__device__ __forceinline__ void phase_na(const Frame& F, const Args& a) {
    const bf16* PROJ = (const bf16*)(F.ws + WS_PROJ); bf16* MIX = (bf16*)(F.ws + WS_MIX); const float* rpb = a.in[5];
    const int j = F.wave & 3, bh = F.wave >> 2, g = F.lane >> 4, li = F.lane & 15, c = 16 * j + li;
    const int ks0 = j == 0 ? 0 : (j == 1 ? 8 : (j == 2 ? 24 : 32));
    int c0 = c - KW / 2; c0 = c0 < 0 ? 0 : (c0 > GW - KW ? GW - KW : c0);
    LAS float* bt = (LAS float*)(F.lds + NA_BT);
    for (int unit = F.vcu; unit < BATCH * AH * 2; unit += F.G) {
        const int b = unit >> 4, h = (unit >> 1) & 7, rs = (unit & 1) * 32;
        const bf16* pbh = PROJ + (size_t)b * SEQ * PC + h * ADH;
        float mq = fabsf(a.in[3][F.lane]), mk = fabsf(a.in[4][F.lane]);
#pragma unroll
        for (int o = 1; o < 64; o <<= 1) { mq = fmaxf(mq, __shfl_xor(mq, o)); mk = fmaxf(mk, __shfl_xor(mk, o)); }
        float mb = 0.f; for (int i = F.lane; i < 15 * 31; i += 64) mb = fmaxf(mb, fabsf(rpb[h * 465 + i]));
#pragma unroll
        for (int o = 1; o < 64; o <<= 1) mb = fmaxf(mb, __shfl_xor(mb, o));
        const float cshift = 64.f * 0.125f * LOG2E * mq * mk + mb * LOG2E;
        __syncthreads();
        for (int i = F.tid; i < 15 * 31; i += NTHR) bt[i] = rpb[h * 465 + i] * LOG2E - cshift;
        int r0 = rs - KH / 2; r0 = r0 < 0 ? 0 : (r0 > ROWS - KH ? ROWS - KH : r0);
        for (int i = 0; i < KH; ++i) na_stage_row(F, pbh, r0 + i);
        VM_WAIT(); __syncthreads();
        const int pkey = 8 * F.wave + (F.lane >> 3), pch = (F.lane & 7) ^ na_swz(pkey);
        auto r0_of = [](int r) { int v = r - KH / 2; return v < 0 ? 0 : (v > ROWS - KH ? ROWS - KH : v); };
        u32x4 pk = {0u, 0u, 0u, 0u}, pv = {0u, 0u, 0u, 0u};
        if (rs + 1 < rs + 32 && r0_of(rs + 1) != r0_of(rs)) { const bf16* src = pbh + (size_t)((r0_of(rs + 1) + KH - 1) * GW + pkey) * PC + pch * 8; pk = *(const u32x4*)(src + C_AK); pv = *(const u32x4*)(src + C_AV); }
        float bias[8][4]; int prev_ro = -100;
        bf16x8 qn[2];
#pragma unroll
        for (int ks = 0; ks < 2; ++ks) qn[ks] = *(const bf16x8*)(PROJ + ((size_t)b * SEQ + rs * GW + c) * PC + C_AQ + h * ADH + 32 * ks + 8 * g);
        for (int r = rs; r < rs + 32; ++r) {
            r0 = r - KH / 2; r0 = r0 < 0 ? 0 : (r0 > ROWS - KH ? ROWS - KH : r0);
            if (r + 1 < rs + 32 && r0_of(r + 1) != r0) { LAS unsigned char* dst = F.lds + ((r0_of(r + 1) + KH - 1) % NA_NSLOT) * NA_SLOT + F.wave * 1024 + F.lane * 16;
                *(LAS u32x4*)dst = pk; *(LAS u32x4*)(dst + 8192) = pv; }
            if (r + 2 < rs + 32 && r0_of(r + 2) != r0_of(r + 1)) { const bf16* src = pbh + (size_t)((r0_of(r + 2) + KH - 1) * GW + pkey) * PC + pch * 8; pk = *(const u32x4*)(src + C_AK); pv = *(const u32x4*)(src + C_AV); }
            const int ro = r0 - r + (KH - 1) + 4 * bh;
            if (ro != prev_ro) { prev_ro = ro;
#pragma unroll
                for (int i4 = 0; i4 < 4; ++i4)
#pragma unroll
                    for (int t = 0; t < 2; ++t)
#pragma unroll
                        for (int q = 0; q < 4; ++q) { const int kc = ks0 + 16 * t + 4 * g + q; const bool valid = kc >= c0 && kc < c0 + KW;
                            bias[i4 * 2 + t][q] = valid ? bt[(ro + i4) * 31 + (kc - c + KW - 1)] : -1.0e30f; } }
            const size_t qtok = (size_t)b * SEQ + r * GW + c;
            bf16x8 qf[2]; qf[0] = qn[0]; qf[1] = qn[1];
            { const size_t ntok = qtok + (r + 1 < rs + 32 ? GW : 0);
#pragma unroll
              for (int ks = 0; ks < 2; ++ks) qn[ks] = *(const bf16x8*)(PROJ + ntok * PC + C_AQ + h * ADH + 32 * ks + 8 * g); }
            f32x4 sacc[8];
#pragma unroll
            for (int i4 = 0; i4 < 4; ++i4) { const LAS unsigned char* ks_ = F.lds + ((r0 + 4 * bh + i4) % NA_NSLOT) * NA_SLOT;
#pragma unroll
                for (int t = 0; t < 2; ++t) { const int row = ks0 + 16 * t + li; f32x4 acc = {bias[i4 * 2 + t][0], bias[i4 * 2 + t][1], bias[i4 * 2 + t][2], bias[i4 * 2 + t][3]};
#pragma unroll
                    for (int ks = 0; ks < 2; ++ks) { const bf16x8 kf = *(const LAS bf16x8*)(ks_ + row * 128 + (((g + 4 * ks) ^ na_swz(row)) << 4));
                        acc = __builtin_amdgcn_mfma_f32_16x16x32_bf16(kf, qf[ks], acc, 0, 0, 0); }
                    sacc[i4 * 2 + t] = acc; } }
            f32x2_t ls2 = {0.f, 0.f};
#pragma unroll
            for (int x = 0; x < 8; ++x) {
#pragma unroll
                for (int q = 0; q < 4; ++q) sacc[x][q] = __builtin_amdgcn_exp2f(sacc[x][q]);
                ls2 += (f32x2_t){sacc[x][0], sacc[x][1]}; ls2 += (f32x2_t){sacc[x][2], sacc[x][3]}; }
            float lsum = ls2[0] + ls2[1];
            f32x4 oacc[4];
#pragma unroll
            for (int dt = 0; dt < 4; ++dt) oacc[dt] = (f32x4){0.f, 0.f, 0.f, 0.f};
#pragma unroll
            for (int m = 0; m < 4; ++m) {
                const int xa = 2 * m, xb = 2 * m + 1;
                bf16x8 pf; { const unsigned w0 = cvt_pk_bf16(sacc[xa][0], sacc[xa][1]), w1 = cvt_pk_bf16(sacc[xa][2], sacc[xa][3]), w2 = cvt_pk_bf16(sacc[xb][0], sacc[xb][1]), w3 = cvt_pk_bf16(sacc[xb][2], sacc[xb][3]);
                    pf = __builtin_bit_cast(bf16x8, (u32x4){w0, w1, w2, w3}); }
                const LAS unsigned char* va = F.lds + ((r0 + 4 * bh + m) % NA_NSLOT) * NA_SLOT + 8192; const LAS unsigned char* vb = va;
                const int rowa = ks0 + 4 * g + (li >> 2), rowb = ks0 + 16 + 4 * g + (li >> 2);
#pragma unroll
                for (int dt = 0; dt < 4; ++dt) { const int cc = 2 * dt + ((li & 3) >> 1), hb = (li & 1) * 8;
                    const v4i16_t ta = __builtin_amdgcn_ds_read_tr16_b64_v4i16((LAS v4i16_t*)(va + rowa * 128 + ((cc ^ na_swz(rowa)) << 4) + hb));
                    const v4i16_t tb = __builtin_amdgcn_ds_read_tr16_b64_v4i16((LAS v4i16_t*)(vb + rowb * 128 + ((cc ^ na_swz(rowb)) << 4) + hb));
                    bf16x8 vf; vf[0] = ta[0]; vf[1] = ta[1]; vf[2] = ta[2]; vf[3] = ta[3]; vf[4] = tb[0]; vf[5] = tb[1]; vf[6] = tb[2]; vf[7] = tb[3];
                    oacc[dt] = __builtin_amdgcn_mfma_f32_16x16x32_bf16(vf, pf, oacc[dt], 0, 0, 0); }
            }
            LAS unsigned char* mrg = F.lds + NA_MRG + (j * 64 + F.lane) * 32; LAS float* mrl = (LAS float*)(F.lds + NA_MRGL) + j * 64 + F.lane;
            if (bh == 1) {
                u32x4 w0, w1; w0.x = cvt_pk_bf16(oacc[0][0], oacc[0][1]); w0.y = cvt_pk_bf16(oacc[0][2], oacc[0][3]); w0.z = cvt_pk_bf16(oacc[1][0], oacc[1][1]); w0.w = cvt_pk_bf16(oacc[1][2], oacc[1][3]);
                w1.x = cvt_pk_bf16(oacc[2][0], oacc[2][1]); w1.y = cvt_pk_bf16(oacc[2][2], oacc[2][3]); w1.z = cvt_pk_bf16(oacc[3][0], oacc[3][1]); w1.w = cvt_pk_bf16(oacc[3][2], oacc[3][3]);
                *(LAS u32x4*)mrg = w0; *(LAS u32x4*)(mrg + 16) = w1; *mrl = lsum;
            }
            LDS_BAR();
            if (bh == 0) {
                const u32x4 w0 = *(const LAS u32x4*)mrg, w1 = *(const LAS u32x4*)(mrg + 16); lsum += *mrl;
                lsum += __shfl_xor(lsum, 16); lsum += __shfl_xor(lsum, 32);
                const float inv = 1.f / lsum;
                bf16* op = MIX + qtok * DM + h * ADH + 4 * g;
#pragma unroll
                for (int dt = 0; dt < 4; ++dt) { const unsigned pa = dt < 2 ? (dt == 0 ? w0.x : w0.z) : (dt == 2 ? w1.x : w1.z), pb = dt < 2 ? (dt == 0 ? w0.y : w0.w) : (dt == 2 ? w1.y : w1.w);
                    const float o0 = (oacc[dt][0] + __builtin_bit_cast(float, pa << 16)) * inv, o1 = (oacc[dt][1] + __builtin_bit_cast(float, pa & 0xffff0000u)) * inv;
                    const float o2 = (oacc[dt][2] + __builtin_bit_cast(float, pb << 16)) * inv, o3 = (oacc[dt][3] + __builtin_bit_cast(float, pb & 0xffff0000u)) * inv;
                    *(unsigned long long*)(op + 16 * dt) = (unsigned long long)cvt_pk_bf16(o0, o1) | ((unsigned long long)cvt_pk_bf16(o2, o3) << 32); }
            }
            LDS_BAR();
        }
    }
}


typedef float f32x16 __attribute__((ext_vector_type(16)));
constexpr size_t WS_GCL = WS_G, WS_BETAL = WS_BETA;
constexpr int P3_QN = 0, P3_KN = 16384, P3_LF = 32768, P3_LB = P3_LF + 17408, P3_TF = P3_LB + 17408, P3_TB = P3_TF + 17408, P3_CW = P3_TB + 17408, P3_SC = P3_CW + 7680, P3_RAW = P3_SC + 1024, LST = 68;
__device__ __forceinline__ unsigned off_b(unsigned row, unsigned ch) { return 256u * row + 16u * (ch ^ (((row & 3) << 2) | ((row >> 2) & 3))); }
__device__ __forceinline__ unsigned rowread_b(unsigned lane, unsigned rowbase, unsigned s) { return off_b(rowbase + (lane & 31), 2 * s + (lane >> 5)); }
__device__ __forceinline__ void dn_inverse(LAS float* LS, LAS float* TS, int lane) {
    for (int i = lane; i < 64 * LST / 4; i += 64) ((LAS f32x4*)TS)[i] = (f32x4){0.f, 0.f, 0.f, 0.f};
    { const int blk = lane >> 4, col = lane & 15; float xa[16];
#pragma unroll
      for (int i = 0; i < 16; ++i) xa[i] = (i == col) ? 1.f : 0.f;
#pragma unroll
      for (int k = 0; k < 16; ++k) { const float xk = xa[k]; TS[(16 * blk + k) * LST + 16 * blk + col] = xk;
#pragma unroll
          for (int i = k + 1; i < 16; ++i) xa[i] -= LS[(16 * blk + i) * LST + 16 * blk + k] * xk; } }
    __builtin_amdgcn_sched_barrier(0);
#pragma unroll
    for (int p = 0; p < 2; ++p) { const int base = 32 * p, r = lane & 15, kq = lane >> 4;
        float a1[4], b1[4];
#pragma unroll
        for (int s4 = 0; s4 < 4; ++s4) { a1[s4] = LS[(base + 16 + r) * LST + base + kq + 4 * s4]; b1[s4] = TS[(base + kq + 4 * s4) * LST + base + r]; }
        const f32x4 a2 = *(const LAS f32x4*)(TS + (base + 16 + r) * LST + base + 16 + 4 * kq);
        __builtin_amdgcn_sched_barrier(0);
        f32x4 M = {0.f, 0.f, 0.f, 0.f};
#pragma unroll
        for (int s4 = 0; s4 < 4; ++s4) M = __builtin_amdgcn_mfma_f32_16x16x4f32(a1[s4], b1[s4], M, 0, 0, 0);
        f32x4 R = {0.f, 0.f, 0.f, 0.f};
#pragma unroll
        for (int s4 = 0; s4 < 4; ++s4) R = __builtin_amdgcn_mfma_f32_16x16x4f32(a2[s4], M[s4], R, 0, 0, 0);
#pragma unroll
        for (int e = 0; e < 4; ++e) TS[(base + 16 + 4 * kq + e) * LST + base + r] = -R[e]; }
    __builtin_amdgcn_sched_barrier(0);
    { const int r = lane & 31, kh = lane >> 5;
      bf16x8 a1[2], b1[2], a2[2];
#pragma unroll
      for (int sx = 0; sx < 2; ++sx) {
          const f32x4 l0 = *(const LAS f32x4*)(LS + (32 + r) * LST + 16 * sx + 8 * kh), l1 = *(const LAS f32x4*)(LS + (32 + r) * LST + 16 * sx + 8 * kh + 4);
          a1[sx] = __builtin_bit_cast(bf16x8, (u32x4){cvt_pk_bf16(l0[0], l0[1]), cvt_pk_bf16(l0[2], l0[3]), cvt_pk_bf16(l1[0], l1[1]), cvt_pk_bf16(l1[2], l1[3])});
          float tb[8];
#pragma unroll
          for (int j = 0; j < 8; ++j) tb[j] = TS[(16 * sx + 8 * kh + j) * LST + r];
          b1[sx] = __builtin_bit_cast(bf16x8, (u32x4){cvt_pk_bf16(tb[0], tb[1]), cvt_pk_bf16(tb[2], tb[3]), cvt_pk_bf16(tb[4], tb[5]), cvt_pk_bf16(tb[6], tb[7])});
          const f32x4 t0 = *(const LAS f32x4*)(TS + (32 + r) * LST + 32 + 16 * sx + 4 * kh), t1 = *(const LAS f32x4*)(TS + (32 + r) * LST + 32 + 16 * sx + 8 + 4 * kh);
          a2[sx] = __builtin_bit_cast(bf16x8, (u32x4){cvt_pk_bf16(t0[0], t0[1]), cvt_pk_bf16(t0[2], t0[3]), cvt_pk_bf16(t1[0], t1[1]), cvt_pk_bf16(t1[2], t1[3])}); }
      __builtin_amdgcn_sched_barrier(0);
      f32x16 M;
#pragma unroll
      for (int e = 0; e < 16; ++e) M[e] = 0.f;
#pragma unroll
      for (int sx = 0; sx < 2; ++sx) M = __builtin_amdgcn_mfma_f32_32x32x16_bf16(a1[sx], b1[sx], M, 0, 0, 0);
      f32x16 R;
#pragma unroll
      for (int e = 0; e < 16; ++e) R[e] = 0.f;
#pragma unroll
      for (int sx = 0; sx < 2; ++sx) { const bf16x8 mb = __builtin_bit_cast(bf16x8, (u32x4){cvt_pk_bf16(M[8 * sx], M[8 * sx + 1]), cvt_pk_bf16(M[8 * sx + 2], M[8 * sx + 3]), cvt_pk_bf16(M[8 * sx + 4], M[8 * sx + 5]), cvt_pk_bf16(M[8 * sx + 6], M[8 * sx + 7])});
          R = __builtin_amdgcn_mfma_f32_32x32x16_bf16(a2[sx], mb, R, 0, 0, 0); }
#pragma unroll
      for (int e = 0; e < 16; ++e) TS[(32 + (e & 3) + 8 * (e >> 2) + 4 * kh) * LST + r] = -R[e]; }
}
__device__ __forceinline__ void phase_dnprep(const Frame& F, const Args& a) {
    const bf16* PROJ = (const bf16*)(F.ws + WS_PROJ); bf16* QKVN = (bf16*)a.out; bf16* TQK = (bf16*)(F.ws + WS_TQK);
    const float* DABp = (const float*)(F.ws + WS_DAB); const float* a_log = a.in[8]; const float* dt_bias = a.in[9]; float* GCL = (float*)(F.ws + WS_GCL); float* BETAL = (float*)(F.ws + WS_BETAL);
    const float* conv_w = a.in[7];
    LAS float* CW = (LAS float*)(F.lds + P3_CW); LAS float* SC = (LAS float*)(F.lds + P3_SC);
    LAS float* LFp = (LAS float*)(F.lds + P3_LF); LAS float* LBp = (LAS float*)(F.lds + P3_LB); LAS float* TFp = (LAS float*)(F.lds + P3_TF); LAS float* TBp = (LAS float*)(F.lds + P3_TB);
    const int hh = F.lane >> 5;
    static_assert(P3_RAW + 68 * 768 <= LDSCTL_OFF, "P3 LDS map");
    const bf16* zsrc = (const bf16*)(F.ws + WS_CTL + 900 * 1024);
    auto stage_raw = [&](int un) { const int tc_ = un & 63, h_ = (un >> 6) & 3, b_ = un >> 8, t0_ = tc_ * 64;
        for (int p = F.wave; p < 51; p += 8) { const int c = 64 * p + F.lane, row = c / 48, cc = c - 48 * row, tt = t0_ - 2 + row;
            const bf16* src = (tt >= 0 && tt < SEQ) ? PROJ + ((size_t)b_ * SEQ + tt) * PC + C_DQ + (cc >> 4) * 512 + h_ * 128 + (cc & 15) * 8 : zsrc;
            __builtin_amdgcn_global_load_lds((const unsigned*)src, (LAS unsigned*)(F.lds + P3_RAW + p * 1024), 16, 0, 0); } };
    const int unit0 = F.vcu * 16, unit_end = (unit0 + 16 < BATCH * DH * 64) ? unit0 + 16 : BATCH * DH * 64;
    if (unit0 >= unit_end) return;
    { const int h = (unit0 >> 6) & 3;
      for (int i = F.tid; i < 3 * 5 * 128; i += NTHR) { const int part = i / 640, tap = (i / 128) % 5, ch = i & 127; CW[i] = conv_w[tap * 1536 + part * 512 + h * 128 + ch]; } }
    stage_raw(unit0);
    auto gate_sc = [&](int un, float pa, float pb) { const int dir = F.wave - 2, h_ = (un >> 6) & 3, b_ = un >> 8, t0_ = (un & 63) * 64; const size_t go = (((size_t)dir * BATCH + b_) * DH + h_) * SEQ;
        float gv = -__expf(a_log[dir * 4 + h_]) * softplus_f(pa + dt_bias[dir * 4 + h_]); const float bv = sigmoid_f(pb);
#pragma unroll
        for (int o = 1; o < 64; o <<= 1) { const float t = __shfl_up(gv, o); if (F.lane >= o) gv += t; }
        SC[dir * 64 + F.lane] = gv; SC[128 + dir * 64 + F.lane] = bv; GCL[go + t0_ + F.lane] = gv; BETAL[go + t0_ + F.lane] = bv; };
    if (F.wave == 2 || F.wave == 3) { const int dir = F.wave - 2, tl = dir ? 63 - F.lane : F.lane, h_ = (unit0 >> 6) & 3;
        const float* dp = DABp + ((size_t)(unit0 >> 8) * SEQ + (unit0 & 63) * 64 + tl) * 16 + dir * 4 + h_; gate_sc(unit0, dp[0], dp[8]); }
    for (int unit = unit0; unit < unit_end; ++unit) {
        const int tc = unit & 63, h = (unit >> 6) & 3, b = unit >> 8, t0 = tc * 64; const size_t tokb = (size_t)b * SEQ + t0;
        if (unit == unit0) VM_WAIT(); else asm volatile("s_waitcnt vmcnt(4)" ::: "memory");
        LDS_BAR();
        { const int tl2 = F.lane >> 4, cg = F.lane & 15, tk = 8 * F.wave + 2 * tl2;
#ifndef P3_REP_CONV
#define P3_REP_CONV 1
#endif
#pragma unroll 1
          for (int part_ = 0; part_ < 3 * P3_REP_CONV; ++part_) { const int part = part_ % 3;
              u32x4 rawp[6];
#pragma unroll
              for (int rr = 0; rr < 6; ++rr) rawp[rr] = *(const LAS u32x4*)(F.lds + P3_RAW + (tk + rr) * 768 + part * 256 + cg * 16);
              float o[2][8];
#pragma unroll
              for (int e2 = 0; e2 < 4; ++e2) {
                  float lo[6], hi[6];
#pragma unroll
                  for (int rr = 0; rr < 6; ++rr) { lo[rr] = __builtin_bit_cast(float, rawp[rr][e2] << 16); hi[rr] = __builtin_bit_cast(float, rawp[rr][e2] & 0xffff0000u); }
                  float a0 = 0.f, a1 = 0.f, b0 = 0.f, b1 = 0.f;
#pragma unroll
                  for (int tap = 0; tap < 5; ++tap) { const f32x2_t w01 = *(const LAS f32x2_t*)(CW + (part * 5 + tap) * 128 + 8 * cg + 2 * e2); const float w0 = w01[0], w1 = w01[1];
                      a0 += lo[tap] * w0; a1 += hi[tap] * w1; b0 += lo[tap + 1] * w0; b1 += hi[tap + 1] * w1; }
                  o[0][2 * e2] = a0; o[0][2 * e2 + 1] = a1; o[1][2 * e2] = b0; o[1][2 * e2 + 1] = b1;
                  __builtin_amdgcn_sched_barrier(0); }
#pragma unroll
              for (int u = 0; u < 2; ++u) { float ss = 0.f;
#pragma unroll
                  for (int e = 0; e < 8; ++e) { const float x = o[u][e]; const float y = x * __builtin_amdgcn_rcpf(1.f + __expf(-x)); o[u][e] = y; ss += y * y; }
                  if (part < 2) { ss = row16_sum(ss);
                      const float sc = rsqrtf(ss + EPS) * (part == 0 ? 0.08838834764831845f : 1.f);
#pragma unroll
                      for (int e = 0; e < 8; ++e) o[u][e] *= sc; }
                  u32x4 w; w.x = cvt_pk_bf16(o[u][0], o[u][1]); w.y = cvt_pk_bf16(o[u][2], o[u][3]); w.z = cvt_pk_bf16(o[u][4], o[u][5]); w.w = cvt_pk_bf16(o[u][6], o[u][7]);
                  *(u32x4*)(QKVN + ((size_t)((b * 4 + h) * 3 + part) * SEQ + t0 + tk + u) * 128 + 8 * cg) = w;
                  if (part < 2) *(LAS u32x4*)(F.lds + (part == 0 ? P3_QN : P3_KN) + off_b(tk + u, cg)) = w; }
          } }
        LDS_BAR();
        if (unit + 1 < unit_end) stage_raw(unit + 1);
        { const int mat = F.wave >> 2, ti = (F.wave >> 1) & 1, tj = F.wave & 1;
          f32x16 acc;
#pragma unroll
          for (int e = 0; e < 16; ++e) acc[e] = 0.f;
#pragma unroll
          for (int s8 = 0; s8 < 8; ++s8) { const bf16x8 af = *(const LAS bf16x8*)(F.lds + (mat ? P3_QN : P3_KN) + rowread_b(F.lane, 32 * ti, s8)), bfr = *(const LAS bf16x8*)(F.lds + P3_KN + rowread_b(F.lane, 32 * tj, s8));
              acc = __builtin_amdgcn_mfma_f32_32x32x16_bf16(af, bfr, acc, 0, 0, 0); }
          LAS float* dstp = (mat ? TBp : TFp) + 32 * tj + (F.lane & 31);
#pragma unroll
          for (int e = 0; e < 16; ++e) dstp[(32 * ti + (e & 3) + 8 * (e >> 2) + 4 * hh) * LST] = acc[e]; }
        LDS_BAR();
        if (unit + 1 < unit_end && (F.wave == 2 || F.wave == 3)) {
            const int un = unit + 1, dir = F.wave - 2, tl = dir ? 63 - F.lane : F.lane; const float* dp = DABp + ((size_t)(un >> 8) * SEQ + (un & 63) * 64 + tl) * 16 + dir * 4 + ((un >> 6) & 3);
            __builtin_amdgcn_global_load_lds((const unsigned*)dp, (LAS unsigned*)(F.lds + P3_KN + dir * 512), 4, 0, 0); __builtin_amdgcn_global_load_lds((const unsigned*)(dp + 8), (LAS unsigned*)(F.lds + P3_KN + dir * 512 + 256), 4, 0, 0); }
        { LAS bf16* qkf = (LAS bf16*)(F.lds + P3_QN); LAS bf16* qkb = (LAS bf16*)(F.lds + P3_QN + 8192);
          const int jn = F.tid & 63, jr = 63 - jn; const float gfj = SC[jn], gbj = SC[64 + jr];
#ifndef P3_REP_EW
#define P3_REP_EW 1
#endif
          for (int rep = 0; rep < P3_REP_EW; ++rep)
#pragma unroll 2
          for (int i = F.tid >> 6; i < 64; i += 8) { const int ir = 63 - i; const float gv = TFp[i * LST + jn], pv = TBp[i * LST + jn];
              const float df = __expf(SC[i] - gfj), db = __expf(SC[64 + ir] - gbj);
              if (i > jn) LFp[i * LST + jn] = SC[128 + i] * gv * df;
              if (i < jn) LBp[ir * LST + jr] = SC[192 + ir] * gv * db;
              qkf[i * 64 + jn] = f2bf(i >= jn ? pv * df : 0.f); qkb[ir * 64 + jr] = f2bf(i <= jn ? pv * db : 0.f); } }
        LDS_BAR();
#ifndef P3_REP_INV
#define P3_REP_INV 1
#endif
        for (int rep = 0; rep < P3_REP_INV; ++rep) if (F.wave < 2) dn_inverse(F.wave ? LBp : LFp, F.wave ? TBp : TFp, F.lane);
        if (unit + 1 < unit_end && (F.wave == 2 || F.wave == 3)) {
            VM_WAIT(); const LAS float* ab = (const LAS float*)(F.lds + P3_KN + (F.wave - 2) * 512); gate_sc(unit + 1, ab[F.lane], ab[64 + F.lane]); }
        LDS_BAR();
        for (int it = F.tid; it < 1024; it += NTHR) { const int m = it >> 9, i = (it >> 3) & 63, c8 = it & 7; const LAS float* tp = (m ? TBp : TFp) + i * LST + 8 * c8;
            const f32x4 x0 = *(const LAS f32x4*)tp, x1 = *(const LAS f32x4*)(tp + 4);
            u32x4 w; w.x = cvt_pk_bf16(x0[0], x0[1]); w.y = cvt_pk_bf16(x0[2], x0[3]); w.z = cvt_pk_bf16(x1[0], x1[1]); w.w = cvt_pk_bf16(x1[2], x1[3]);
            *(u32x4*)(TQK + ((size_t)unit * 4 + 2 * m) * 4096 + i * 64 + 8 * c8) = w;
            *(u32x4*)(TQK + ((size_t)unit * 4 + 2 * m + 1) * 4096 + i * 64 + 8 * c8) = *(const LAS u32x4*)(F.lds + P3_QN + m * 8192 + i * 128 + c8 * 16); }
    }
}
constexpr int P4_BUF = 57344, P4_KN = 0, P4_QN = 16384, P4_VN = 32768, P4_T = 40960, P4_QK = 49152, P4_ST = 114688, P4_RT = 131072, P4_VNT = 139264, P4_VDT = 147456, P4_SC = 155648;
__device__ __forceinline__ unsigned off_s(unsigned row, unsigned ch) { return 128u * row + (((ch ^ ((row >> 1) & 7u))) << 4); }
__device__ __forceinline__ unsigned rowread_s(unsigned lane, unsigned rowbase, unsigned s) { return off_s(rowbase + (lane & 31), 2 * s + (lane >> 5)); }
__device__ __forceinline__ void p4_stage(const Frame& F, const bf16* QKVN, const bf16* TQK, const float* GCL, const float* BETAL, int b, int h, int dir, int dvh, int n, int buf) {
    const int tc = dir ? 63 - n : n, t0 = tc * 64; const size_t tokb = (size_t)t0, pl0 = (size_t)((b * 4 + h) * 3) * SEQ; const size_t u3 = (size_t)((b * 4 + h) * 64 + tc);
    LAS unsigned char* B = F.lds + buf * P4_BUF; const int L = F.lane, w = F.wave;
    {
#pragma unroll
      for (int k = 0; k < 2; ++k) { const int q = w + 8 * k, row = 4 * q + (L >> 4), pos = L & 15, ch = pos ^ (((row & 3) << 2) | ((row >> 2) & 3)); const size_t tok = tokb + (dir ? 63 - row : row);
          __builtin_amdgcn_global_load_lds((const unsigned*)(QKVN + (pl0 + SEQ + tok) * 128 + ch * 8), (LAS unsigned*)(B + P4_KN + q * 1024), 16, 0, 0);
          __builtin_amdgcn_global_load_lds((const unsigned*)(QKVN + (pl0 + tok) * 128 + ch * 8), (LAS unsigned*)(B + P4_QN + q * 1024), 16, 0, 0); } }
    { const int row = 8 * w + (L >> 3), pos = L & 7, chs = pos ^ ((row >> 1) & 7); const size_t tok = tokb + (dir ? 63 - row : row);
      __builtin_amdgcn_global_load_lds((const unsigned*)(QKVN + (pl0 + 2 * SEQ + tok) * 128 + dvh * 64 + pos * 8), (LAS unsigned*)(B + P4_VN + w * 1024), 16, 0, 0);
      __builtin_amdgcn_global_load_lds((const unsigned*)(TQK + (u3 * 4 + 2 * dir) * 4096 + row * 64 + chs * 8), (LAS unsigned*)(B + P4_T + w * 1024), 16, 0, 0);
      __builtin_amdgcn_global_load_lds((const unsigned*)(TQK + (u3 * 4 + 2 * dir + 1) * 4096 + row * 64 + chs * 8), (LAS unsigned*)(B + P4_QK + w * 1024), 16, 0, 0); }
    if (w == 0) { const size_t go = (((size_t)dir * BATCH + b) * DH + h) * SEQ + t0; LAS unsigned char* sc = F.lds + P4_SC + buf * 512;
        __builtin_amdgcn_global_load_lds((const unsigned*)(GCL + go + L), (LAS unsigned*)sc, 4, 0, 0); __builtin_amdgcn_global_load_lds((const unsigned*)(BETAL + go + L), (LAS unsigned*)(sc + 256), 4, 0, 0); }
}
__device__ __forceinline__ void phase_dnscan(const Frame& F, const Args& a) {
    const bf16* QKVN = (const bf16*)a.out; const bf16* TQK = (const bf16*)(F.ws + WS_TQK); const float* GCL = (const float*)(F.ws + WS_GCL); const float* BETAL = (const float*)(F.ws + WS_BETAL);
    bf16* O = (bf16*)(F.ws + WS_A);
    const int w = F.wave, L = F.lane, hh = L >> 5, l31 = L & 31;
    const int mat = w >> 2, ti = (w >> 1) & 1, tj = w & 1, kt = w >> 1, nt = w & 1;
    for (int unit = F.vcu; unit < BATCH * DH * 4; unit += F.G) {
        const int dvh = unit & 1, dir = (unit >> 1) & 1, h = (unit >> 2) & 3, b = unit >> 4;
        __syncthreads();
        for (int i = F.tid; i < 16384 / 16; i += NTHR) ((LAS u32x4*)(F.lds + P4_ST))[i] = (u32x4){0u, 0u, 0u, 0u};
        p4_stage(F, QKVN, TQK, GCL, BETAL, b, h, dir, dvh, 0, 0);
        f32x16 sacc;
#pragma unroll
        for (int e = 0; e < 16; ++e) sacc[e] = 0.f;
        VM_WAIT(); __syncthreads();
        for (int n = 0; n < 64; ++n) {
            const int cb = n & 1; const LAS unsigned char* B = F.lds + cb * P4_BUF; const LAS float* sc = (const LAS float*)(F.lds + P4_SC + cb * 512);
            if (n + 1 < 64) p4_stage(F, QKVN, TQK, GCL, BETAL, b, h, dir, dvh, n + 1, cb ^ 1);
            f32x16 acc1;
#pragma unroll
            for (int e = 0; e < 16; ++e) acc1[e] = 0.f;
            { bf16x8 fa[8], fb[8];
#pragma unroll
              for (int s8 = 0; s8 < 8; ++s8) { fa[s8] = *(const LAS bf16x8*)(B + (mat ? P4_QN : P4_KN) + rowread_b(L, 32 * ti, s8)); fb[s8] = *(const LAS bf16x8*)(F.lds + P4_ST + rowread_b(L, 32 * tj, s8)); }
              __builtin_amdgcn_sched_barrier(0);
#pragma unroll
              for (int s8 = 0; s8 < 8; ++s8) acc1 = __builtin_amdgcn_mfma_f32_32x32x16_bf16(fa[s8], fb[s8], acc1, 0, 0, 0); }
            const int ncol = 32 * tj + l31; const float gl = sc[63];
            if (mat == 0) {
                bf16 vraw[16];
#pragma unroll
                for (int e = 0; e < 16; ++e) vraw[e] = *(const LAS bf16*)(B + P4_VN + (32 * ti + 8 * (e >> 2) + 4 * hh + (e & 3)) * 128 + ncol * 2);
                __builtin_amdgcn_sched_barrier(0);
#pragma unroll
                for (int rg = 0; rg < 4; ++rg) { float r4[4];
#pragma unroll
                    for (int q = 0; q < 4; ++q) { const int i = 32 * ti + 8 * rg + 4 * hh + q; const float vv = bf2f(vraw[4 * rg + q]);
                        r4[q] = sc[64 + i] * (vv - __expf(sc[i]) * acc1[4 * rg + q]); }
                    *(LAS unsigned long long*)(F.lds + P4_RT + off_s(ncol, 4 * ti + rg) + 8 * hh) = (unsigned long long)cvt_pk_bf16(r4[0], r4[1]) | ((unsigned long long)cvt_pk_bf16(r4[2], r4[3]) << 32); }
            } else {
#pragma unroll
                for (int e = 0; e < 16; ++e) { const int i = 32 * ti + (e & 3) + 8 * (e >> 2) + 4 * hh; acc1[e] *= __expf(sc[i]); }
            }
            LDS_BAR();
            if (mat == 0) {
                f32x16 va;
#pragma unroll
                for (int e = 0; e < 16; ++e) va[e] = 0.f;
                { bf16x8 fa[4], fb[4];
#pragma unroll
                  for (int s4 = 0; s4 < 4; ++s4) { fa[s4] = *(const LAS bf16x8*)(B + P4_T + rowread_s(L, 32 * ti, s4)); fb[s4] = *(const LAS bf16x8*)(F.lds + P4_RT + rowread_s(L, 32 * tj, s4)); }
                  __builtin_amdgcn_sched_barrier(0);
#pragma unroll
                  for (int s4 = 0; s4 < 4; ++s4) va = __builtin_amdgcn_mfma_f32_32x32x16_bf16(fa[s4], fb[s4], va, 0, 0, 0); }
#pragma unroll
                for (int rg = 0; rg < 4; ++rg) { float d4[4];
#pragma unroll
                    for (int q = 0; q < 4; ++q) d4[q] = va[4 * rg + q] * __expf(gl - sc[32 * ti + 8 * rg + 4 * hh + q]);
                    const unsigned o8 = off_s(ncol, 4 * ti + rg) + 8 * hh;
                    *(LAS unsigned long long*)(F.lds + P4_VNT + o8) = (unsigned long long)cvt_pk_bf16(va[4 * rg], va[4 * rg + 1]) | ((unsigned long long)cvt_pk_bf16(va[4 * rg + 2], va[4 * rg + 3]) << 32);
                    *(LAS unsigned long long*)(F.lds + P4_VDT + o8) = (unsigned long long)cvt_pk_bf16(d4[0], d4[1]) | ((unsigned long long)cvt_pk_bf16(d4[2], d4[3]) << 32); }
            }
            LDS_BAR();
            if (mat == 1) {
                { bf16x8 fa[4], fb[4];
#pragma unroll
                  for (int s4 = 0; s4 < 4; ++s4) { fa[s4] = *(const LAS bf16x8*)(B + P4_QK + rowread_s(L, 32 * ti, s4)); fb[s4] = *(const LAS bf16x8*)(F.lds + P4_VNT + rowread_s(L, 32 * tj, s4)); }
                  __builtin_amdgcn_sched_barrier(0);
#pragma unroll
                  for (int s4 = 0; s4 < 4; ++s4) acc1 = __builtin_amdgcn_mfma_f32_32x32x16_bf16(fa[s4], fb[s4], acc1, 0, 0, 0); }
                const int tc = dir ? 63 - n : n; bf16* op = O + ((size_t)dir * NT + (size_t)b * SEQ + tc * 64) * DW + h * 128 + dvh * 64 + ncol;
#pragma unroll
                for (int e = 0; e < 16; ++e) { const int i = 32 * ti + (e & 3) + 8 * (e >> 2) + 4 * hh; op[(unsigned)((dir ? 63 - i : i) * DW)] = f2bf(acc1[e]); }
            }
            { const float egl = __expf(gl);
#pragma unroll
              for (int e = 0; e < 16; ++e) sacc[e] *= egl;
              const unsigned blk = (L >> 4) & 1, q4 = (L & 15) >> 2, p4 = L & 3;
              bf16x8 fv[4];
#pragma unroll
              for (int s4 = 0; s4 < 4; ++s4) fv[s4] = *(const LAS bf16x8*)(F.lds + P4_VDT + rowread_s(L, 32 * nt, s4));
              v4i16_t tv[8];
              { const unsigned kb = (unsigned)(size_t)(B + P4_KN), a0 = kb + off_b(8 * hh + q4, 4 * kt + 2 * blk + (p4 >> 1)) + 8 * (p4 & 1), a1 = kb + off_b(8 * hh + 4 + q4, 4 * kt + 2 * blk + (p4 >> 1)) + 8 * (p4 & 1);
                asm volatile("ds_read_b64_tr_b16 %0, %8\n\tds_read_b64_tr_b16 %1, %9\n\tds_read_b64_tr_b16 %2, %8 offset:4096\n\tds_read_b64_tr_b16 %3, %9 offset:4096\n\t"
                             "ds_read_b64_tr_b16 %4, %8 offset:8192\n\tds_read_b64_tr_b16 %5, %9 offset:8192\n\tds_read_b64_tr_b16 %6, %8 offset:12288\n\tds_read_b64_tr_b16 %7, %9 offset:12288\n\ts_waitcnt lgkmcnt(0)"
                             : "=&v"(tv[0]), "=&v"(tv[1]), "=&v"(tv[2]), "=&v"(tv[3]), "=&v"(tv[4]), "=&v"(tv[5]), "=&v"(tv[6]), "=&v"(tv[7]) : "v"(a0), "v"(a1) : "memory"); }
#pragma unroll
              for (int s4 = 0; s4 < 4; ++s4) { const v4i16_t t0v = tv[2 * s4], t1v = tv[2 * s4 + 1];
                  bf16x8 af; af[0] = t0v[0]; af[1] = t0v[1]; af[2] = t0v[2]; af[3] = t0v[3]; af[4] = t1v[0]; af[5] = t1v[1]; af[6] = t1v[2]; af[7] = t1v[3];
                  sacc = __builtin_amdgcn_mfma_f32_32x32x16_bf16(af, fv[s4], sacc, 0, 0, 0); }
              const int nn = 32 * nt + l31;
#pragma unroll
              for (int rg = 0; rg < 4; ++rg)
                  *(LAS unsigned long long*)(F.lds + P4_ST + off_b(nn, 4 * kt + rg) + 8 * hh) = (unsigned long long)cvt_pk_bf16(sacc[4 * rg], sacc[4 * rg + 1]) | ((unsigned long long)cvt_pk_bf16(sacc[4 * rg + 2], sacc[4 * rg + 3]) << 32);
            }
            if (mat == 1) asm volatile("s_waitcnt vmcnt(16)" ::: "memory"); else VM_WAIT();
            LDS_BAR();
        }
        VM_WAIT();
    }
}
__device__ __forceinline__ void phase_post(const Frame& F, const Args& a) {
    bf16* MIX = (bf16*)(F.ws + WS_MIX); const bf16* O = (const bf16*)(F.ws + WS_A); const bf16* PROJ = (const bf16*)(F.ws + WS_PROJ); const float* ag = a.in[6]; const float* dg = a.in[10];
    const int gw = F.vcu * NWAVES + F.wave, NGW = F.G * NWAVES, lane = F.lane;
    const f32x4 g0 = *(const f32x4*)(ag + lane * 8), g1 = *(const f32x4*)(ag + lane * 8 + 4);
    const f32x4 d0 = *(const f32x4*)(dg + (lane & 15) * 8), d1 = *(const f32x4*)(dg + (lane & 15) * 8 + 4);
    u32x4 nav, nof, nob, nzv;
    if (gw < NT) { nav = *(const u32x4*)(MIX + (size_t)gw * DM + lane * 8); nof = *(const u32x4*)(O + (size_t)gw * DW + lane * 8); nob = *(const u32x4*)(O + ((size_t)NT + gw) * DW + lane * 8); nzv = *(const u32x4*)(PROJ + (size_t)gw * PC + C_DZ + lane * 8); }
    for (int tok = gw; tok < NT; tok += NGW) {
        bf16* mp = MIX + (size_t)tok * DM;
        const u32x4 av = nav, of = nof, ob = nob, zv = nzv;
        { const int tn = tok + NGW < NT ? tok + NGW : tok;
          nav = *(const u32x4*)(MIX + (size_t)tn * DM + lane * 8); nof = *(const u32x4*)(O + (size_t)tn * DW + lane * 8); nob = *(const u32x4*)(O + ((size_t)NT + tn) * DW + lane * 8); nzv = *(const u32x4*)(PROJ + (size_t)tn * PC + C_DZ + lane * 8); }
        float x[8]; float ss = 0.f;
#pragma unroll
        for (int e = 0; e < 4; ++e) { x[2 * e] = __builtin_bit_cast(float, av[e] << 16); x[2 * e + 1] = __builtin_bit_cast(float, av[e] & 0xffff0000u); ss += x[2 * e] * x[2 * e] + x[2 * e + 1] * x[2 * e + 1]; }
        const float rstd = rsqrtf(wave_sum(ss) * (1.f / 512) + EPS);
        u32x4 w; w.x = cvt_pk_bf16(x[0] * rstd * g0[0], x[1] * rstd * g0[1]); w.y = cvt_pk_bf16(x[2] * rstd * g0[2], x[3] * rstd * g0[3]); w.z = cvt_pk_bf16(x[4] * rstd * g1[0], x[5] * rstd * g1[1]); w.w = cvt_pk_bf16(x[6] * rstd * g1[2], x[7] * rstd * g1[3]);
        *(u32x4*)(mp + lane * 8) = w;
        float o[8], z[8]; float s2 = 0.f;
#pragma unroll
        for (int e = 0; e < 4; ++e) { o[2 * e] = __builtin_bit_cast(float, of[e] << 16) + __builtin_bit_cast(float, ob[e] << 16); o[2 * e + 1] = __builtin_bit_cast(float, of[e] & 0xffff0000u) + __builtin_bit_cast(float, ob[e] & 0xffff0000u);
            z[2 * e] = __builtin_bit_cast(float, zv[e] << 16); z[2 * e + 1] = __builtin_bit_cast(float, zv[e] & 0xffff0000u); s2 += o[2 * e] * o[2 * e] + o[2 * e + 1] * o[2 * e + 1]; }
        s2 = row16_sum(s2);
        const float r2 = rsqrtf(s2 * (1.f / 128) + EPS);
        float y[8];
#pragma unroll
        for (int e = 0; e < 8; ++e) y[e] = o[e] * r2 * (e < 4 ? d0[e] : d1[e - 4]) * z[e] * __builtin_amdgcn_rcpf(1.f + __expf(-z[e]));
        u32x4 w2; w2.x = cvt_pk_bf16(y[0], y[1]); w2.y = cvt_pk_bf16(y[2], y[3]); w2.z = cvt_pk_bf16(y[4], y[5]); w2.w = cvt_pk_bf16(y[6], y[7]);
        *(u32x4*)(mp + 512 + lane * 8) = w2;
    }
}

__global__ void __launch_bounds__(NTHR, 2) fwd(Args args) {
    extern __shared__ __attribute__((aligned(16))) unsigned char lds_raw[];
    Frame F; F.lds = (LAS unsigned char*)lds_raw; F.tid = threadIdx.x; F.lane = F.tid & 63; F.wave = __builtin_amdgcn_readfirstlane(F.tid >> 6);
    F.G = gridDim.x; { const int bx = blockIdx.x; F.vcu = (F.G % 8 == 0) ? (bx % 8) * (F.G / 8) + bx / 8 : bx; } F.ws = args.ws;
    gu32* ctl = (gu32*)(F.ws + WS_CTL);
    for (int u = F.tid; u < 128; u += NTHR) ((LAS unsigned*)(F.lds + LDSCTL_OFF))[u] = 0u;
    __syncthreads();
    const int lo = args.ph_lo, hi = args.ph_hi;
    XcdBarrier bar; bar.bar = (unsigned*)ctl + CW_BAR; bar.x = 0; bar.st = nullptr;
    if (hi - lo > 1) bar = xcd_barrier_post((unsigned*)ctl + CW_BAR, (volatile LAS unsigned*)(F.lds + MISC_OFF));
#ifndef PH_MASK
#define PH_MASK 0xffff
#endif
#define IN(k) (((PH_MASK >> (k)) & 1) && lo <= (k) && (k) < hi)
#define SEAM(k) do { if (IN(k) && IN((k) + 1)) xcd_barrier(bar); } while (0)
#ifndef ALIGN1
#define ALIGN1 false
#endif
#ifndef ALIGN6
#define ALIGN6 true
#endif
#ifndef ALIGN8
#define ALIGN8 true
#endif
#ifndef ALIGN9
#define ALIGN9 true
#endif
#ifndef DBL_MASK
#define DBL_MASK 0
#endif
#define DBL(k) (((DBL_MASK >> (k)) & 1) != 0)
    bf16* XN = (bf16*)(F.ws + WS_A); bf16* X2B = (bf16*)(F.ws + WS_A); bf16* PROJ = (bf16*)(F.ws + WS_PROJ); bf16* MIX = (bf16*)(F.ws + WS_MIX);
    bf16* HID = (bf16*)(F.ws + WS_HID); bf16* Y = (bf16*)(F.ws + WS_Y); float* SSQ2 = (float*)(F.ws + WS_SSQ2);
    if (IN(0)) { phase0(F, args); if (DBL(0)) { xcd_barrier(bar); phase0(F, args); } } SEAM(0);
    if (IN(1)) {
        LAS float* gains = (LAS float*)(F.lds + TAB_OFF);
        if (F.tid < 64) gains[F.tid] = args.in[3][F.tid] * (0.125f * LOG2E); else if (F.tid < 128) gains[F.tid] = args.in[4][F.tid - 64];
        __syncthreads();
        pg8::Gemm g{XN, (const bf16*)(F.ws + WS_WIN), DM, 0, DM, 0}; pg8::StaticOrder S; S.init(NT, PC + 256, F.G, (int)blockIdx.x);
        pg8::gemm_phase<EpiInProjF, pg8::StaticOrder, pg8::DenseA, ALIGN1>(F.lds, g, S, pg8::DenseA{DM}, EpiInProjF{PROJ, gains, (float*)(F.ws + WS_DAB)});
    } SEAM(1);
    if (IN(2)) { phase_na(F, args); if (DBL(2)) { xcd_barrier(bar); phase_na(F, args); } }
    __syncthreads();
    if (IN(3)) { phase_dnprep(F, args); if (DBL(3)) { xcd_barrier(bar); phase_dnprep(F, args); } } SEAM(3);
    if (IN(4)) { phase_dnscan(F, args); if (DBL(4)) { xcd_barrier(bar); phase_dnscan(F, args); } } SEAM(4);
    if (IN(5)) { phase_post(F, args); } SEAM(5);
    if (IN(6)) {
        pg8::Gemm g{MIX, (const bf16*)(F.ws + WS_WO), DM, 0, DM, 0}; pg8::StaticOrder S; S.init(NT, DM, F.G, (int)blockIdx.x);
        pg8::gemm_phase<EpiOutF, pg8::StaticOrder, pg8::DenseA, ALIGN6>(F.lds, g, S, pg8::DenseA{DM}, EpiOutF{args.in[0], args.out, X2B, SSQ2});
    } SEAM(6);
    if (IN(7)) {
        pg8::Gemm g{X2B, (const bf16*)(F.ws + WS_WR), DM, 0, DM, 0}; pg8::StaticOrder S; S.init(NT, 256, F.G, (int)blockIdx.x);
        EpiRouterF E{SSQ2, args.in[14], args.in[16], (int*)(F.ws + WS_TOKE), (float*)(F.ws + WS_TOKG), (float*)(F.ws + WS_RSTD2), (int*)(F.ws + WS_BIDX), (unsigned*)ctl + CW_CNT};
        pg8::gemm_phase<EpiRouterF, pg8::StaticOrder, pg8::DenseA, false>(F.lds, g, S, pg8::DenseA{DM}, E);
    } SEAM(7);
    if (IN(8)) {
        const int n = moe_setup1(F);
        pg8::Gemm g{X2B, (const bf16*)(F.ws + WS_WGU), DM, (size_t)512 * DM * 2, DM, 0};
        MoeSched S{(const LAS int*)(F.lds + TAB_OFF + TB_UT), n};
        const LAS unsigned* t0 = (const LAS unsigned*)(F.lds + TAB_OFF + TB_T);
        pg8::gemm_phase<EpiMoe1F, MoeSched, pg8::GatherA, ALIGN8>(F.lds, g, S, pg8::GatherA{t0}, EpiMoe1F{HID, (const LAS float*)(t0 + 6 * 256), t0 + 12 * 256, (const LAS float*)(t0 + 18 * 256)});
    } SEAM(8);
    if (IN(9)) {
        const int n = moe_setup2(F);
        pg8::Gemm g{HID, (const bf16*)(F.ws + WS_WD), 2 * DE, (size_t)DM * DE * 2, DE, 4};
        MoeSched S{(const LAS int*)(F.lds + TAB_OFF + TB_UT), n};
        pg8::gemm_phase<EpiMoe2F, MoeSched, pg8::DenseA, ALIGN9>(F.lds, g, S, pg8::DenseA{2 * DE}, EpiMoe2F{X2B, args.out, (const LAS unsigned*)(F.lds + TAB_OFF + TB_T)});
    }
#undef IN
#undef SEAM
}


extern "C" void kernel_launch(void* const* d_in, const int* in_sizes, int n_in, void* d_out, int out_size, void* d_ws, size_t ws_size, hipStream_t stream) {
    static int grid = 0;
    if (grid == 0) {
        if (n_in != 20 || in_sizes[0] != NT * DM || out_size != NT * DM || ws_size < WS_END2) { fprintf(stderr, "kernel_launch: unexpected n_in %d / sizes / ws_size %zu (need %zu)\n", n_in, ws_size, (size_t)WS_END2); grid = -1; return; }
        int dev = 0, cus = 0, per_cu = 0;
        if (hipGetDevice(&dev) != hipSuccess || hipDeviceGetAttribute(&cus, hipDeviceAttributeMultiprocessorCount, dev) != hipSuccess) { grid = -1; return; }
        if (hipFuncSetAttribute((const void*)fwd, hipFuncAttributeMaxDynamicSharedMemorySize, LDS_BYTES) != hipSuccess) { fprintf(stderr, "kernel_launch: hipFuncSetAttribute failed\n"); grid = -1; return; }
        if (hipOccupancyMaxActiveBlocksPerMultiprocessor(&per_cu, (const void*)fwd, NTHR, LDS_BYTES) != hipSuccess || per_cu < 1) fprintf(stderr, "kernel_launch: occupancy query says %d\n", per_cu);
        (void)hipGetLastError();
        grid = cus;
    }
    if (grid < 0) return;
    (void)hipMemsetAsync((unsigned char*)d_ws + WS_CTL, 0, 1 * MiB, stream);
    Args a{}; for (int i = 0; i < 20; ++i) a.in[i] = (const float*)d_in[i]; a.out = (float*)d_out; a.ws = (unsigned char*)d_ws;
#define FWD(lo_, hi_) do { a.ph_lo = (lo_); a.ph_hi = (hi_); hipLaunchKernelGGL(fwd, dim3(grid), dim3(NTHR), LDS_BYTES, stream, a); } while (0)
#if defined(PROBE_EXTRA)
    for (int k = 0; k < 10; ++k) { FWD(k, k + 1); if (k == PROBE_EXTRA) FWD(k, k + 1); }
#else
    FWD(0, 10);
#endif
}
```

```cpp
#include <hip/hip_runtime.h>
#include <cstdio>
#include <cstdint>

typedef unsigned short bf16;
typedef unsigned u32x4 __attribute__((ext_vector_type(4)));
typedef float f32x4 __attribute__((ext_vector_type(4)));

constexpr int BATCH = 16, SEQ = 4096, DM = 1024, NT = BATCH * SEQ;
constexpr int GW = 64, ROWS = SEQ / GW, KH = 8, KW = 16;
constexpr int AH = 8, ADH = 64, AW = 512;
constexpr int DH = 4, DHD = 128, DW = 512, DCONV = 5, DCHUNK = 64;
constexpr int INC = 3600, PC = 3584;
constexpr int NG = 8, EPG = 8, NE = 64, DE = 256;
constexpr float EPS = 1e-6f;
constexpr float LOG2E = 1.4426950408889634f;
constexpr int C_AQ = 0, C_AK = 512, C_AV = 1024, C_DQ = 1536, C_DK = 2048, C_DV = 2560, C_DZ = 3072;

constexpr size_t MiB = 1ull << 20;
constexpr size_t WS_CTL   = 0;
constexpr size_t WS_WIN   = 1 * MiB;
constexpr size_t WS_WO    = 8 * MiB + 512 * 1024;
constexpr size_t WS_WR    = 10 * MiB + 512 * 1024;
constexpr size_t WS_WGU   = 11 * MiB;
constexpr size_t WS_WD    = 75 * MiB;
constexpr size_t WS_A     = 107 * MiB;
constexpr size_t WS_PROJ  = 235 * MiB;
constexpr size_t WS_MIX   = 683 * MiB;
constexpr size_t WS_TQK   = 811 * MiB;
constexpr size_t WS_DAB   = 939 * MiB;
constexpr size_t WS_G     = 943 * MiB;
constexpr size_t WS_BETA  = 945 * MiB;
constexpr size_t WS_TOKE  = 947 * MiB;
constexpr size_t WS_TOKG  = 948 * MiB;
constexpr size_t WS_RSTD2 = 949 * MiB;
constexpr size_t WS_BIDX  = 950 * MiB;
constexpr size_t WS_END   = 966 * MiB;
constexpr size_t WS_HID   = WS_PROJ;
constexpr size_t WS_Y     = WS_PROJ + 80 * MiB;
constexpr int CW_CNT = 1024;

__device__ __forceinline__ float bf2f(bf16 v) { return __builtin_bit_cast(float, (unsigned)v << 16); }
__device__ __forceinline__ bf16 f2bf(float f) { unsigned u = __builtin_bit_cast(unsigned, f); return (bf16)((u + 0x7fffu + ((u >> 16) & 1u)) >> 16); }
template <int CTRL> __device__ __forceinline__ float dpp_f(float v) { return __builtin_bit_cast(float, __builtin_amdgcn_update_dpp(0, __builtin_bit_cast(int, v), CTRL, 0xf, 0xf, false)); }
__device__ __forceinline__ float row16_sum(float v) {
    v += dpp_f<0xB1>(v);
    v += dpp_f<0x4E>(v);
    v += dpp_f<0x141>(v);
    v += dpp_f<0x140>(v);
    return v;
}
__device__ __forceinline__ float wave_sum(float v) {
    const int b = __builtin_bit_cast(int, row16_sum(v));
    return (__builtin_bit_cast(float, __builtin_amdgcn_readlane(b, 0)) + __builtin_bit_cast(float, __builtin_amdgcn_readlane(b, 16))) + (__builtin_bit_cast(float, __builtin_amdgcn_readlane(b, 32)) + __builtin_bit_cast(float, __builtin_amdgcn_readlane(b, 48)));
}
__device__ __forceinline__ float silu_f(float x) { return x / (1.f + __expf(-x)); }
__device__ __forceinline__ float sigmoid_f(float x) { return 1.f / (1.f + __expf(-x)); }
__device__ __forceinline__ float softplus_f(float x) { return fmaxf(x, 0.f) + log1pf(__expf(-fabsf(x))); }

#define LAS __attribute__((address_space(3)))
#define GAS __attribute__((address_space(1)))
typedef short bf16x8 __attribute__((ext_vector_type(8)));
typedef GAS unsigned gu32;
constexpr int NWAVES = 8, NTHR = 512;
constexpr int LDS_BYTES = 163840, RING_BYTES = 131072, LDSCTL_OFF = 163328, MISC_OFF = LDSCTL_OFF + 64, TAB_OFF = 132096;
constexpr size_t WS_SSQ2 = 966 * MiB;
constexpr size_t WS_EDL  = 970 * MiB;
constexpr size_t WS_END2 = 972 * MiB;
constexpr int CW_TMO = 0, CW_BAR = 4096;
constexpr int CW_PCNT = 1280;
constexpr size_t WS_R2T = WS_CTL + 256 * 1024;
constexpr size_t WS_TOKP = WS_TOKE;
#define RLX_AGENT __ATOMIC_RELAXED, __HIP_MEMORY_SCOPE_AGENT
#define LDS_WAIT() asm volatile("s_waitcnt lgkmcnt(0)" ::: "memory")
#define VM_WAIT() asm volatile("s_waitcnt vmcnt(0)" ::: "memory")
#define LDS_BAR() do { asm volatile("s_waitcnt lgkmcnt(0)" ::: "memory"); __builtin_amdgcn_s_barrier(); asm volatile("" ::: "memory"); } while (0)
__device__ __forceinline__ unsigned pk2(float lo, float hi) { return (unsigned)f2bf(lo) | ((unsigned)f2bf(hi) << 16); }
typedef float f32x2_t __attribute__((ext_vector_type(2)));
typedef __bf16 bf16x2_t __attribute__((ext_vector_type(2)));
__device__ __forceinline__ unsigned cvt_pk_bf16_asm(float lo, float hi) { unsigned r; asm volatile("v_cvt_pk_bf16_f32 %0, %1, %2" : "=v"(r) : "v"(lo), "v"(hi)); return r; }
__device__ __forceinline__ unsigned cvt_pk_bf16(float lo, float hi) { const f32x2_t v = {lo, hi}; const bf16x2_t b = __builtin_convertvector(v, bf16x2_t); return __builtin_bit_cast(unsigned, b); }

#define XB_TMO      128
#define XB_XCNT(j)  (256  + 64 * (j))
#define XB_XSUB(j)  (1280 + 64 * (j))
#define XB_XGEN(j)  (2304 + 64 * (j))
#define XB_TOP      3328
#define XB_TOPGEN   3392
#define XCD_BAR_WORDS 3456
#define XB_SPIN_CAP (1u << 22)
__device__ __forceinline__ unsigned xb_ld(unsigned* p)              { return __hip_atomic_load(p, __ATOMIC_RELAXED, __HIP_MEMORY_SCOPE_AGENT); }
__device__ __forceinline__ unsigned xb_add(unsigned* p, unsigned v) { return __hip_atomic_fetch_add(p, v, __ATOMIC_RELAXED, __HIP_MEMORY_SCOPE_AGENT); }
__device__ __forceinline__ unsigned xb_xcc_id() { return (unsigned)__builtin_amdgcn_s_getreg((3 << 11) | 20) & 0xFu; }
#define XB_SPIN(cond, bar) do { unsigned _sp = 0; while (cond) { __builtin_amdgcn_s_sleep(1); \
    if ((++_sp & 255u) == 0u) { if (xb_ld(&(bar)[XB_TMO])) break; if (_sp > XB_SPIN_CAP) { atomicAdd(&(bar)[XB_TMO], 1u); break; } } } } while (0)
struct XcdBarrier { unsigned* bar; unsigned x; volatile LAS unsigned* st; };
__device__ __forceinline__ XcdBarrier xcd_barrier_post(unsigned* bar, volatile LAS unsigned* st) {
    XcdBarrier b; b.bar = bar; b.x = xb_xcc_id(); b.st = st;
    if (threadIdx.x == 0) (void)xb_add(&bar[XB_XCNT(b.x)], 1u);
    return b;
}
__device__ __forceinline__ void xcd_barrier_complete(unsigned* bar, unsigned x, unsigned& nloc, unsigned& nx) {
    const unsigned G = gridDim.x * gridDim.y * gridDim.z;
    unsigned sum, cnt, mine, sp = 0u;
    for (;;) {
        sum = 0u; cnt = 0u; mine = 0u;
#pragma unroll
        for (unsigned j = 0; j < 16; ++j) { const unsigned c = xb_ld(&bar[XB_XCNT(j)]); sum += c; cnt += (c > 0u) ? 1u : 0u; mine = (j == x) ? c : mine; }
        if (sum == G) break;
        __builtin_amdgcn_s_sleep(1);
        if ((++sp & 255u) == 0u) { if (xb_ld(&bar[XB_TMO])) break; if (sp > XB_SPIN_CAP) { atomicAdd(&bar[XB_TMO], 1u); break; } }
    }
    nloc = mine > 0u ? mine : 1u; nx = cnt > 0u ? cnt : 1u;
}
__device__ __forceinline__ void xcd_barrier(const XcdBarrier& b) {
    asm volatile("s_waitcnt vmcnt(0)" ::: "memory");
    __syncthreads();
    if (threadIdx.x == 0) {
        unsigned* bar = b.bar;
        __builtin_amdgcn_s_waitcnt(0);
        unsigned nloc = b.st[0], nx = b.st[1];
        if (nloc == 0u) { xcd_barrier_complete(bar, b.x, nloc, nx); b.st[0] = nloc; b.st[1] = nx; }
        const unsigned old = xb_add(&bar[XB_XSUB(b.x)], 1u);
        const unsigned gen = old / nloc;
        if (old + 1u == (gen + 1u) * nloc) {
            __builtin_amdgcn_fence(__ATOMIC_RELEASE, "agent");
            asm volatile("s_waitcnt vmcnt(0)" ::: "memory");
            const unsigned og = xb_add(&bar[XB_TOP], 1u);
            const unsigned tg = og / nx;
            if (og + 1u == (tg + 1u) * nx) xb_add(&bar[XB_TOPGEN], 1u);
            else XB_SPIN(xb_ld(&bar[XB_TOPGEN]) == tg, bar);
            __builtin_amdgcn_fence(__ATOMIC_ACQUIRE, "agent");
            xb_add(&bar[XB_XGEN(b.x)], 1u);
            asm volatile("s_waitcnt vmcnt(0)" ::: "memory");
        } else {
            XB_SPIN(xb_ld(&bar[XB_XGEN(b.x)]) == gen, bar);
            __builtin_amdgcn_fence(__ATOMIC_ACQUIRE, "agent");
            asm volatile("s_waitcnt vmcnt(0)" ::: "memory");
        }
    }
    __syncthreads();
}

namespace pg8 {
constexpr int BM = 256, BK = 64, HALF = 128, HTB = HALF * BK * 2, NXCD = 8, WGM = 8;
__host__ __device__ __forceinline__ int lds_byte(int r, int c) { const int st = (r >> 4) * 2 + (c >> 5), rr = r & 15, cc = c & 31, ob = rr * 64 + cc * 2; return st * 1024 + (ob ^ (((ob >> 9) & 1) << 5)); }
__host__ __device__ __forceinline__ void stage_rc(int b, int& R, int& C) { const int st = b / 1024, sb = b % 1024, swz = sb ^ (((sb >> 9) & 1) << 5); R = (st >> 1) * 16 + swz / 64; C = (st & 1) * 32 + (swz % 64) / 2; }
__host__ __device__ __forceinline__ int perm32(int rho) { const int n = rho >> 4, i = rho & 15; return 8 * (i >> 2) + 4 * n + (i & 3); }
struct Unit { int pm, pn, e, ts, e2; };
struct Gemm { const bf16* A; const bf16* Bt; int K; size_t bstride; int ldb, bsplit; };
struct StaticOrder {
    int nM, nN, nwg, G, c;
    __device__ void init(int M, int N, int G_, int c_) { nM = M / BM; nN = N / BM; nwg = nM * nN; G = G_; c = c_; }
    __device__ bool next(int i, Unit& u) const {
        const long L = (long)i * G + c; if (L >= nwg) return false;
        int wgid = (int)L; { const int q = nwg / NXCD, r = nwg % NXCD, xcd = wgid % NXCD, off = wgid / NXCD; wgid = (xcd < r ? xcd * (q + 1) : r * (q + 1) + (xcd - r) * q) + off; }
        const int nig = WGM * nN, gid = wgid / nig, fm = gid * WGM, gsz = (nM - fm) < WGM ? (nM - fm) : WGM;
        u.pm = fm + ((wgid % nig) % gsz); u.pn = (wgid % nig) / gsz; u.e = 0; u.ts = 0; u.e2 = 0; return true;
    }
};
struct DenseA { int K; __device__ __forceinline__ unsigned rowoff(const Unit& u, int h, int R) const { return (unsigned)(u.pm * BM + h * HALF + R) * (unsigned)(K * 2); } };
struct GatherA { const LAS unsigned* tab; __device__ __forceinline__ unsigned rowoff(const Unit& u, int h, int R) const { return tab[u.ts * BM + h * HALF + R]; } };

template <class Epi, class Sched, class AMap, bool ALIGN_EPI>
__device__ __forceinline__ void gemm_phase(LAS unsigned char* lds, const Gemm g, const Sched& S, const AMap& AM, const Epi& E) {
    const int tid = threadIdx.x, wid = __builtin_amdgcn_readfirstlane(tid >> 6), lane = tid & 63, wr = wid >> 2, wc = wid & 3, fr = lane & 15, fq = lane >> 4;
    const int K = g.K, nt = K / BK;
    unsigned voffB[2];
#pragma unroll
    for (int i = 0; i < 2; ++i) { int R, C; stage_rc(tid * 16 + i * 8192, R, C); const int Rb = Epi::PERM ? ((R & ~31) + perm32(R & 31)) : R;
        voffB[i] = (unsigned)(Rb * g.ldb + C) * 2u; }
    const size_t kstep = (size_t)(BK * 2);
    const size_t hstep = (size_t)HALF * g.ldb * 2;
    const int bsplit = g.bsplit;
    const size_t tstep = 2 * hstep;
    const unsigned ldsw = (unsigned)wid * 1024u;
    const int aoff = lds_byte(wr * 64 + fr, fq * 8), boff = lds_byte(wc * 32 + fr, fq * 8);
    const char* const Ab = (const char*)g.A;
#define PG8_SA(b, h) (((b) * 2 + (h)) * HTB)
#define PG8_SB(b, h) ((4 + (b) * 2 + (h)) * HTB)
#define PG8_STAGE(bufoff, gbase, voff) do { _Pragma("unroll") for (int _i = 0; _i < 2; ++_i) \
        __builtin_amdgcn_global_load_lds((const unsigned*)((const char*)(gbase) + (voff)[_i]), (LAS unsigned*)(lds + (bufoff) + ldsw + _i * 8192), 16, 0, 0); } while (0)
#define PG8_LDA(dst, b, h) do { _Pragma("unroll") for (int m = 0; m < 4; ++m) _Pragma("unroll") for (int k = 0; k < 2; ++k) dst[m][k] = *(const LAS bf16x8*)(lds + PG8_SA(b, h) + aoff + m * 2048 + k * 1024); } while (0)
#define PG8_LDB(dst, b, h) do { _Pragma("unroll") for (int n = 0; n < 2; ++n) _Pragma("unroll") for (int k = 0; k < 2; ++k) dst[n][k] = *(const LAS bf16x8*)(lds + PG8_SB(b, h) + boff + n * 2048 + k * 1024); } while (0)
#define PG8_MMA(ai, bj, At, Bt) do { __builtin_amdgcn_s_setprio(1); _Pragma("unroll") for (int m = 0; m < 4; ++m) _Pragma("unroll") for (int n = 0; n < 2; ++n) _Pragma("unroll") for (int k = 0; k < 2; ++k) \
        acc[ai][bj][m][n] = __builtin_amdgcn_mfma_f32_16x16x32_bf16(Bt[n][k], At[m][k], acc[ai][bj][m][n], 0, 0, 0); __builtin_amdgcn_s_setprio(0); } while (0)
#define PG8_WAIT_V(n) asm volatile("s_waitcnt vmcnt(" #n ")" ::: "memory")
#define PG8_WAIT_L(n) asm volatile("s_waitcnt lgkmcnt(" #n ")" ::: "memory")
#define PG8_BAR __builtin_amdgcn_s_barrier()
#define PG8_SCHED __builtin_amdgcn_sched_barrier(0)
    Unit cur, nxt; int ui = 0;
    if (!S.next(0, cur)) return;
    f32x4 acc[2][2][4][2];
#pragma unroll
    for (int a = 0; a < 2; ++a)
#pragma unroll
        for (int b = 0; b < 2; ++b)
#pragma unroll
            for (int m = 0; m < 4; ++m)
#pragma unroll
                for (int n = 0; n < 2; ++n) acc[a][b][m][n] = (f32x4){0.f, 0.f, 0.f, 0.f};
    bf16x8 At[4][2], B0[2][2], B1[2][2];
    unsigned ca[2][2];
#pragma unroll
    for (int i = 0; i < 2; ++i) { int R, C; stage_rc(tid * 16 + i * 8192, R, C);
#pragma unroll
        for (int h = 0; h < 2; ++h) ca[h][i] = AM.rowoff(cur, h, R) + (unsigned)C * 2u; }
    const char* cB = (const char*)g.Bt + (size_t)cur.e * g.bstride + (size_t)cur.pn * tstep;
    const char* cB2 = (const char*)g.Bt + (size_t)cur.e2 * g.bstride + (size_t)cur.pn * tstep;
    PG8_STAGE(PG8_SB(0, 0), cB, voffB); PG8_STAGE(PG8_SB(0, 1), cB + hstep, voffB); PG8_STAGE(PG8_SA(0, 0), Ab, ca[0]); PG8_STAGE(PG8_SA(0, 1), Ab, ca[1]);
    if (wr == 1) PG8_BAR;
    PG8_WAIT_V(2); PG8_BAR;
    PG8_STAGE(PG8_SB(1, 0), cB + kstep, voffB); PG8_STAGE(PG8_SA(1, 0), Ab + kstep, ca[0]); PG8_STAGE(PG8_SB(1, 1), cB + hstep + kstep, voffB);
    PG8_WAIT_V(6); PG8_BAR;
    for (;;) {
        const bool has_next = S.next(ui + 1, nxt);
        const char* nB = has_next ? (const char*)g.Bt + (size_t)nxt.e * g.bstride + (size_t)nxt.pn * tstep : cB;
        for (int t = 0; t < nt; t += 2) {
            const bool last = (t == nt - 2);
            unsigned a2[2][2];
#pragma unroll
            for (int h = 0; h < 2; ++h)
#pragma unroll
                for (int i = 0; i < 2; ++i) a2[h][i] = ca[h][i];
            if (last && has_next) {
                int tq = tid; asm volatile("" : "+v"(tq));
#pragma unroll
                for (int i = 0; i < 2; ++i) { int R, C; stage_rc(tq * 16 + i * 8192, R, C);
#pragma unroll
                    for (int h = 0; h < 2; ++h) a2[h][i] = AM.rowoff(nxt, h, R) + (unsigned)C * 2u; }
            }
            const char* a1 = Ab + (size_t)(t + 1) * kstep;
            const char* a2b = last ? Ab : Ab + (size_t)(t + 2) * kstep;
            const char* b2 = last ? nB : ((bsplit > 0 && t + 2 >= bsplit) ? cB2 + (size_t)(t + 2 - bsplit) * kstep : cB + (size_t)(t + 2) * kstep);
            const char* a3b = a2b + kstep; const char* b3 = b2 + kstep;
            PG8_LDB(B0, 0, 0); PG8_LDB(B1, 0, 1); PG8_SCHED; PG8_LDA(At, 0, 0); PG8_STAGE(PG8_SA(1, 1), a1, ca[1]);
            PG8_WAIT_V(8); PG8_WAIT_L(0); PG8_BAR; PG8_MMA(0, 0, At, B0); PG8_MMA(0, 1, At, B1); PG8_BAR; PG8_SCHED;
            PG8_LDA(At, 0, 1); PG8_STAGE(PG8_SB(0, 0), b2, voffB); PG8_STAGE(PG8_SB(0, 1), b2 + hstep, voffB); PG8_STAGE(PG8_SA(0, 0), a2b, a2[0]);
            PG8_WAIT_V(8); PG8_WAIT_L(0); PG8_BAR; PG8_MMA(1, 0, At, B0); PG8_MMA(1, 1, At, B1); PG8_BAR; PG8_SCHED;
            PG8_LDB(B0, 1, 0); PG8_LDB(B1, 1, 1); PG8_SCHED; PG8_LDA(At, 1, 0); PG8_STAGE(PG8_SA(0, 1), a2b, a2[1]);
            PG8_WAIT_V(8); PG8_WAIT_L(0); PG8_BAR; PG8_MMA(0, 0, At, B0); PG8_MMA(0, 1, At, B1); PG8_BAR; PG8_SCHED;
            PG8_LDA(At, 1, 1); PG8_STAGE(PG8_SB(1, 0), b3, voffB); PG8_STAGE(PG8_SB(1, 1), b3 + hstep, voffB); PG8_STAGE(PG8_SA(1, 0), a3b, a2[0]);
            PG8_WAIT_V(8); PG8_WAIT_L(0); PG8_BAR; PG8_MMA(1, 0, At, B0); PG8_MMA(1, 1, At, B1); PG8_BAR; PG8_SCHED;
            if (last) {
#pragma unroll
                for (int h = 0; h < 2; ++h)
#pragma unroll
                    for (int i = 0; i < 2; ++i) ca[h][i] = a2[h][i];
            }
        }
        if constexpr (ALIGN_EPI) { if (wr == 0) PG8_BAR; }
        if constexpr (!Epi::AFTER_DRAIN) { E(acc, cur, wr, wc, fr, fq); }
        if (!has_next) break;
#pragma unroll
        for (int a = 0; a < 2; ++a)
#pragma unroll
            for (int b = 0; b < 2; ++b)
#pragma unroll
                for (int m = 0; m < 4; ++m)
#pragma unroll
                    for (int n = 0; n < 2; ++n) acc[a][b][m][n] = (f32x4){0.f, 0.f, 0.f, 0.f};
        cur = nxt; cB = nB; cB2 = (const char*)g.Bt + (size_t)cur.e2 * g.bstride + (size_t)cur.pn * tstep; ++ui;
        if constexpr (ALIGN_EPI) { if (wr == 1) PG8_BAR; }
    }
    PG8_WAIT_V(0);
    if constexpr (!ALIGN_EPI) { if (wr == 0) PG8_BAR; }
    PG8_BAR;
    if constexpr (Epi::AFTER_DRAIN) { E.fused(acc, cur, wr, wc, fr, fq, lds, wid, lane); }
#undef PG8_SA
#undef PG8_SB
#undef PG8_STAGE
#undef PG8_LDA
#undef PG8_LDB
#undef PG8_MMA
#undef PG8_WAIT_V
#undef PG8_WAIT_L
#undef PG8_BAR
#undef PG8_SCHED
}
}

struct EpiInProjF { static constexpr bool PERM = true, AFTER_DRAIN = false;
    bf16* proj; const LAS float* gains; float* dab;
    __device__ __forceinline__ void operator()(const f32x4 (&acc)[2][2][4][2], const pg8::Unit& u, int wr, int wc, int fr, int fq) const {
        if (u.pn == 14) {
            if (wc == 0) {
#pragma unroll
                for (int ai = 0; ai < 2; ++ai)
#pragma unroll
                    for (int m = 0; m < 4; ++m) { const int row = u.pm * 256 + ai * 128 + wr * 64 + m * 16 + fr;
#pragma unroll
                        for (int n = 0; n < 2; ++n) { f32x4 t = acc[ai][0][m][n];
#pragma unroll
                            for (int i = 0; i < 4; ++i) t[i] += __shfl_xor(t[i], 32);
                            if (fq < 2) *(f32x4*)(dab + (size_t)row * 16 + 8 * fq + 4 * n) = t; } }
            }
            return;
        }
        const int mode = u.pn < 2 ? 0 : (u.pn < 4 ? 1 : 2);
        float one = 1.f; asm volatile("" : "+v"(one));
        f32x4 gv[2][2];
        if (mode < 2) {
#pragma unroll
            for (int bj = 0; bj < 2; ++bj)
#pragma unroll
                for (int n = 0; n < 2; ++n) gv[bj][n] = *(const LAS f32x4*)(gains + mode * 64 + 32 * bj + 8 * fq + 4 * n);
        }
#pragma unroll
        for (int ai = 0; ai < 2; ++ai)
#pragma unroll
            for (int m = 0; m < 4; ++m) {
                const int row = u.pm * 256 + ai * 128 + wr * 64 + m * 16 + fr;
                f32x4 v[2][2];
#pragma unroll
                for (int bj = 0; bj < 2; ++bj)
#pragma unroll
                    for (int n = 0; n < 2; ++n) v[bj][n] = acc[ai][bj][m][n];
                if (mode >= 2) {
#pragma unroll
                    for (int bj = 0; bj < 2; ++bj)
#pragma unroll
                        for (int n = 0; n < 2; ++n) v[bj][n] = v[bj][n] * one;
                }
                if (mode < 2) {
                    float ss = 0.f;
#pragma unroll
                    for (int bj = 0; bj < 2; ++bj)
#pragma unroll
                        for (int n = 0; n < 2; ++n) ss += (v[bj][n][0] * v[bj][n][0] + v[bj][n][1] * v[bj][n][1]) + (v[bj][n][2] * v[bj][n][2] + v[bj][n][3] * v[bj][n][3]);
                    ss += __shfl_xor(ss, 16); ss += __shfl_xor(ss, 32);
                    const float rstd = rsqrtf(ss * (1.f / 64) + EPS);
#pragma unroll
                    for (int bj = 0; bj < 2; ++bj)
#pragma unroll
                        for (int n = 0; n < 2; ++n) v[bj][n] = v[bj][n] * rstd * gv[bj][n];
                }
                bf16* rp = proj + (size_t)row * PC + u.pn * 256 + wc * 64 + 8 * fq;
#pragma unroll
                for (int bj = 0; bj < 2; ++bj) { u32x4 w; w.x = cvt_pk_bf16_asm(v[bj][0][0], v[bj][0][1]); w.y = cvt_pk_bf16_asm(v[bj][0][2], v[bj][0][3]); w.z = cvt_pk_bf16_asm(v[bj][1][0], v[bj][1][1]); w.w = cvt_pk_bf16_asm(v[bj][1][2], v[bj][1][3]);
                    *(u32x4*)(rp + 32 * bj) = w; }
            }
    }
};
struct EpiOutF { static constexpr bool PERM = true, AFTER_DRAIN = false;
    const float* x; float* out; bf16* x2b; float* ssq2;
    __device__ __forceinline__ void operator()(const f32x4 (&acc)[2][2][4][2], const pg8::Unit& u, int wr, int wc, int fr, int fq) const {
#pragma unroll
        for (int ai = 0; ai < 2; ++ai)
#pragma unroll
            for (int m = 0; m < 4; ++m) {
                const int row = u.pm * 256 + ai * 128 + wr * 64 + m * 16 + fr; float ss = 0.f;
#pragma unroll
                for (int bj = 0; bj < 2; ++bj) { const size_t off = (size_t)row * DM + u.pn * 256 + bj * 128 + wc * 32 + 8 * fq;
                    const f32x4 r0 = *(const f32x4*)(x + off) + acc[ai][bj][m][0], r1 = *(const f32x4*)(x + off + 4) + acc[ai][bj][m][1];
                    ss += (r0[0] * r0[0] + r0[1] * r0[1]) + (r0[2] * r0[2] + r0[3] * r0[3]) + (r1[0] * r1[0] + r1[1] * r1[1]) + (r1[2] * r1[2] + r1[3] * r1[3]);
                    u32x4 w; w.x = cvt_pk_bf16_asm(r0[0], r0[1]); w.y = cvt_pk_bf16_asm(r0[2], r0[3]); w.z = cvt_pk_bf16_asm(r1[0], r1[1]); w.w = cvt_pk_bf16_asm(r1[2], r1[3]);
                    *(u32x4*)(x2b + off) = w; }
                ss += __shfl_xor(ss, 16); ss += __shfl_xor(ss, 32);
                if (fq == 0) ssq2[(size_t)(u.pn * 4 + wc) * NT + row] = ss;
            }
    }
};
struct EpiRouterF { static constexpr bool PERM = true, AFTER_DRAIN = true;
    const float* ssq2; const float* bg; const float* be; int* toke; float* tokg; float* rstd2; int* bidx; unsigned* cnt;
    __device__ __forceinline__ void fused(const f32x4 (&acc)[2][2][4][2], const pg8::Unit& u, int wr, int wc, int fr, int fq, LAS unsigned char* lds, int wid, int lane) const {
        LAS float* LG = (LAS float*)lds;
        LAS unsigned* cl = (LAS unsigned*)(lds + 80 * 1024);
        LAS unsigned* clp = cl + 128;
        const int tid = threadIdx.x;
        if (tid < 128) cl[tid] = 0u;
        if (tid < 448) clp[tid] = 0u;
        if (wc == 0) {
#pragma unroll
            for (int ai = 0; ai < 2; ++ai)
#pragma unroll
                for (int m = 0; m < 4; ++m) { const int r = ai * 128 + wr * 64 + m * 16 + fr;
#pragma unroll
                    for (int bj = 0; bj < 2; ++bj)
#pragma unroll
                        for (int n = 0; n < 2; ++n)
#pragma unroll
                            for (int i = 0; i < 4; ++i) LG[r * 73 + 32 * bj + 8 * fq + 4 * n + i] = acc[ai][bj][m][n][i]; }
        } else if (wc == 1 && fq == 0) {
#pragma unroll
            for (int ai = 0; ai < 2; ++ai)
#pragma unroll
                for (int m = 0; m < 4; ++m) { const int r = ai * 128 + wr * 64 + m * 16 + fr;
#pragma unroll
                    for (int n = 0; n < 2; ++n)
#pragma unroll
                        for (int i = 0; i < 4; ++i) LG[r * 73 + 64 + 4 * n + i] = acc[ai][0][m][n][i]; }
        }
        __syncthreads();
        int e0 = 0, e1 = 0, pb = 0, slo = 0; unsigned r0 = 0, r1 = 0, rp = 0; const int tok = u.pm * 256 + tid;
        if (tid < 256) {
            float ss = 0.f;
#pragma unroll
            for (int p = 0; p < 16; ++p) ss += ssq2[(size_t)p * NT + tok];
            const float rstd = rsqrtf(ss * (1.f / DM) + EPS);
            const LAS float* lg = LG + tid * 73;
            float gl[8];
#pragma unroll
            for (int n = 0; n < 8; ++n) gl[n] = lg[64 + n] * rstd + bg[n];
            int gs = 0; float gm = gl[0];
#pragma unroll
            for (int n = 1; n < 8; ++n) if (gl[n] > gm) { gm = gl[n]; gs = n; }
            float den = 0.f;
#pragma unroll
            for (int n = 0; n < 8; ++n) den += __expf(gl[n] - gm);
            const float gp = 1.f / den;
            float el[8];
#pragma unroll
            for (int n = 0; n < 8; ++n) el[n] = lg[gs * 8 + n] * rstd + be[gs * 8 + n];
            int i1 = 0; float v1 = el[0];
#pragma unroll
            for (int n = 1; n < 8; ++n) if (el[n] > v1) { v1 = el[n]; i1 = n; }
            int i2 = 0; float v2 = -3.0e38f;
#pragma unroll
            for (int n = 0; n < 8; ++n) if (n != i1 && el[n] > v2) { v2 = el[n]; i2 = n; }
            const float ex = __expf(v2 - v1), p1 = 1.f / (1.f + ex), p2 = ex * p1;
            e0 = gs * 8 + i1; e1 = gs * 8 + i2;
            tokg[tok * 2] = gp * p1; tokg[tok * 2 + 1] = gp * p2; rstd2[tok] = rstd;
            r0 = __hip_atomic_fetch_add(cl + e0, 1u, __ATOMIC_RELAXED, __HIP_MEMORY_SCOPE_WORKGROUP);
            r1 = __hip_atomic_fetch_add(cl + e1, 1u, __ATOMIC_RELAXED, __HIP_MEMORY_SCOPE_WORKGROUP);
            { const int lo = i1 < i2 ? i1 : i2, hi = i1 < i2 ? i2 : i1; slo = i1 < i2 ? 0 : 1; pb = gs * 28 + (lo * (15 - lo)) / 2 + (hi - lo - 1); }
            rp = __hip_atomic_fetch_add(clp + pb, 1u, __ATOMIC_RELAXED, __HIP_MEMORY_SCOPE_WORKGROUP);
        }
        __syncthreads();
        if (tid < 64) { const unsigned c = cl[tid]; cl[64 + tid] = c ? __hip_atomic_fetch_add(cnt + tid, c, __ATOMIC_RELAXED, __HIP_MEMORY_SCOPE_AGENT) : 0u; }
        else if (tid >= 256 && tid < 256 + 224) { const int q = tid - 256; const unsigned c = clp[q]; clp[224 + q] = c ? __hip_atomic_fetch_add(cnt + (CW_PCNT - CW_CNT) + q, c, __ATOMIC_RELAXED, __HIP_MEMORY_SCOPE_AGENT) : 0u; }
        __syncthreads();
        if (tid < 256) { bidx[(size_t)e0 * 65536 + cl[64 + e0] + r0] = tok; bidx[(size_t)e1 * 65536 + cl[64 + e1] + r1] = tok | (1 << 16);
            toke[tok] = (int)(clp[224 + pb] + rp) | (pb << 16) | (slo << 24); }
    }
};
struct EpiMoe1F { static constexpr bool PERM = true, AFTER_DRAIN = false;
    bf16* hid2; const LAS float* rscale; const LAS unsigned* dest; const LAS float* gate;
    __device__ __forceinline__ void operator()(const f32x4 (&acc)[2][2][4][2], const pg8::Unit& u, int wr, int wc, int fr, int fq) const {
#pragma unroll
        for (int ai = 0; ai < 2; ++ai)
#pragma unroll
            for (int m = 0; m < 4; ++m) { const int r = ai * 128 + wr * 64 + m * 16 + fr; const float rs = rscale[u.ts * 256 + r], gt = gate[u.ts * 256 + r]; const unsigned d = dest[u.ts * 256 + r];
                float h[8];
#pragma unroll
                for (int n = 0; n < 2; ++n)
#pragma unroll
                    for (int i = 0; i < 4; ++i) { const float gv = acc[ai][0][m][n][i] * rs, up = acc[ai][1][m][n][i] * rs; h[4 * n + i] = gv * up * gt * __builtin_amdgcn_rcpf(1.f + __expf(-gv)); }
                u32x4 w; w.x = cvt_pk_bf16_asm(h[0], h[1]); w.y = cvt_pk_bf16_asm(h[2], h[3]); w.z = cvt_pk_bf16_asm(h[4], h[5]); w.w = cvt_pk_bf16_asm(h[6], h[7]);
                if (d != 0xffffffffu) *(u32x4*)((char*)hid2 + d + (unsigned)((u.pn * 128 + wc * 32 + 8 * fq) * 2)) = w;
                __builtin_amdgcn_sched_barrier(0); }
    }
};
struct EpiMoe2F { static constexpr bool PERM = true, AFTER_DRAIN = false;
    const bf16* x2b; float* out; const LAS unsigned* tokp1;
    __device__ __forceinline__ void operator()(const f32x4 (&acc)[2][2][4][2], const pg8::Unit& u, int wr, int wc, int fr, int fq) const {
#pragma unroll
        for (int ai = 0; ai < 2; ++ai) {
            unsigned off0[4]; u32x4 xr[4][2];
#pragma unroll
            for (int m = 0; m < 4; ++m) { const unsigned t1 = tokp1[u.ts * 256 + ai * 128 + wr * 64 + m * 16 + fr];
                off0[m] = t1 ? (t1 - 1u) * (unsigned)DM + (unsigned)(u.pn * 256 + wc * 32 + 8 * fq) : 0xffffffffu;
#pragma unroll
                for (int bj = 0; bj < 2; ++bj) xr[m][bj] = *(const u32x4*)(x2b + (t1 ? off0[m] + bj * 128 : 0u)); }
#pragma unroll
            for (int m = 0; m < 4; ++m) if (off0[m] != 0xffffffffu) {
#pragma unroll
                for (int bj = 0; bj < 2; ++bj) { const unsigned off = off0[m] + bj * 128; const u32x4 x = xr[m][bj];
                    f32x4 o0, o1; o0[0] = __builtin_bit_cast(float, x.x << 16); o0[1] = __builtin_bit_cast(float, x.x & 0xffff0000u); o0[2] = __builtin_bit_cast(float, x.y << 16); o0[3] = __builtin_bit_cast(float, x.y & 0xffff0000u);
                    o1[0] = __builtin_bit_cast(float, x.z << 16); o1[1] = __builtin_bit_cast(float, x.z & 0xffff0000u); o1[2] = __builtin_bit_cast(float, x.w << 16); o1[3] = __builtin_bit_cast(float, x.w & 0xffff0000u);
                    __builtin_nontemporal_store(o0 + acc[ai][bj][m][0], (f32x4*)(out + off)); __builtin_nontemporal_store(o1 + acc[ai][bj][m][1], (f32x4*)(out + off + 4)); } }
            __builtin_amdgcn_sched_barrier(0); }
    }
};
struct MoeSched { const LAS int* tab; int n;
    __device__ __forceinline__ bool next(int i, pg8::Unit& u) const { if (i >= n) return false;
        u.pm = __builtin_amdgcn_readfirstlane(tab[8 * i]); u.pn = __builtin_amdgcn_readfirstlane(tab[8 * i + 1]); u.e = __builtin_amdgcn_readfirstlane(tab[8 * i + 2]); u.ts = __builtin_amdgcn_readfirstlane(tab[8 * i + 3]);
        u.e2 = __builtin_amdgcn_readfirstlane(tab[8 * i + 4]); return true; }
};

struct Args { const float* in[20]; float* out; unsigned char* ws; int ph_lo, ph_hi; };
struct Frame { LAS unsigned char* lds; int tid, lane, wave, vcu, G; unsigned char* ws; };

template <class RowMap>
__device__ __forceinline__ void p0_transpose_item(const float* W, int ldw, int k0, int n0, const float* ksc, bf16* dst, int Kd, const RowMap& rm, LAS float* scr, int lane) {
    const int kr = lane >> 4, nq = lane & 15;
    f32x4 tv[16];
#pragma unroll
    for (int i = 0; i < 16; ++i) tv[i] = *(const f32x4*)(W + (size_t)(k0 + 4 * i + kr) * ldw + n0 + 4 * nq);
    if (ksc) {
#pragma unroll
        for (int i = 0; i < 16; ++i) tv[i] = tv[i] * ksc[k0 + 4 * i + kr]; }
#pragma unroll
    for (int i = 0; i < 16; ++i) { LAS float* d = scr + (4 * i + kr) * 65 + 4 * nq; d[0] = tv[i][0]; d[1] = tv[i][1]; d[2] = tv[i][2]; d[3] = tv[i][3]; }
    LDS_WAIT(); asm volatile("" ::: "memory");
    const int c = lane & 7;
#pragma unroll
    for (int j = 0; j < 8; ++j) { const int n = (lane >> 3) + 8 * j; const LAS float* sp = scr + (8 * c) * 65 + n;
        u32x4 o; o.x = cvt_pk_bf16(sp[0 * 65], sp[1 * 65]); o.y = cvt_pk_bf16(sp[2 * 65], sp[3 * 65]); o.z = cvt_pk_bf16(sp[4 * 65], sp[5 * 65]); o.w = cvt_pk_bf16(sp[6 * 65], sp[7 * 65]);
        *(u32x4*)(dst + (size_t)rm(n0 + n) * Kd + k0 + 8 * c) = o; }
    LDS_WAIT(); asm volatile("" ::: "memory");
}
struct RmIn  { __device__ __forceinline__ int operator()(int n) const { const int pn = n >> 8, lc = n & 255; return pn * 256 + 128 * ((lc >> 5) & 1) + 32 * (lc >> 6) + (lc & 31); } };
struct RmId  { int off; __device__ __forceinline__ int operator()(int n) const { return off + n; } };
struct RmGU  { int e, u; __device__ __forceinline__ int operator()(int n) const { return e * 512 + 256 * (n >> 7) + 128 * u + (n & 127); } };

__device__ __forceinline__ void phase0(const Frame& F, const Args& a) {
    const float* x = a.in[0]; const float* ln1_g = a.in[1]; const float* w_in = a.in[2];
    const float* w_out = a.in[11]; const float* ln2_g = a.in[12]; const float* wg_r = a.in[13]; const float* we_r = a.in[15];
    const float* w_gate = a.in[17]; const float* w_up = a.in[18]; const float* w_down = a.in[19];
    bf16* WinT = (bf16*)(F.ws + WS_WIN); bf16* WoT = (bf16*)(F.ws + WS_WO); bf16* WrT = (bf16*)(F.ws + WS_WR); bf16* WguT = (bf16*)(F.ws + WS_WGU); bf16* WdT = (bf16*)(F.ws + WS_WD);
    bf16* XN = (bf16*)(F.ws + WS_A);
    LAS float* scr = (LAS float*)(F.lds + F.wave * 16640);
    const int gw = F.vcu * NWAVES + F.wave, NGW = F.G * NWAVES;
    constexpr int I_IN = 16 * 56, I_O = 16 * 16, I_G = 64 * 16 * 4, I_D = 64 * 4 * 16, I_R = 512;
    constexpr int NITEMS = I_IN + I_O + 2 * I_G + I_D + I_R;
#ifndef P0_REP_ITEMS
#define P0_REP_ITEMS 1
#endif
#ifndef P0_REP_ROWS
#define P0_REP_ROWS 1
#endif
#ifndef P0_NOITEMS
    for (int rep = 0; rep < P0_REP_ITEMS; ++rep)
    for (int it = gw; it < NITEMS; it += NGW) {
        int r = it;
        if (r < I_IN) { p0_transpose_item(w_in, INC, 64 * (r / 56), 64 * (r % 56), nullptr, WinT, DM, RmIn{}, scr, F.lane); continue; } r -= I_IN;
        if (r < I_O) { p0_transpose_item(w_out, DM, 64 * (r / 16), 64 * (r % 16), nullptr, WoT, DM, RmId{0}, scr, F.lane); continue; } r -= I_O;
        if (r < 2 * I_G) { const int u = r / I_G; r -= u * I_G; const int e = r / 64, q = r % 64;
            p0_transpose_item((u ? w_up : w_gate) + (size_t)e * DM * DE, DE, 64 * (q / 4), 64 * (q % 4), ln2_g, WguT, DM, RmGU{e, u}, scr, F.lane); continue; } r -= 2 * I_G;
        if (r < I_D) { const int e = r / 64, q = r % 64; p0_transpose_item(w_down + (size_t)e * DE * DM, DM, 64 * (q / 16), 64 * (q % 16), nullptr, WdT, DE, RmId{e * DM}, scr, F.lane); continue; } r -= I_D;
        if (r >= 256) {
            r -= 256; unsigned w[8];
#pragma unroll
            for (int j = 0; j < 8; ++j) { float v0 = 0.f, v1 = 0.f; const int k = F.lane * 16 + 2 * j;
                if (r < 32) { v0 = w_in[(size_t)k * INC + PC + (r & 15)]; v1 = w_in[(size_t)(k + 1) * INC + PC + (r & 15)];
                    if (r >= 16) { v0 -= __builtin_bit_cast(float, (unsigned)f2bf(v0) << 16); v1 -= __builtin_bit_cast(float, (unsigned)f2bf(v1) << 16); } }
                w[j] = pk2(v0, v1); }
            u32x4* dp = (u32x4*)(WinT + (size_t)(PC + r) * DM + F.lane * 16);
            dp[0] = (u32x4){w[0], w[1], w[2], w[3]}; dp[1] = (u32x4){w[4], w[5], w[6], w[7]};
            continue; }
        {
            const float* src = nullptr; int ld = 0, col = 0;
            if (r < 32) { src = we_r; ld = 64; col = r; } else if (r >= 128 && r < 160) { src = we_r; ld = 64; col = 32 + (r - 128); } else if (r >= 32 && r < 40) { src = wg_r; ld = 8; col = r - 32; }
            unsigned w[8];
#pragma unroll
            for (int j = 0; j < 8; ++j) { const int k = F.lane * 16 + 2 * j; float v0 = 0.f, v1 = 0.f; if (src) { v0 = src[(size_t)k * ld + col] * ln2_g[k]; v1 = src[(size_t)(k + 1) * ld + col] * ln2_g[k + 1]; } w[j] = pk2(v0, v1); }
            u32x4* dp = (u32x4*)(WrT + (size_t)r * DM + F.lane * 16);
            dp[0] = (u32x4){w[0], w[1], w[2], w[3]}; dp[1] = (u32x4){w[4], w[5], w[6], w[7]};
        }
    }
#endif
#ifndef P0_NOROWS
    {
    const f32x4* gr = (const f32x4*)ln1_g + F.lane;
    f32x4 nx[4], ny[4];
    if (gw < NT) { const f32x4* xr = (const f32x4*)(x + (size_t)gw * DM) + F.lane;
#pragma unroll
        for (int j = 0; j < 4; ++j) nx[j] = xr[64 * j]; }
    if (gw + NGW < NT) { const f32x4* xr = (const f32x4*)(x + (size_t)(gw + NGW) * DM) + F.lane;
#pragma unroll
        for (int j = 0; j < 4; ++j) ny[j] = xr[64 * j]; }
    for (int rep = 0; rep < P0_REP_ROWS; ++rep)
    for (int m = gw; m < NT; m += NGW) {
        f32x4 v[4]; float s = 0.f;
#pragma unroll
        for (int j = 0; j < 4; ++j) { v[j] = nx[j]; s += (v[j].x * v[j].x + v[j].y * v[j].y) + (v[j].z * v[j].z + v[j].w * v[j].w); }
#pragma unroll
        for (int j = 0; j < 4; ++j) nx[j] = ny[j];
        if (m + 2 * NGW < NT) { const f32x4* xr = (const f32x4*)(x + (size_t)(m + 2 * NGW) * DM) + F.lane;
#pragma unroll
            for (int j = 0; j < 4; ++j) ny[j] = xr[64 * j]; }
        const float rstd = rsqrtf(wave_sum(s) * (1.f / DM) + EPS);
        unsigned long long* o8 = (unsigned long long*)(XN + (size_t)m * DM) + F.lane;
#pragma unroll
        for (int j = 0; j < 4; ++j) { v[j] = v[j] * rstd * gr[64 * j];
            o8[64 * j] = (unsigned long long)cvt_pk_bf16(v[j].x, v[j].y) | ((unsigned long long)cvt_pk_bf16(v[j].z, v[j].w) << 32); }
    }
    }
#endif
}

constexpr int TB_PRE = 0  , TB_UT = 512  , TB_PT = 1024  , TB_T = 2048  ;
__device__ __forceinline__ void moe_prefixes(const Frame& F) {
    const unsigned* cnt = (const unsigned*)(F.ws + WS_CTL) + CW_CNT; const unsigned* pcnt = (const unsigned*)(F.ws + WS_CTL) + CW_PCNT;
    LAS int* pre = (LAS int*)(F.lds + TAB_OFF + TB_PRE); LAS int* pt = (LAS int*)(F.lds + TAB_OFF + TB_PT);
    if (F.tid < 64) pre[F.tid] = (int)((__hip_atomic_load(cnt + F.tid, RLX_AGENT) + 255u) >> 8);
    else if (F.tid >= 128 && F.tid < 128 + 224) pt[F.tid - 128] = (int)((__hip_atomic_load(pcnt + (F.tid - 128), RLX_AGENT) + 255u) >> 8);
    __syncthreads();
    if (F.tid == 0) { int s = 0; for (int e = 0; e < 64; ++e) { const int t = pre[e]; pre[e] = s; s += t; } pre[64] = s; }
    if (F.tid == 64) { int s = 0; for (int q = 0; q < 224; ++q) { const int t = pt[q]; pt[q] = s; s += t; } pt[224] = s; }
    __syncthreads();
}
__device__ __forceinline__ int moe_setup1(const Frame& F) {
    const unsigned* cnt = (const unsigned*)(F.ws + WS_CTL) + CW_CNT;
    LAS int* pre = (LAS int*)(F.lds + TAB_OFF + TB_PRE); LAS int* pt = (LAS int*)(F.lds + TAB_OFF + TB_PT); LAS int* ut = (LAS int*)(F.lds + TAB_OFF + TB_UT);
    LAS unsigned* t0 = (LAS unsigned*)(F.lds + TAB_OFF + TB_T); LAS float* t1 = (LAS float*)(t0 + 6 * 256); LAS unsigned* t2 = t0 + 12 * 256; LAS float* t3 = (LAS float*)(t0 + 18 * 256);
    const int* bidx = (const int*)(F.ws + WS_BIDX); const float* rstd2 = (const float*)(F.ws + WS_RSTD2); const float* tokg = (const float*)(F.ws + WS_TOKG); const int* tokp = (const int*)(F.ws + WS_TOKP);
    unsigned* r2t = (unsigned*)(F.ws + WS_R2T);
    moe_prefixes(F);
    for (int tok = F.vcu * NTHR + F.tid; tok < NT; tok += F.G * NTHR) { const int tp = tokp[tok]; r2t[256 * pt[(tp >> 16) & 0xff] + (tp & 0xffff)] = (unsigned)tok + 1u; }
    const int total = pre[64] * 2;
    int n = 0; for (int i = 0; i < 6; ++i) if ((long)i * F.G + F.vcu < total) n = i + 1;
    if (F.tid < n) { const int L = F.tid * F.G + F.vcu; const int rtg = L >> 1, pn = L & 1; int e = 0; for (int q = 0; q < 64; ++q) if (pre[q + 1] <= rtg) e = q + 1;
        ut[8 * F.tid] = rtg; ut[8 * F.tid + 1] = pn; ut[8 * F.tid + 2] = e; ut[8 * F.tid + 3] = F.tid; ut[8 * F.tid + 4] = e; }
    __syncthreads();
    { int ts3[3]; bool val3[3]; int tp3[3]; float rs3[3], g3[3];
#pragma unroll
      for (int k = 0; k < 3; ++k) { const int x = F.tid + NTHR * k; ts3[k] = 0; val3[k] = false;
          if (x < n * 256) { const int i = x >> 8, r = x & 255, rtg = ut[8 * i], e = ut[8 * i + 2]; const int idx = (rtg - pre[e]) * 256 + r; const int c = (int)__hip_atomic_load(cnt + e, RLX_AGENT);
              val3[k] = idx < c; ts3[k] = bidx[(size_t)e * 65536 + (val3[k] ? idx : 0)]; } }
#pragma unroll
      for (int k = 0; k < 3; ++k) { const int tok = ts3[k] & 0xffff, slot = ts3[k] >> 16; tp3[k] = tokp[tok]; rs3[k] = rstd2[tok]; g3[k] = tokg[tok * 2 + slot]; }
#pragma unroll
      for (int k = 0; k < 3; ++k) { const int x = F.tid + NTHR * k;
          if (x < n * 256) { const int tok = ts3[k] & 0xffff, slot = ts3[k] >> 16, tp = tp3[k];
              t0[x] = (unsigned)tok * (unsigned)(DM * 2); t1[x] = val3[k] ? rs3[k] : 0.f;
              t2[x] = val3[k] ? (unsigned)(256 * pt[(tp >> 16) & 0xff] + (tp & 0xffff)) * 1024u + (slot == ((tp >> 24) & 1) ? 0u : 512u) : 0xffffffffu;
              t3[x] = g3[k]; } } }
    __syncthreads();
    return n;
}
__device__ __forceinline__ int moe_setup2(const Frame& F) {
    LAS int* pt = (LAS int*)(F.lds + TAB_OFF + TB_PT); LAS int* ut = (LAS int*)(F.lds + TAB_OFF + TB_UT); LAS unsigned* t0 = (LAS unsigned*)(F.lds + TAB_OFF + TB_T);
    const unsigned* r2t = (const unsigned*)(F.ws + WS_R2T);
    moe_prefixes(F);
    const int total = pt[224] * 4;
    int n = 0; for (int i = 0; i < 8; ++i) if ((long)i * F.G + F.vcu < total) n = i + 1;
    if (F.tid < n) { const int L = F.tid * F.G + F.vcu; const int rtg = L >> 2, pn = L & 3; int pb = 0; for (int q = 0; q < 224; ++q) if (pt[q + 1] <= rtg) pb = q + 1;
        const int gs = pb / 28, pi = pb - 28 * gs; int lo = 0; for (int l = 0; l < 7; ++l) if (pi >= (l * (15 - l)) / 2) lo = l; const int hi = lo + 1 + pi - (lo * (15 - lo)) / 2;
        ut[8 * F.tid] = rtg; ut[8 * F.tid + 1] = pn; ut[8 * F.tid + 2] = gs * 8 + lo; ut[8 * F.tid + 3] = F.tid; ut[8 * F.tid + 4] = gs * 8 + hi; }
    __syncthreads();
    { unsigned v4[4];
#pragma unroll
      for (int k = 0; k < 4; ++k) { const int x = F.tid + NTHR * k; v4[k] = 0u; if (x < n * 256) v4[k] = r2t[(size_t)ut[8 * (x >> 8)] * 256 + (x & 255)]; }
#pragma unroll
      for (int k = 0; k < 4; ++k) { const int x = F.tid + NTHR * k; if (x < n * 256) t0[x] = v4[k]; } }
    __syncthreads();
    return n;
}

typedef short v4i16_t __attribute__((ext_vector_type(4)));
constexpr int NA_SLOT = 16384, NA_NSLOT = 9, NA_MRG = NA_NSLOT * NA_SLOT, NA_MRGL = NA_MRG + 8192, NA_BT = NA_MRGL + 1024;
__device__ __forceinline__ int na_swz(int key) { return ((key >> 1) & 3) << 1; }
__device__ __forceinline__ void na_stage_row(const Frame& F, const bf16* pbh, int bandrow) {
    const int key = 8 * F.wave + (F.lane >> 3), c = (F.lane & 7) ^ na_swz(key);
    const bf16* src = pbh + (size_t)(bandrow * GW + key) * PC + c * 8;
    LAS unsigned char* dst = F.lds + (bandrow % NA_NSLOT) * NA_SLOT + F.wave * 1024;
    __builtin_amdgcn_global_load_lds((const unsigned*)(src + C_AK), (LAS unsigned*)dst, 16, 0, 0);
    __builtin_amdgcn_global_load_lds((const unsigned*)(src + C_AV), (LAS unsigned*)(dst + 8192), 16, 0, 0);
}
__device__ __forceinline__ void phase_na(const Frame& F, const Args& a) {
    const bf16* PROJ = (const bf16*)(F.ws + WS_PROJ); bf16* MIX = (bf16*)(F.ws + WS_MIX); const float* rpb = a.in[5];
    const int j = F.wave & 3, bh = F.wave >> 2, g = F.lane >> 4, li = F.lane & 15, c = 16 * j + li;
    const int ks0 = j == 0 ? 0 : (j == 1 ? 8 : (j == 2 ? 24 : 32));
    int c0 = c - KW / 2; c0 = c0 < 0 ? 0 : (c0 > GW - KW ? GW - KW : c0);
    LAS float* bt = (LAS float*)(F.lds + NA_BT);
    for (int unit = F.vcu; unit < BATCH * AH * 2; unit += F.G) {
        const int b = unit >> 4, h = (unit >> 1) & 7, rs = (unit & 1) * 32;
        const bf16* pbh = PROJ + (size_t)b * SEQ * PC + h * ADH;
        float mq = fabsf(a.in[3][F.lane]), mk = fabsf(a.in[4][F.lane]);
#pragma unroll
        for (int o = 1; o < 64; o <<= 1) { mq = fmaxf(mq, __shfl_xor(mq, o)); mk = fmaxf(mk, __shfl_xor(mk, o)); }
        float mb = 0.f; for (int i = F.lane; i < 15 * 31; i += 64) mb = fmaxf(mb, fabsf(rpb[h * 465 + i]));
#pragma unroll
        for (int o = 1; o < 64; o <<= 1) mb = fmaxf(mb, __shfl_xor(mb, o));
        const float cshift = 64.f * 0.125f * LOG2E * mq * mk + mb * LOG2E;
        __syncthreads();
        for (int i = F.tid; i < 15 * 31; i += NTHR) bt[i] = rpb[h * 465 + i] * LOG2E - cshift;
        int r0 = rs - KH / 2; r0 = r0 < 0 ? 0 : (r0 > ROWS - KH ? ROWS - KH : r0);
        for (int i = 0; i < KH; ++i) na_stage_row(F, pbh, r0 + i);
        VM_WAIT(); __syncthreads();
        const int pkey = 8 * F.wave + (F.lane >> 3), pch = (F.lane & 7) ^ na_swz(pkey);
        auto r0_of = [](int r) { int v = r - KH / 2; return v < 0 ? 0 : (v > ROWS - KH ? ROWS - KH : v); };
        u32x4 pk = {0u, 0u, 0u, 0u}, pv = {0u, 0u, 0u, 0u};
        if (rs + 1 < rs + 32 && r0_of(rs + 1) != r0_of(rs)) { const bf16* src = pbh + (size_t)((r0_of(rs + 1) + KH - 1) * GW + pkey) * PC + pch * 8; pk = *(const u32x4*)(src + C_AK); pv = *(const u32x4*)(src + C_AV); }
        float bias[8][4]; int prev_ro = -100;
        bf16x8 qn[2];
#pragma unroll
        for (int ks = 0; ks < 2; ++ks) qn[ks] = *(const bf16x8*)(PROJ + ((size_t)b * SEQ + rs * GW + c) * PC + C_AQ + h * ADH + 32 * ks + 8 * g);
        for (int r = rs; r < rs + 32; ++r) {
            r0 = r - KH / 2; r0 = r0 < 0 ? 0 : (r0 > ROWS - KH ? ROWS - KH : r0);
            if (r + 1 < rs + 32 && r0_of(r + 1) != r0) { LAS unsigned char* dst = F.lds + ((r0_of(r + 1) + KH - 1) % NA_NSLOT) * NA_SLOT + F.wave * 1024 + F.lane * 16;
                *(LAS u32x4*)dst = pk; *(LAS u32x4*)(dst + 8192) = pv; }
            if (r + 2 < rs + 32 && r0_of(r + 2) != r0_of(r + 1)) { const bf16* src = pbh + (size_t)((r0_of(r + 2) + KH - 1) * GW + pkey) * PC + pch * 8; pk = *(const u32x4*)(src + C_AK); pv = *(const u32x4*)(src + C_AV); }
            const int ro = r0 - r + (KH - 1) + 4 * bh;
            if (ro != prev_ro) { prev_ro = ro;
#pragma unroll
                for (int i4 = 0; i4 < 4; ++i4)
#pragma unroll
                    for (int t = 0; t < 2; ++t)
#pragma unroll
                        for (int q = 0; q < 4; ++q) { const int kc = ks0 + 16 * t + 4 * g + q; const bool valid = kc >= c0 && kc < c0 + KW;
                            bias[i4 * 2 + t][q] = valid ? bt[(ro + i4) * 31 + (kc - c + KW - 1)] : -1.0e30f; } }
            const size_t qtok = (size_t)b * SEQ + r * GW + c;
            bf16x8 qf[2]; qf[0] = qn[0]; qf[1] = qn[1];
            { const size_t ntok = qtok + (r + 1 < rs + 32 ? GW : 0);
#pragma unroll
              for (int ks = 0; ks < 2; ++ks) qn[ks] = *(const bf16x8*)(PROJ + ntok * PC + C_AQ + h * ADH + 32 * ks + 8 * g); }
            f32x4 sacc[8];
#pragma unroll
            for (int i4 = 0; i4 < 4; ++i4) { const LAS unsigned char* ks_ = F.lds + ((r0 + 4 * bh + i4) % NA_NSLOT) * NA_SLOT;
#pragma unroll
                for (int t = 0; t < 2; ++t) { const int row = ks0 + 16 * t + li; f32x4 acc = {bias[i4 * 2 + t][0], bias[i4 * 2 + t][1], bias[i4 * 2 + t][2], bias[i4 * 2 + t][3]};
#pragma unroll
                    for (int ks = 0; ks < 2; ++ks) { const bf16x8 kf = *(const LAS bf16x8*)(ks_ + row * 128 + (((g + 4 * ks) ^ na_swz(row)) << 4));
                        acc = __builtin_amdgcn_mfma_f32_16x16x32_bf16(kf, qf[ks], acc, 0, 0, 0); }
                    sacc[i4 * 2 + t] = acc; } }
            f32x2_t ls2 = {0.f, 0.f};
#pragma unroll
            for (int x = 0; x < 8; ++x) {
#pragma unroll
                for (int q = 0; q < 4; ++q) sacc[x][q] = __builtin_amdgcn_exp2f(sacc[x][q]);
                ls2 += (f32x2_t){sacc[x][0], sacc[x][1]}; ls2 += (f32x2_t){sacc[x][2], sacc[x][3]}; }
            float lsum = ls2[0] + ls2[1];
            f32x4 oacc[4];
#pragma unroll
            for (int dt = 0; dt < 4; ++dt) oacc[dt] = (f32x4){0.f, 0.f, 0.f, 0.f};
#pragma unroll
            for (int m = 0; m < 4; ++m) {
                const int xa = 2 * m, xb = 2 * m + 1;
                bf16x8 pf; { const unsigned w0 = cvt_pk_bf16(sacc[xa][0], sacc[xa][1]), w1 = cvt_pk_bf16(sacc[xa][2], sacc[xa][3]), w2 = cvt_pk_bf16(sacc[xb][0], sacc[xb][1]), w3 = cvt_pk_bf16(sacc[xb][2], sacc[xb][3]);
                    pf = __builtin_bit_cast(bf16x8, (u32x4){w0, w1, w2, w3}); }
                const LAS unsigned char* va = F.lds + ((r0 + 4 * bh + m) % NA_NSLOT) * NA_SLOT + 8192; const LAS unsigned char* vb = va;
                const int rowa = ks0 + 4 * g + (li >> 2), rowb = ks0 + 16 + 4 * g + (li >> 2);
#pragma unroll
                for (int dt = 0; dt < 4; ++dt) { const int cc = 2 * dt + ((li & 3) >> 1), hb = (li & 1) * 8;
                    const v4i16_t ta = __builtin_amdgcn_ds_read_tr16_b64_v4i16((LAS v4i16_t*)(va + rowa * 128 + ((cc ^ na_swz(rowa)) << 4) + hb));
                    const v4i16_t tb = __builtin_amdgcn_ds_read_tr16_b64_v4i16((LAS v4i16_t*)(vb + rowb * 128 + ((cc ^ na_swz(rowb)) << 4) + hb));
                    bf16x8 vf; vf[0] = ta[0]; vf[1] = ta[1]; vf[2] = ta[2]; vf[3] = ta[3]; vf[4] = tb[0]; vf[5] = tb[1]; vf[6] = tb[2]; vf[7] = tb[3];
                    oacc[dt] = __builtin_amdgcn_mfma_f32_16x16x32_bf16(vf, pf, oacc[dt], 0, 0, 0); }
            }
            LAS unsigned char* mrg = F.lds + NA_MRG + (j * 64 + F.lane) * 32; LAS float* mrl = (LAS float*)(F.lds + NA_MRGL) + j * 64 + F.lane;
            if (bh == 1) {
                u32x4 w0, w1; w0.x = cvt_pk_bf16(oacc[0][0], oacc[0][1]); w0.y = cvt_pk_bf16(oacc[0][2], oacc[0][3]); w0.z = cvt_pk_bf16(oacc[1][0], oacc[1][1]); w0.w = cvt_pk_bf16(oacc[1][2], oacc[1][3]);
                w1.x = cvt_pk_bf16(oacc[2][0], oacc[2][1]); w1.y = cvt_pk_bf16(oacc[2][2], oacc[2][3]); w1.z = cvt_pk_bf16(oacc[3][0], oacc[3][1]); w1.w = cvt_pk_bf16(oacc[3][2], oacc[3][3]);
                *(LAS u32x4*)mrg = w0; *(LAS u32x4*)(mrg + 16) = w1; *mrl = lsum;
            }
            LDS_BAR();
            if (bh == 0) {
                const u32x4 w0 = *(const LAS u32x4*)mrg, w1 = *(const LAS u32x4*)(mrg + 16); lsum += *mrl;
                lsum += __shfl_xor(lsum, 16); lsum += __shfl_xor(lsum, 32);
                const float inv = 1.f / lsum;
                bf16* op = MIX + qtok * DM + h * ADH + 4 * g;
#pragma unroll
                for (int dt = 0; dt < 4; ++dt) { const unsigned pa = dt < 2 ? (dt == 0 ? w0.x : w0.z) : (dt == 2 ? w1.x : w1.z), pb = dt < 2 ? (dt == 0 ? w0.y : w0.w) : (dt == 2 ? w1.y : w1.w);
                    const float o0 = (oacc[dt][0] + __builtin_bit_cast(float, pa << 16)) * inv, o1 = (oacc[dt][1] + __builtin_bit_cast(float, pa & 0xffff0000u)) * inv;
                    const float o2 = (oacc[dt][2] + __builtin_bit_cast(float, pb << 16)) * inv, o3 = (oacc[dt][3] + __builtin_bit_cast(float, pb & 0xffff0000u)) * inv;
                    *(unsigned long long*)(op + 16 * dt) = (unsigned long long)cvt_pk_bf16(o0, o1) | ((unsigned long long)cvt_pk_bf16(o2, o3) << 32); }
            }
            LDS_BAR();
        }
    }
}


typedef float f32x16 __attribute__((ext_vector_type(16)));
constexpr size_t WS_GCL = WS_G, WS_BETAL = WS_BETA;
constexpr int P3_QN = 0, P3_KN = 16384, P3_LF = 32768, P3_LB = P3_LF + 17408, P3_TF = P3_LB + 17408, P3_TB = P3_TF + 17408, P3_CW = P3_TB + 17408, P3_SC = P3_CW + 7680, P3_RAW = P3_SC + 1024, LST = 68;
__device__ __forceinline__ unsigned off_b(unsigned row, unsigned ch) { return 256u * row + 16u * (ch ^ (((row & 3) << 2) | ((row >> 2) & 3))); }
__device__ __forceinline__ unsigned rowread_b(unsigned lane, unsigned rowbase, unsigned s) { return off_b(rowbase + (lane & 31), 2 * s + (lane >> 5)); }
__device__ __forceinline__ void dn_inverse(LAS float* LS, LAS float* TS, int lane) {
    for (int i = lane; i < 64 * LST / 4; i += 64) ((LAS f32x4*)TS)[i] = (f32x4){0.f, 0.f, 0.f, 0.f};
    { const int blk = lane >> 4, col = lane & 15; float xa[16];
#pragma unroll
      for (int i = 0; i < 16; ++i) xa[i] = (i == col) ? 1.f : 0.f;
#pragma unroll
      for (int k = 0; k < 16; ++k) { const float xk = xa[k]; TS[(16 * blk + k) * LST + 16 * blk + col] = xk;
#pragma unroll
          for (int i = k + 1; i < 16; ++i) xa[i] -= LS[(16 * blk + i) * LST + 16 * blk + k] * xk; } }
    __builtin_amdgcn_sched_barrier(0);
#pragma unroll
    for (int p = 0; p < 2; ++p) { const int base = 32 * p, r = lane & 15, kq = lane >> 4;
        float a1[4], b1[4];
#pragma unroll
        for (int s4 = 0; s4 < 4; ++s4) { a1[s4] = LS[(base + 16 + r) * LST + base + kq + 4 * s4]; b1[s4] = TS[(base + kq + 4 * s4) * LST + base + r]; }
        const f32x4 a2 = *(const LAS f32x4*)(TS + (base + 16 + r) * LST + base + 16 + 4 * kq);
        __builtin_amdgcn_sched_barrier(0);
        f32x4 M = {0.f, 0.f, 0.f, 0.f};
#pragma unroll
        for (int s4 = 0; s4 < 4; ++s4) M = __builtin_amdgcn_mfma_f32_16x16x4f32(a1[s4], b1[s4], M, 0, 0, 0);
        f32x4 R = {0.f, 0.f, 0.f, 0.f};
#pragma unroll
        for (int s4 = 0; s4 < 4; ++s4) R = __builtin_amdgcn_mfma_f32_16x16x4f32(a2[s4], M[s4], R, 0, 0, 0);
#pragma unroll
        for (int e = 0; e < 4; ++e) TS[(base + 16 + 4 * kq + e) * LST + base + r] = -R[e]; }
    __builtin_amdgcn_sched_barrier(0);
    { const int r = lane & 31, kh = lane >> 5;
      bf16x8 a1[2], b1[2], a2[2];
#pragma unroll
      for (int sx = 0; sx < 2; ++sx) {
          const f32x4 l0 = *(const LAS f32x4*)(LS + (32 + r) * LST + 16 * sx + 8 * kh), l1 = *(const LAS f32x4*)(LS + (32 + r) * LST + 16 * sx + 8 * kh + 4);
          a1[sx] = __builtin_bit_cast(bf16x8, (u32x4){cvt_pk_bf16(l0[0], l0[1]), cvt_pk_bf16(l0[2], l0[3]), cvt_pk_bf16(l1[0], l1[1]), cvt_pk_bf16(l1[2], l1[3])});
          float tb[8];
#pragma unroll
          for (int j = 0; j < 8; ++j) tb[j] = TS[(16 * sx + 8 * kh + j) * LST + r];
          b1[sx] = __builtin_bit_cast(bf16x8, (u32x4){cvt_pk_bf16(tb[0], tb[1]), cvt_pk_bf16(tb[2], tb[3]), cvt_pk_bf16(tb[4], tb[5]), cvt_pk_bf16(tb[6], tb[7])});
          const f32x4 t0 = *(const LAS f32x4*)(TS + (32 + r) * LST + 32 + 16 * sx + 4 * kh), t1 = *(const LAS f32x4*)(TS + (32 + r) * LST + 32 + 16 * sx + 8 + 4 * kh);
          a2[sx] = __builtin_bit_cast(bf16x8, (u32x4){cvt_pk_bf16(t0[0], t0[1]), cvt_pk_bf16(t0[2], t0[3]), cvt_pk_bf16(t1[0], t1[1]), cvt_pk_bf16(t1[2], t1[3])}); }
      __builtin_amdgcn_sched_barrier(0);
      f32x16 M;
#pragma unroll
      for (int e = 0; e < 16; ++e) M[e] = 0.f;
#pragma unroll
      for (int sx = 0; sx < 2; ++sx) M = __builtin_amdgcn_mfma_f32_32x32x16_bf16(a1[sx], b1[sx], M, 0, 0, 0);
      f32x16 R;
#pragma unroll
      for (int e = 0; e < 16; ++e) R[e] = 0.f;
#pragma unroll
      for (int sx = 0; sx < 2; ++sx) { const bf16x8 mb = __builtin_bit_cast(bf16x8, (u32x4){cvt_pk_bf16(M[8 * sx], M[8 * sx + 1]), cvt_pk_bf16(M[8 * sx + 2], M[8 * sx + 3]), cvt_pk_bf16(M[8 * sx + 4], M[8 * sx + 5]), cvt_pk_bf16(M[8 * sx + 6], M[8 * sx + 7])});
          R = __builtin_amdgcn_mfma_f32_32x32x16_bf16(a2[sx], mb, R, 0, 0, 0); }
#pragma unroll
      for (int e = 0; e < 16; ++e) TS[(32 + (e & 3) + 8 * (e >> 2) + 4 * kh) * LST + r] = -R[e]; }
}
__device__ __forceinline__ void phase_dnprep(const Frame& F, const Args& a) {
    const bf16* PROJ = (const bf16*)(F.ws + WS_PROJ); bf16* QKVN = (bf16*)a.out; bf16* TQK = (bf16*)(F.ws + WS_TQK);
    const float* DABp = (const float*)(F.ws + WS_DAB); const float* a_log = a.in[8]; const float* dt_bias = a.in[9]; float* GCL = (float*)(F.ws + WS_GCL); float* BETAL = (float*)(F.ws + WS_BETAL);
    const float* conv_w = a.in[7];
    LAS float* CW = (LAS float*)(F.lds + P3_CW); LAS float* SC = (LAS float*)(F.lds + P3_SC);
    LAS float* LFp = (LAS float*)(F.lds + P3_LF); LAS float* LBp = (LAS float*)(F.lds + P3_LB); LAS float* TFp = (LAS float*)(F.lds + P3_TF); LAS float* TBp = (LAS float*)(F.lds + P3_TB);
    const int hh = F.lane >> 5;
    static_assert(P3_RAW + 68 * 768 <= LDSCTL_OFF, "P3 LDS map");
    const bf16* zsrc = (const bf16*)(F.ws + WS_CTL + 900 * 1024);
    auto stage_raw = [&](int un) { const int tc_ = un & 63, h_ = (un >> 6) & 3, b_ = un >> 8, t0_ = tc_ * 64;
        for (int p = F.wave; p < 51; p += 8) { const int c = 64 * p + F.lane, row = c / 48, cc = c - 48 * row, tt = t0_ - 2 + row;
            const bf16* src = (tt >= 0 && tt < SEQ) ? PROJ + ((size_t)b_ * SEQ + tt) * PC + C_DQ + (cc >> 4) * 512 + h_ * 128 + (cc & 15) * 8 : zsrc;
            __builtin_amdgcn_global_load_lds((const unsigned*)src, (LAS unsigned*)(F.lds + P3_RAW + p * 1024), 16, 0, 0); } };
    const int unit0 = F.vcu * 16, unit_end = (unit0 + 16 < BATCH * DH * 64) ? unit0 + 16 : BATCH * DH * 64;
    if (unit0 >= unit_end) return;
    { const int h = (unit0 >> 6) & 3;
      for (int i = F.tid; i < 3 * 5 * 128; i += NTHR) { const int part = i / 640, tap = (i / 128) % 5, ch = i & 127; CW[i] = conv_w[tap * 1536 + part * 512 + h * 128 + ch]; } }
    stage_raw(unit0);
    auto gate_sc = [&](int un, float pa, float pb) { const int dir = F.wave - 2, h_ = (un >> 6) & 3, b_ = un >> 8, t0_ = (un & 63) * 64; const size_t go = (((size_t)dir * BATCH + b_) * DH + h_) * SEQ;
        float gv = -__expf(a_log[dir * 4 + h_]) * softplus_f(pa + dt_bias[dir * 4 + h_]); const float bv = sigmoid_f(pb);
#pragma unroll
        for (int o = 1; o < 64; o <<= 1) { const float t = __shfl_up(gv, o); if (F.lane >= o) gv += t; }
        const float glv = __builtin_bit_cast(float, __builtin_amdgcn_readlane(__builtin_bit_cast(int, gv), 63));
        SC[dir * 64 + F.lane] = gv; SC[128 + dir * 64 + F.lane] = bv; GCL[go + t0_ + F.lane] = __expf(gv); BETAL[go + t0_ + F.lane] = bv; ((float*)(F.ws + WS_EDL))[go + t0_ + F.lane] = __expf(glv - gv); };
    if (F.wave == 2 || F.wave == 3) { const int dir = F.wave - 2, tl = dir ? 63 - F.lane : F.lane, h_ = (unit0 >> 6) & 3;
        const float* dp = DABp + ((size_t)(unit0 >> 8) * SEQ + (unit0 & 63) * 64 + tl) * 16 + dir * 4 + h_; gate_sc(unit0, dp[0], dp[8]); }
    for (int unit = unit0; unit < unit_end; ++unit) {
        const int tc = unit & 63, h = (unit >> 6) & 3, b = unit >> 8, t0 = tc * 64; const size_t tokb = (size_t)b * SEQ + t0;
        if (unit == unit0) VM_WAIT(); else asm volatile("s_waitcnt vmcnt(4)" ::: "memory");
        LDS_BAR();
        { const int tl2 = F.lane >> 4, cg = F.lane & 15, tk = 8 * F.wave + 2 * tl2;
#ifndef P3_REP_CONV
#define P3_REP_CONV 1
#endif
#pragma unroll 1
          for (int part_ = 0; part_ < 3 * P3_REP_CONV; ++part_) { const int part = part_ % 3;
              u32x4 rawp[6];
#pragma unroll
              for (int rr = 0; rr < 6; ++rr) rawp[rr] = *(const LAS u32x4*)(F.lds + P3_RAW + (tk + rr) * 768 + part * 256 + cg * 16);
              float o[2][8];
#pragma unroll
              for (int e2 = 0; e2 < 4; ++e2) {
                  float lo[6], hi[6];
#pragma unroll
                  for (int rr = 0; rr < 6; ++rr) { lo[rr] = __builtin_bit_cast(float, rawp[rr][e2] << 16); hi[rr] = __builtin_bit_cast(float, rawp[rr][e2] & 0xffff0000u); }
                  float a0 = 0.f, a1 = 0.f, b0 = 0.f, b1 = 0.f;
#pragma unroll
                  for (int tap = 0; tap < 5; ++tap) { const f32x2_t w01 = *(const LAS f32x2_t*)(CW + (part * 5 + tap) * 128 + 8 * cg + 2 * e2); const float w0 = w01[0], w1 = w01[1];
                      a0 += lo[tap] * w0; a1 += hi[tap] * w1; b0 += lo[tap + 1] * w0; b1 += hi[tap + 1] * w1; }
                  o[0][2 * e2] = a0; o[0][2 * e2 + 1] = a1; o[1][2 * e2] = b0; o[1][2 * e2 + 1] = b1;
                  __builtin_amdgcn_sched_barrier(0); }
#pragma unroll
              for (int u = 0; u < 2; ++u) { float ss = 0.f;
#pragma unroll
                  for (int e = 0; e < 8; ++e) { const float x = o[u][e]; const float y = x * __builtin_amdgcn_rcpf(1.f + __expf(-x)); o[u][e] = y; ss += y * y; }
                  if (part < 2) { ss = row16_sum(ss);
                      const float sc = rsqrtf(ss + EPS) * (part == 0 ? 0.08838834764831845f : 1.f);
#pragma unroll
                      for (int e = 0; e < 8; ++e) o[u][e] *= sc; }
                  u32x4 w; w.x = cvt_pk_bf16(o[u][0], o[u][1]); w.y = cvt_pk_bf16(o[u][2], o[u][3]); w.z = cvt_pk_bf16(o[u][4], o[u][5]); w.w = cvt_pk_bf16(o[u][6], o[u][7]);
                  *(u32x4*)(QKVN + ((size_t)((b * 4 + h) * 3 + part) * SEQ + t0 + tk + u) * 128 + 8 * cg) = w;
                  if (part < 2) *(LAS u32x4*)(F.lds + (part == 0 ? P3_QN : P3_KN) + off_b(tk + u, cg)) = w; }
          } }
        LDS_BAR();
        if (unit + 1 < unit_end) stage_raw(unit + 1);
        { const int mat = F.wave >> 2, ti = (F.wave >> 1) & 1, tj = F.wave & 1;
          f32x16 acc;
#pragma unroll
          for (int e = 0; e < 16; ++e) acc[e] = 0.f;
#pragma unroll
          for (int s8 = 0; s8 < 8; ++s8) { const bf16x8 af = *(const LAS bf16x8*)(F.lds + (mat ? P3_QN : P3_KN) + rowread_b(F.lane, 32 * ti, s8)), bfr = *(const LAS bf16x8*)(F.lds + P3_KN + rowread_b(F.lane, 32 * tj, s8));
              acc = __builtin_amdgcn_mfma_f32_32x32x16_bf16(af, bfr, acc, 0, 0, 0); }
          LAS float* dstp = (mat ? TBp : TFp) + 32 * tj + (F.lane & 31);
#pragma unroll
          for (int e = 0; e < 16; ++e) dstp[(32 * ti + (e & 3) + 8 * (e >> 2) + 4 * hh) * LST] = acc[e]; }
        LDS_BAR();
        if (unit + 1 < unit_end && (F.wave == 2 || F.wave == 3)) {
            const int un = unit + 1, dir = F.wave - 2, tl = dir ? 63 - F.lane : F.lane; const float* dp = DABp + ((size_t)(un >> 8) * SEQ + (un & 63) * 64 + tl) * 16 + dir * 4 + ((un >> 6) & 3);
            __builtin_amdgcn_global_load_lds((const unsigned*)dp, (LAS unsigned*)(F.lds + P3_KN + dir * 512), 4, 0, 0); __builtin_amdgcn_global_load_lds((const unsigned*)(dp + 8), (LAS unsigned*)(F.lds + P3_KN + dir * 512 + 256), 4, 0, 0); }
        { LAS bf16* qkf = (LAS bf16*)(F.lds + P3_QN); LAS bf16* qkb = (LAS bf16*)(F.lds + P3_QN + 8192);
          const int jn = F.tid & 63, jr = 63 - jn; const float gfj = SC[jn], gbj = SC[64 + jr];
#ifndef P3_REP_EW
#define P3_REP_EW 1
#endif
          for (int rep = 0; rep < P3_REP_EW; ++rep)
#pragma unroll 2
          for (int i = F.tid >> 6; i < 64; i += 8) { const int ir = 63 - i; const float gv = TFp[i * LST + jn], pv = TBp[i * LST + jn];
              const float df = __expf(SC[i] - gfj), db = __expf(SC[64 + ir] - gbj);
              if (i > jn) LFp[i * LST + jn] = SC[128 + i] * gv * df;
              if (i < jn) LBp[ir * LST + jr] = SC[192 + ir] * gv * db;
              qkf[i * 64 + jn] = f2bf(i >= jn ? pv * df : 0.f); qkb[ir * 64 + jr] = f2bf(i <= jn ? pv * db : 0.f); } }
        LDS_BAR();
#ifndef P3_REP_INV
#define P3_REP_INV 1
#endif
        for (int rep = 0; rep < P3_REP_INV; ++rep) if (F.wave < 2) dn_inverse(F.wave ? LBp : LFp, F.wave ? TBp : TFp, F.lane);
        if (unit + 1 < unit_end && (F.wave == 2 || F.wave == 3)) {
            VM_WAIT(); const LAS float* ab = (const LAS float*)(F.lds + P3_KN + (F.wave - 2) * 512); gate_sc(unit + 1, ab[F.lane], ab[64 + F.lane]); }
        LDS_BAR();
        for (int it = F.tid; it < 1024; it += NTHR) { const int m = it >> 9, i = (it >> 3) & 63, c8 = it & 7; const LAS float* tp = (m ? TBp : TFp) + i * LST + 8 * c8;
            const f32x4 x0 = *(const LAS f32x4*)tp, x1 = *(const LAS f32x4*)(tp + 4);
            u32x4 w; w.x = cvt_pk_bf16(x0[0], x0[1]); w.y = cvt_pk_bf16(x0[2], x0[3]); w.z = cvt_pk_bf16(x1[0], x1[1]); w.w = cvt_pk_bf16(x1[2], x1[3]);
            *(u32x4*)(TQK + ((size_t)unit * 4 + 2 * m) * 4096 + i * 64 + 8 * c8) = w;
            *(u32x4*)(TQK + ((size_t)unit * 4 + 2 * m + 1) * 4096 + i * 64 + 8 * c8) = *(const LAS u32x4*)(F.lds + P3_QN + m * 8192 + i * 128 + c8 * 16); }
    }
}
constexpr int P4_BUF = 57344, P4_KN = 0, P4_QN = 16384, P4_VN = 32768, P4_T = 40960, P4_QK = 49152, P4_ST = 114688, P4_RT = 131072, P4_VNT = 139264, P4_VDT = 147456, P4_SC = 155648;
__device__ __forceinline__ unsigned off_s(unsigned row, unsigned ch) { return 128u * row + (((ch ^ ((row >> 1) & 7u))) << 4); }
__device__ __forceinline__ unsigned rowread_s(unsigned lane, unsigned rowbase, unsigned s) { return off_s(rowbase + (lane & 31), 2 * s + (lane >> 5)); }
__device__ __forceinline__ void p4_stage(const Frame& F, const bf16* QKVN, const bf16* TQK, const float* GCL, const float* BETAL, int b, int h, int dir, int dvh, int n, int buf) {
    const int tc = dir ? 63 - n : n, t0 = tc * 64; const size_t tokb = (size_t)t0, pl0 = (size_t)((b * 4 + h) * 3) * SEQ; const size_t u3 = (size_t)((b * 4 + h) * 64 + tc);
    LAS unsigned char* B = F.lds + buf * P4_BUF; const int L = F.lane, w = F.wave;
    {
#pragma unroll
      for (int k = 0; k < 2; ++k) { const int q = w + 8 * k, row = 4 * q + (L >> 4), pos = L & 15, ch = pos ^ (((row & 3) << 2) | ((row >> 2) & 3)); const size_t tok = tokb + (dir ? 63 - row : row);
          __builtin_amdgcn_global_load_lds((const unsigned*)(QKVN + (pl0 + SEQ + tok) * 128 + ch * 8), (LAS unsigned*)(B + P4_KN + q * 1024), 16, 0, 0);
          __builtin_amdgcn_global_load_lds((const unsigned*)(QKVN + (pl0 + tok) * 128 + ch * 8), (LAS unsigned*)(B + P4_QN + q * 1024), 16, 0, 0); } }
    { const int row = 8 * w + (L >> 3), pos = L & 7, chs = pos ^ ((row >> 1) & 7); const size_t tok = tokb + (dir ? 63 - row : row);
      __builtin_amdgcn_global_load_lds((const unsigned*)(QKVN + (pl0 + 2 * SEQ + tok) * 128 + dvh * 64 + pos * 8), (LAS unsigned*)(B + P4_VN + w * 1024), 16, 0, 0);
      __builtin_amdgcn_global_load_lds((const unsigned*)(TQK + (u3 * 4 + 2 * dir) * 4096 + row * 64 + chs * 8), (LAS unsigned*)(B + P4_T + w * 1024), 16, 0, 0);
      __builtin_amdgcn_global_load_lds((const unsigned*)(TQK + (u3 * 4 + 2 * dir + 1) * 4096 + row * 64 + chs * 8), (LAS unsigned*)(B + P4_QK + w * 1024), 16, 0, 0); }
    if (w == 0) { const size_t go = (((size_t)dir * BATCH + b) * DH + h) * SEQ + t0; LAS unsigned char* sc = F.lds + P4_SC + buf * 1024;
        __builtin_amdgcn_global_load_lds((const unsigned*)(GCL + go + L), (LAS unsigned*)sc, 4, 0, 0); __builtin_amdgcn_global_load_lds((const unsigned*)(BETAL + go + L), (LAS unsigned*)(sc + 256), 4, 0, 0);
        __builtin_amdgcn_global_load_lds((const unsigned*)((const float*)(F.ws + WS_EDL) + go + L), (LAS unsigned*)(sc + 512), 4, 0, 0); }
}
__device__ __forceinline__ void phase_dnscan(const Frame& F, const Args& a) {
    const bf16* QKVN = (const bf16*)a.out; const bf16* TQK = (const bf16*)(F.ws + WS_TQK); const float* GCL = (const float*)(F.ws + WS_GCL); const float* BETAL = (const float*)(F.ws + WS_BETAL);
    bf16* O = (bf16*)(F.ws + WS_A);
    const int w = F.wave, L = F.lane, hh = L >> 5, l31 = L & 31;
    const int mat = w >> 2, ti = (w >> 1) & 1, tj = w & 1, kt = w >> 1, nt = w & 1;
    for (int unit = F.vcu; unit < BATCH * DH * 4; unit += F.G) {
        const int dvh = unit & 1, dir = (unit >> 1) & 1, h = (unit >> 2) & 3, b = unit >> 4;
        __syncthreads();
        for (int i = F.tid; i < 16384 / 16; i += NTHR) ((LAS u32x4*)(F.lds + P4_ST))[i] = (u32x4){0u, 0u, 0u, 0u};
        p4_stage(F, QKVN, TQK, GCL, BETAL, b, h, dir, dvh, 0, 0);
        f32x16 sacc;
#pragma unroll
        for (int e = 0; e < 16; ++e) sacc[e] = 0.f;
        VM_WAIT(); __syncthreads();
        for (int n = 0; n < 64; ++n) {
            const int cb = n & 1; const LAS unsigned char* B = F.lds + cb * P4_BUF; const LAS float* sc = (const LAS float*)(F.lds + P4_SC + cb * 1024);
            if (n + 1 < 64) p4_stage(F, QKVN, TQK, GCL, BETAL, b, h, dir, dvh, n + 1, cb ^ 1);
            f32x16 acc1;
#pragma unroll
            for (int e = 0; e < 16; ++e) acc1[e] = 0.f;
            { bf16x8 fa[8], fb[8];
#pragma unroll
              for (int s8 = 0; s8 < 8; ++s8) { fa[s8] = *(const LAS bf16x8*)(B + (mat ? P4_QN : P4_KN) + rowread_b(L, 32 * ti, s8)); fb[s8] = *(const LAS bf16x8*)(F.lds + P4_ST + rowread_b(L, 32 * tj, s8)); }
              __builtin_amdgcn_sched_barrier(0);
#pragma unroll
              for (int s8 = 0; s8 < 8; ++s8) acc1 = __builtin_amdgcn_mfma_f32_32x32x16_bf16(fa[s8], fb[s8], acc1, 0, 0, 0); }
            const int ncol = 32 * tj + l31;
            if (mat == 0) {
                bf16 vraw[16];
#pragma unroll
                for (int e = 0; e < 16; ++e) vraw[e] = *(const LAS bf16*)(B + P4_VN + (32 * ti + 8 * (e >> 2) + 4 * hh + (e & 3)) * 128 + ncol * 2);
                __builtin_amdgcn_sched_barrier(0);
#pragma unroll
                for (int rg = 0; rg < 4; ++rg) { float r4[4];
#pragma unroll
                    for (int q = 0; q < 4; ++q) { const int i = 32 * ti + 8 * rg + 4 * hh + q; const float vv = bf2f(vraw[4 * rg + q]);
                        r4[q] = sc[64 + i] * (vv - sc[i] * acc1[4 * rg + q]); }
                    *(LAS unsigned long long*)(F.lds + P4_RT + off_s(ncol, 4 * ti + rg) + 8 * hh) = (unsigned long long)cvt_pk_bf16(r4[0], r4[1]) | ((unsigned long long)cvt_pk_bf16(r4[2], r4[3]) << 32); }
            } else {
#pragma unroll
                for (int e = 0; e < 16; ++e) { const int i = 32 * ti + (e & 3) + 8 * (e >> 2) + 4 * hh; acc1[e] *= sc[i]; }
            }
            LDS_BAR();
            if (mat == 0) {
                f32x16 va;
#pragma unroll
                for (int e = 0; e < 16; ++e) va[e] = 0.f;
                { bf16x8 fa[4], fb[4];
#pragma unroll
                  for (int s4 = 0; s4 < 4; ++s4) { fa[s4] = *(const LAS bf16x8*)(B + P4_T + rowread_s(L, 32 * ti, s4)); fb[s4] = *(const LAS bf16x8*)(F.lds + P4_RT + rowread_s(L, 32 * tj, s4)); }
                  __builtin_amdgcn_sched_barrier(0);
#pragma unroll
                  for (int s4 = 0; s4 < 4; ++s4) va = __builtin_amdgcn_mfma_f32_32x32x16_bf16(fa[s4], fb[s4], va, 0, 0, 0); }
#pragma unroll
                for (int rg = 0; rg < 4; ++rg) { float d4[4];
#pragma unroll
                    for (int q = 0; q < 4; ++q) d4[q] = va[4 * rg + q] * sc[128 + 32 * ti + 8 * rg + 4 * hh + q];
                    const unsigned o8 = off_s(ncol, 4 * ti + rg) + 8 * hh;
                    *(LAS unsigned long long*)(F.lds + P4_VNT + o8) = (unsigned long long)cvt_pk_bf16(va[4 * rg], va[4 * rg + 1]) | ((unsigned long long)cvt_pk_bf16(va[4 * rg + 2], va[4 * rg + 3]) << 32);
                    *(LAS unsigned long long*)(F.lds + P4_VDT + o8) = (unsigned long long)cvt_pk_bf16(d4[0], d4[1]) | ((unsigned long long)cvt_pk_bf16(d4[2], d4[3]) << 32); }
            }
            LDS_BAR();
            if (mat == 1) {
                { bf16x8 fa[4], fb[4];
#pragma unroll
                  for (int s4 = 0; s4 < 4; ++s4) { fa[s4] = *(const LAS bf16x8*)(B + P4_QK + rowread_s(L, 32 * ti, s4)); fb[s4] = *(const LAS bf16x8*)(F.lds + P4_VNT + rowread_s(L, 32 * tj, s4)); }
                  __builtin_amdgcn_sched_barrier(0);
#pragma unroll
                  for (int s4 = 0; s4 < 4; ++s4) acc1 = __builtin_amdgcn_mfma_f32_32x32x16_bf16(fa[s4], fb[s4], acc1, 0, 0, 0); }
                const int tc = dir ? 63 - n : n; bf16* op = O + ((size_t)dir * NT + (size_t)b * SEQ + tc * 64) * DW + h * 128 + dvh * 64 + ncol;
#pragma unroll
                for (int e = 0; e < 16; ++e) { const int i = 32 * ti + (e & 3) + 8 * (e >> 2) + 4 * hh; op[(unsigned)((dir ? 63 - i : i) * DW)] = f2bf(acc1[e]); }
            }
            { const float egl = sc[63];
#pragma unroll
              for (int e = 0; e < 16; ++e) sacc[e] *= egl;
              const unsigned blk = (L >> 4) & 1, q4 = (L & 15) >> 2, p4 = L & 3;
              bf16x8 fv[4];
#pragma unroll
              for (int s4 = 0; s4 < 4; ++s4) fv[s4] = *(const LAS bf16x8*)(F.lds + P4_VDT + rowread_s(L, 32 * nt, s4));
              v4i16_t tv[8];
              { const unsigned kb = (unsigned)(size_t)(B + P4_KN), a0 = kb + off_b(8 * hh + q4, 4 * kt + 2 * blk + (p4 >> 1)) + 8 * (p4 & 1), a1 = kb + off_b(8 * hh + 4 + q4, 4 * kt + 2 * blk + (p4 >> 1)) + 8 * (p4 & 1);
                asm volatile("ds_read_b64_tr_b16 %0, %8\n\tds_read_b64_tr_b16 %1, %9\n\tds_read_b64_tr_b16 %2, %8 offset:4096\n\tds_read_b64_tr_b16 %3, %9 offset:4096\n\t"
                             "ds_read_b64_tr_b16 %4, %8 offset:8192\n\tds_read_b64_tr_b16 %5, %9 offset:8192\n\tds_read_b64_tr_b16 %6, %8 offset:12288\n\tds_read_b64_tr_b16 %7, %9 offset:12288\n\ts_waitcnt lgkmcnt(0)"
                             : "=&v"(tv[0]), "=&v"(tv[1]), "=&v"(tv[2]), "=&v"(tv[3]), "=&v"(tv[4]), "=&v"(tv[5]), "=&v"(tv[6]), "=&v"(tv[7]) : "v"(a0), "v"(a1) : "memory"); }
#pragma unroll
              for (int s4 = 0; s4 < 4; ++s4) { const v4i16_t t0v = tv[2 * s4], t1v = tv[2 * s4 + 1];
                  bf16x8 af; af[0] = t0v[0]; af[1] = t0v[1]; af[2] = t0v[2]; af[3] = t0v[3]; af[4] = t1v[0]; af[5] = t1v[1]; af[6] = t1v[2]; af[7] = t1v[3];
                  sacc = __builtin_amdgcn_mfma_f32_32x32x16_bf16(af, fv[s4], sacc, 0, 0, 0); }
              const int nn = 32 * nt + l31;
#pragma unroll
              for (int rg = 0; rg < 4; ++rg)
                  *(LAS unsigned long long*)(F.lds + P4_ST + off_b(nn, 4 * kt + rg) + 8 * hh) = (unsigned long long)cvt_pk_bf16(sacc[4 * rg], sacc[4 * rg + 1]) | ((unsigned long long)cvt_pk_bf16(sacc[4 * rg + 2], sacc[4 * rg + 3]) << 32);
            }
            if (mat == 1) asm volatile("s_waitcnt vmcnt(16)" ::: "memory"); else VM_WAIT();
            LDS_BAR();
        }
        VM_WAIT();
    }
}
__device__ __forceinline__ void phase_post(const Frame& F, const Args& a) {
    bf16* MIX = (bf16*)(F.ws + WS_MIX); const bf16* O = (const bf16*)(F.ws + WS_A); const bf16* PROJ = (const bf16*)(F.ws + WS_PROJ); const float* ag = a.in[6]; const float* dg = a.in[10];
    const int gw = F.vcu * NWAVES + F.wave, NGW = F.G * NWAVES, lane = F.lane;
    const f32x4 g0 = *(const f32x4*)(ag + lane * 8), g1 = *(const f32x4*)(ag + lane * 8 + 4);
    const f32x4 d0 = *(const f32x4*)(dg + (lane & 15) * 8), d1 = *(const f32x4*)(dg + (lane & 15) * 8 + 4);
    u32x4 nav, nof, nob, nzv;
    if (gw < NT) { nav = *(const u32x4*)(MIX + (size_t)gw * DM + lane * 8); nof = *(const u32x4*)(O + (size_t)gw * DW + lane * 8); nob = *(const u32x4*)(O + ((size_t)NT + gw) * DW + lane * 8); nzv = *(const u32x4*)(PROJ + (size_t)gw * PC + C_DZ + lane * 8); }
    for (int tok = gw; tok < NT; tok += NGW) {
        bf16* mp = MIX + (size_t)tok * DM;
        const u32x4 av = nav, of = nof, ob = nob, zv = nzv;
        { const int tn = tok + NGW < NT ? tok + NGW : tok;
          nav = *(const u32x4*)(MIX + (size_t)tn * DM + lane * 8); nof = *(const u32x4*)(O + (size_t)tn * DW + lane * 8); nob = *(const u32x4*)(O + ((size_t)NT + tn) * DW + lane * 8); nzv = *(const u32x4*)(PROJ + (size_t)tn * PC + C_DZ + lane * 8); }
        float x[8]; float ss = 0.f;
#pragma unroll
        for (int e = 0; e < 4; ++e) { x[2 * e] = __builtin_bit_cast(float, av[e] << 16); x[2 * e + 1] = __builtin_bit_cast(float, av[e] & 0xffff0000u); ss += x[2 * e] * x[2 * e] + x[2 * e + 1] * x[2 * e + 1]; }
        const float rstd = rsqrtf(wave_sum(ss) * (1.f / 512) + EPS);
        u32x4 w; w.x = cvt_pk_bf16(x[0] * rstd * g0[0], x[1] * rstd * g0[1]); w.y = cvt_pk_bf16(x[2] * rstd * g0[2], x[3] * rstd * g0[3]); w.z = cvt_pk_bf16(x[4] * rstd * g1[0], x[5] * rstd * g1[1]); w.w = cvt_pk_bf16(x[6] * rstd * g1[2], x[7] * rstd * g1[3]);
        *(u32x4*)(mp + lane * 8) = w;
        float o[8], z[8]; float s2 = 0.f;
#pragma unroll
        for (int e = 0; e < 4; ++e) { o[2 * e] = __builtin_bit_cast(float, of[e] << 16) + __builtin_bit_cast(float, ob[e] << 16); o[2 * e + 1] = __builtin_bit_cast(float, of[e] & 0xffff0000u) + __builtin_bit_cast(float, ob[e] & 0xffff0000u);
            z[2 * e] = __builtin_bit_cast(float, zv[e] << 16); z[2 * e + 1] = __builtin_bit_cast(float, zv[e] & 0xffff0000u); s2 += o[2 * e] * o[2 * e] + o[2 * e + 1] * o[2 * e + 1]; }
        s2 = row16_sum(s2);
        const float r2 = rsqrtf(s2 * (1.f / 128) + EPS);
        float y[8];
#pragma unroll
        for (int e = 0; e < 8; ++e) y[e] = o[e] * r2 * (e < 4 ? d0[e] : d1[e - 4]) * z[e] * __builtin_amdgcn_rcpf(1.f + __expf(-z[e]));
        u32x4 w2; w2.x = cvt_pk_bf16(y[0], y[1]); w2.y = cvt_pk_bf16(y[2], y[3]); w2.z = cvt_pk_bf16(y[4], y[5]); w2.w = cvt_pk_bf16(y[6], y[7]);
        *(u32x4*)(mp + 512 + lane * 8) = w2;
    }
}

__global__ void __launch_bounds__(NTHR, 2) fwd(Args args) {
    extern __shared__ __attribute__((aligned(16))) unsigned char lds_raw[];
    Frame F; F.lds = (LAS unsigned char*)lds_raw; F.tid = threadIdx.x; F.lane = F.tid & 63; F.wave = __builtin_amdgcn_readfirstlane(F.tid >> 6);
    F.G = gridDim.x; { const int bx = blockIdx.x; F.vcu = (F.G % 8 == 0) ? (bx % 8) * (F.G / 8) + bx / 8 : bx; } F.ws = args.ws;
    gu32* ctl = (gu32*)(F.ws + WS_CTL);
    for (int u = F.tid; u < 128; u += NTHR) ((LAS unsigned*)(F.lds + LDSCTL_OFF))[u] = 0u;
    __syncthreads();
    const int lo = args.ph_lo, hi = args.ph_hi;
    XcdBarrier bar; bar.bar = (unsigned*)ctl + CW_BAR; bar.x = 0; bar.st = nullptr;
    if (hi - lo > 1) bar = xcd_barrier_post((unsigned*)ctl + CW_BAR, (volatile LAS unsigned*)(F.lds + MISC_OFF));
#ifndef PH_MASK
#define PH_MASK 0xffff
#endif
#define IN(k) (((PH_MASK >> (k)) & 1) && lo <= (k) && (k) < hi)
#define SEAM(k) do { if (IN(k) && IN((k) + 1)) xcd_barrier(bar); } while (0)
#ifndef ALIGN1
#define ALIGN1 false
#endif
#ifndef ALIGN6
#define ALIGN6 true
#endif
#ifndef ALIGN8
#define ALIGN8 true
#endif
#ifndef ALIGN9
#define ALIGN9 true
#endif
#ifndef DBL_MASK
#define DBL_MASK 0
#endif
#define DBL(k) (((DBL_MASK >> (k)) & 1) != 0)
    bf16* XN = (bf16*)(F.ws + WS_A); bf16* X2B = (bf16*)(F.ws + WS_A); bf16* PROJ = (bf16*)(F.ws + WS_PROJ); bf16* MIX = (bf16*)(F.ws + WS_MIX);
    bf16* HID = (bf16*)(F.ws + WS_HID); bf16* Y = (bf16*)(F.ws + WS_Y); float* SSQ2 = (float*)(F.ws + WS_SSQ2);
    if (IN(0)) { phase0(F, args); if (DBL(0)) { xcd_barrier(bar); phase0(F, args); } } SEAM(0);
    if (IN(1)) {
        LAS float* gains = (LAS float*)(F.lds + TAB_OFF);
        if (F.tid < 64) gains[F.tid] = args.in[3][F.tid] * (0.125f * LOG2E); else if (F.tid < 128) gains[F.tid] = args.in[4][F.tid - 64];
        __syncthreads();
        pg8::Gemm g{XN, (const bf16*)(F.ws + WS_WIN), DM, 0, DM, 0}; pg8::StaticOrder S; S.init(NT, PC + 256, F.G, (int)blockIdx.x);
        pg8::gemm_phase<EpiInProjF, pg8::StaticOrder, pg8::DenseA, ALIGN1>(F.lds, g, S, pg8::DenseA{DM}, EpiInProjF{PROJ, gains, (float*)(F.ws + WS_DAB)});
    } SEAM(1);
    if (IN(2)) { phase_na(F, args); if (DBL(2)) { xcd_barrier(bar); phase_na(F, args); } }
    __syncthreads();
    if (IN(3)) { phase_dnprep(F, args); if (DBL(3)) { xcd_barrier(bar); phase_dnprep(F, args); } } SEAM(3);
    if (IN(4)) { phase_dnscan(F, args); if (DBL(4)) { xcd_barrier(bar); phase_dnscan(F, args); } } SEAM(4);
    if (IN(5)) { phase_post(F, args); } SEAM(5);
    if (IN(6)) {
        pg8::Gemm g{MIX, (const bf16*)(F.ws + WS_WO), DM, 0, DM, 0}; pg8::StaticOrder S; S.init(NT, DM, F.G, (int)blockIdx.x);
        pg8::gemm_phase<EpiOutF, pg8::StaticOrder, pg8::DenseA, ALIGN6>(F.lds, g, S, pg8::DenseA{DM}, EpiOutF{args.in[0], args.out, X2B, SSQ2});
    } SEAM(6);
    if (IN(7)) {
        pg8::Gemm g{X2B, (const bf16*)(F.ws + WS_WR), DM, 0, DM, 0}; pg8::StaticOrder S; S.init(NT, 256, F.G, (int)blockIdx.x);
        EpiRouterF E{SSQ2, args.in[14], args.in[16], (int*)(F.ws + WS_TOKE), (float*)(F.ws + WS_TOKG), (float*)(F.ws + WS_RSTD2), (int*)(F.ws + WS_BIDX), (unsigned*)ctl + CW_CNT};
        pg8::gemm_phase<EpiRouterF, pg8::StaticOrder, pg8::DenseA, false>(F.lds, g, S, pg8::DenseA{DM}, E);
    } SEAM(7);
    if (IN(8)) {
        const int n = moe_setup1(F);
        pg8::Gemm g{X2B, (const bf16*)(F.ws + WS_WGU), DM, (size_t)512 * DM * 2, DM, 0};
        MoeSched S{(const LAS int*)(F.lds + TAB_OFF + TB_UT), n};
        const LAS unsigned* t0 = (const LAS unsigned*)(F.lds + TAB_OFF + TB_T);
        pg8::gemm_phase<EpiMoe1F, MoeSched, pg8::GatherA, ALIGN8>(F.lds, g, S, pg8::GatherA{t0}, EpiMoe1F{HID, (const LAS float*)(t0 + 6 * 256), t0 + 12 * 256, (const LAS float*)(t0 + 18 * 256)});
    } SEAM(8);
    if (IN(9)) {
        const int n = moe_setup2(F);
        pg8::Gemm g{HID, (const bf16*)(F.ws + WS_WD), 2 * DE, (size_t)DM * DE * 2, DE, 4};
        MoeSched S{(const LAS int*)(F.lds + TAB_OFF + TB_UT), n};
        pg8::gemm_phase<EpiMoe2F, MoeSched, pg8::DenseA, ALIGN9>(F.lds, g, S, pg8::DenseA{2 * DE}, EpiMoe2F{X2B, args.out, (const LAS unsigned*)(F.lds + TAB_OFF + TB_T)});
    }
#undef IN
#undef SEAM
}


extern "C" void kernel_launch(void* const* d_in, const int* in_sizes, int n_in, void* d_out, int out_size, void* d_ws, size_t ws_size, hipStream_t stream) {
    static int grid = 0;
    if (grid == 0) {
        if (n_in != 20 || in_sizes[0] != NT * DM || out_size != NT * DM || ws_size < WS_END2) { fprintf(stderr, "kernel_launch: unexpected n_in %d / sizes / ws_size %zu (need %zu)\n", n_in, ws_size, (size_t)WS_END2); grid = -1; return; }
        int dev = 0, cus = 0, per_cu = 0;
        if (hipGetDevice(&dev) != hipSuccess || hipDeviceGetAttribute(&cus, hipDeviceAttributeMultiprocessorCount, dev) != hipSuccess) { grid = -1; return; }
        if (hipFuncSetAttribute((const void*)fwd, hipFuncAttributeMaxDynamicSharedMemorySize, LDS_BYTES) != hipSuccess) { fprintf(stderr, "kernel_launch: hipFuncSetAttribute failed\n"); grid = -1; return; }
        if (hipOccupancyMaxActiveBlocksPerMultiprocessor(&per_cu, (const void*)fwd, NTHR, LDS_BYTES) != hipSuccess || per_cu < 1) fprintf(stderr, "kernel_launch: occupancy query says %d\n", per_cu);
        (void)hipGetLastError();
        grid = cus;
    }
    if (grid < 0) return;
    (void)hipMemsetAsync((unsigned char*)d_ws + WS_CTL, 0, 1 * MiB, stream);
    Args a{}; for (int i = 0; i < 20; ++i) a.in[i] = (const float*)d_in[i]; a.out = (float*)d_out; a.ws = (unsigned char*)d_ws;
#define FWD(lo_, hi_) do { a.ph_lo = (lo_); a.ph_hi = (hi_); hipLaunchKernelGGL(fwd, dim3(grid), dim3(NTHR), LDS_BYTES, stream, a); } while (0)
#if defined(PROBE_EXTRA)
    for (int k = 0; k < 10; ++k) { FWD(k, k + 1); if (k == PROBE_EXTRA) FWD(k, k + 1); }
#else
    FWD(0, 10);
#endif
}
```

```cpp
#include <hip/hip_runtime.h>
#include <cstdio>
#include <cstdint>

typedef unsigned short bf16;
typedef unsigned u32x4 __attribute__((ext_vector_type(4)));
typedef float f32x4 __attribute__((ext_vector_type(4)));

constexpr int BATCH = 16, SEQ = 4096, DM = 1024, NT = BATCH * SEQ;
constexpr int GW = 64, ROWS = SEQ / GW, KH = 8, KW = 16;
constexpr int AH = 8, ADH = 64, AW = 512;
constexpr int DH = 4, DHD = 128, DW = 512, DCONV = 5, DCHUNK = 64;
constexpr int INC = 3600, PC = 3584;
constexpr int NG = 8, EPG = 8, NE = 64, DE = 256;
constexpr float EPS = 1e-6f;
constexpr float LOG2E = 1.4426950408889634f;
constexpr int C_AQ = 0, C_AK = 512, C_AV = 1024, C_DQ = 1536, C_DK = 2048, C_DV = 2560, C_DZ = 3072;

constexpr size_t MiB = 1ull << 20;
constexpr size_t WS_CTL   = 0;
constexpr size_t WS_WIN   = 1 * MiB;
constexpr size_t WS_WO    = 8 * MiB + 512 * 1024;
constexpr size_t WS_WR    = 10 * MiB + 512 * 1024;
constexpr size_t WS_WGU   = 11 * MiB;
constexpr size_t WS_WD    = 75 * MiB;
constexpr size_t WS_A     = 107 * MiB;
constexpr size_t WS_PROJ  = 235 * MiB;
constexpr size_t WS_MIX   = 683 * MiB;
constexpr size_t WS_TQK   = 811 * MiB;
constexpr size_t WS_DAB   = 939 * MiB;
constexpr size_t WS_G     = 943 * MiB;
constexpr size_t WS_BETA  = 945 * MiB;
constexpr size_t WS_TOKE  = 947 * MiB;
constexpr size_t WS_TOKG  = 948 * MiB;
constexpr size_t WS_RSTD2 = 949 * MiB;
constexpr size_t WS_BIDX  = 950 * MiB;
constexpr size_t WS_END   = 966 * MiB;
constexpr size_t WS_HID   = WS_PROJ;
constexpr size_t WS_Y     = WS_PROJ + 80 * MiB;
constexpr int CW_CNT = 1024;

__device__ __forceinline__ float bf2f(bf16 v) { return __builtin_bit_cast(float, (unsigned)v << 16); }
__device__ __forceinline__ bf16 f2bf(float f) { unsigned u = __builtin_bit_cast(unsigned, f); return (bf16)((u + 0x7fffu + ((u >> 16) & 1u)) >> 16); }
template <int CTRL> __device__ __forceinline__ float dpp_f(float v) { return __builtin_bit_cast(float, __builtin_amdgcn_update_dpp(0, __builtin_bit_cast(int, v), CTRL, 0xf, 0xf, false)); }
__device__ __forceinline__ float row16_sum(float v) {
    v += dpp_f<0xB1>(v);
    v += dpp_f<0x4E>(v);
    v += dpp_f<0x141>(v);
    v += dpp_f<0x140>(v);
    return v;
}
__device__ __forceinline__ float wave_sum(float v) {
    const int b = __builtin_bit_cast(int, row16_sum(v));
    return (__builtin_bit_cast(float, __builtin_amdgcn_readlane(b, 0)) + __builtin_bit_cast(float, __builtin_amdgcn_readlane(b, 16))) + (__builtin_bit_cast(float, __builtin_amdgcn_readlane(b, 32)) + __builtin_bit_cast(float, __builtin_amdgcn_readlane(b, 48)));
}
__device__ __forceinline__ float silu_f(float x) { return x / (1.f + __expf(-x)); }
__device__ __forceinline__ float sigmoid_f(float x) { return 1.f / (1.f + __expf(-x)); }
__device__ __forceinline__ float softplus_f(float x) { return fmaxf(x, 0.f) + log1pf(__expf(-fabsf(x))); }

#define LAS __attribute__((address_space(3)))
#define GAS __attribute__((address_space(1)))
typedef short bf16x8 __attribute__((ext_vector_type(8)));
typedef GAS unsigned gu32;
constexpr int NWAVES = 8, NTHR = 512;
constexpr int LDS_BYTES = 163840, RING_BYTES = 131072, LDSCTL_OFF = 163328, MISC_OFF = LDSCTL_OFF + 64, TAB_OFF = 132096;
constexpr size_t WS_SSQ2 = 966 * MiB;
constexpr size_t WS_EDL  = 970 * MiB;
constexpr size_t WS_END2 = 972 * MiB;
constexpr int CW_TMO = 0, CW_BAR = 4096;
constexpr int CW_PCNT = 1280;
constexpr size_t WS_R2T = WS_CTL + 256 * 1024;
constexpr size_t WS_TOKP = WS_TOKE;
#define RLX_AGENT __ATOMIC_RELAXED, __HIP_MEMORY_SCOPE_AGENT
#define LDS_WAIT() asm volatile("s_waitcnt lgkmcnt(0)" ::: "memory")
#define VM_WAIT() asm volatile("s_waitcnt vmcnt(0)" ::: "memory")
#define LDS_BAR() do { asm volatile("s_waitcnt lgkmcnt(0)" ::: "memory"); __builtin_amdgcn_s_barrier(); asm volatile("" ::: "memory"); } while (0)
__device__ __forceinline__ unsigned pk2(float lo, float hi) { return (unsigned)f2bf(lo) | ((unsigned)f2bf(hi) << 16); }
typedef float f32x2_t __attribute__((ext_vector_type(2)));
typedef __bf16 bf16x2_t __attribute__((ext_vector_type(2)));
__device__ __forceinline__ unsigned cvt_pk_bf16_asm(float lo, float hi) { unsigned r; asm volatile("v_cvt_pk_bf16_f32 %0, %1, %2" : "=v"(r) : "v"(lo), "v"(hi)); return r; }
__device__ __forceinline__ unsigned cvt_pk_bf16(float lo, float hi) { const f32x2_t v = {lo, hi}; const bf16x2_t b = __builtin_convertvector(v, bf16x2_t); return __builtin_bit_cast(unsigned, b); }

#define XB_TMO      128
#define XB_XCNT(j)  (256  + 64 * (j))
#define XB_XSUB(j)  (1280 + 64 * (j))
#define XB_XGEN(j)  (2304 + 64 * (j))
#define XB_TOP      3328
#define XB_TOPGEN   3392
#define XCD_BAR_WORDS 3456
#define XB_SPIN_CAP (1u << 22)
__device__ __forceinline__ unsigned xb_ld(unsigned* p)              { return __hip_atomic_load(p, __ATOMIC_RELAXED, __HIP_MEMORY_SCOPE_AGENT); }
__device__ __forceinline__ unsigned xb_add(unsigned* p, unsigned v) { return __hip_atomic_fetch_add(p, v, __ATOMIC_RELAXED, __HIP_MEMORY_SCOPE_AGENT); }
__device__ __forceinline__ unsigned xb_xcc_id() { return (unsigned)__builtin_amdgcn_s_getreg((3 << 11) | 20) & 0xFu; }
#define XB_SPIN(cond, bar) do { unsigned _sp = 0; while (cond) { __builtin_amdgcn_s_sleep(1); \
    if ((++_sp & 255u) == 0u) { if (xb_ld(&(bar)[XB_TMO])) break; if (_sp > XB_SPIN_CAP) { atomicAdd(&(bar)[XB_TMO], 1u); break; } } } } while (0)
struct XcdBarrier { unsigned* bar; unsigned x; volatile LAS unsigned* st; };
__device__ __forceinline__ XcdBarrier xcd_barrier_post(unsigned* bar, volatile LAS unsigned* st) {
    XcdBarrier b; b.bar = bar; b.x = xb_xcc_id(); b.st = st;
    if (threadIdx.x == 0) (void)xb_add(&bar[XB_XCNT(b.x)], 1u);
    return b;
}
__device__ __forceinline__ void xcd_barrier_complete(unsigned* bar, unsigned x, unsigned& nloc, unsigned& nx) {
    const unsigned G = gridDim.x * gridDim.y * gridDim.z;
    unsigned sum, cnt, mine, sp = 0u;
    for (;;) {
        sum = 0u; cnt = 0u; mine = 0u;
#pragma unroll
        for (unsigned j = 0; j < 16; ++j) { const unsigned c = xb_ld(&bar[XB_XCNT(j)]); sum += c; cnt += (c > 0u) ? 1u : 0u; mine = (j == x) ? c : mine; }
        if (sum == G) break;
        __builtin_amdgcn_s_sleep(1);
        if ((++sp & 255u) == 0u) { if (xb_ld(&bar[XB_TMO])) break; if (sp > XB_SPIN_CAP) { atomicAdd(&bar[XB_TMO], 1u); break; } }
    }
    nloc = mine > 0u ? mine : 1u; nx = cnt > 0u ? cnt : 1u;
}
__device__ __forceinline__ void xcd_barrier(const XcdBarrier& b) {
    asm volatile("s_waitcnt vmcnt(0)" ::: "memory");
    __syncthreads();
    if (threadIdx.x == 0) {
        unsigned* bar = b.bar;
        __builtin_amdgcn_s_waitcnt(0);
        unsigned nloc = b.st[0], nx = b.st[1];
        if (nloc == 0u) { xcd_barrier_complete(bar, b.x, nloc, nx); b.st[0] = nloc; b.st[1] = nx; }
        const unsigned old = xb_add(&bar[XB_XSUB(b.x)], 1u);
        const unsigned gen = old / nloc;
        if (old + 1u == (gen + 1u) * nloc) {
            __builtin_amdgcn_fence(__ATOMIC_RELEASE, "agent");
            asm volatile("s_waitcnt vmcnt(0)" ::: "memory");
            const unsigned og = xb_add(&bar[XB_TOP], 1u);
            const unsigned tg = og / nx;
            if (og + 1u == (tg + 1u) * nx) xb_add(&bar[XB_TOPGEN], 1u);
            else XB_SPIN(xb_ld(&bar[XB_TOPGEN]) == tg, bar);
            __builtin_amdgcn_fence(__ATOMIC_ACQUIRE, "agent");
            xb_add(&bar[XB_XGEN(b.x)], 1u);
            asm volatile("s_waitcnt vmcnt(0)" ::: "memory");
        } else {
            XB_SPIN(xb_ld(&bar[XB_XGEN(b.x)]) == gen, bar);
            __builtin_amdgcn_fence(__ATOMIC_ACQUIRE, "agent");
            asm volatile("s_waitcnt vmcnt(0)" ::: "memory");
        }
    }
    __syncthreads();
}

namespace pg8 {
constexpr int BM = 256, BK = 64, HALF = 128, HTB = HALF * BK * 2, NXCD = 8, WGM = 8;
__host__ __device__ __forceinline__ int lds_byte(int r, int c) { const int st = (r >> 4) * 2 + (c >> 5), rr = r & 15, cc = c & 31, ob = rr * 64 + cc * 2; return st * 1024 + (ob ^ (((ob >> 9) & 1) << 5)); }
__host__ __device__ __forceinline__ void stage_rc(int b, int& R, int& C) { const int st = b / 1024, sb = b % 1024, swz = sb ^ (((sb >> 9) & 1) << 5); R = (st >> 1) * 16 + swz / 64; C = (st & 1) * 32 + (swz % 64) / 2; }
__host__ __device__ __forceinline__ int perm32(int rho) { const int n = rho >> 4, i = rho & 15; return 8 * (i >> 2) + 4 * n + (i & 3); }
struct Unit { int pm, pn, e, ts, e2; };
struct Gemm { const bf16* A; const bf16* Bt; int K; size_t bstride; int ldb, bsplit; };
struct StaticOrder {
    int nM, nN, nwg, G, c;
    __device__ void init(int M, int N, int G_, int c_) { nM = M / BM; nN = N / BM; nwg = nM * nN; G = G_; c = c_; }
    __device__ bool next(int i, Unit& u) const {
        const long L = (long)i * G + c; if (L >= nwg) return false;
        int wgid = (int)L; { const int q = nwg / NXCD, r = nwg % NXCD, xcd = wgid % NXCD, off = wgid / NXCD; wgid = (xcd < r ? xcd * (q + 1) : r * (q + 1) + (xcd - r) * q) + off; }
        const int nig = WGM * nN, gid = wgid / nig, fm = gid * WGM, gsz = (nM - fm) < WGM ? (nM - fm) : WGM;
        u.pm = fm + ((wgid % nig) % gsz); u.pn = (wgid % nig) / gsz; u.e = 0; u.ts = 0; u.e2 = 0; return true;
    }
};
struct DenseA { int K; __device__ __forceinline__ unsigned rowoff(const Unit& u, int h, int R) const { return (unsigned)(u.pm * BM + h * HALF + R) * (unsigned)(K * 2); } };
struct GatherA { const LAS unsigned* tab; __device__ __forceinline__ unsigned rowoff(const Unit& u, int h, int R) const { return tab[u.ts * BM + h * HALF + R]; } };

template <class Epi, class Sched, class AMap, bool ALIGN_EPI>
__device__ __forceinline__ void gemm_phase(LAS unsigned char* lds, const Gemm g, const Sched& S, const AMap& AM, const Epi& E) {
    const int tid = threadIdx.x, wid = __builtin_amdgcn_readfirstlane(tid >> 6), lane = tid & 63, wr = wid >> 2, wc = wid & 3, fr = lane & 15, fq = lane >> 4;
    const int K = g.K, nt = K / BK;
    unsigned voffB[2];
#pragma unroll
    for (int i = 0; i < 2; ++i) { int R, C; stage_rc(tid * 16 + i * 8192, R, C); const int Rb = Epi::PERM ? ((R & ~31) + perm32(R & 31)) : R;
        voffB[i] = (unsigned)(Rb * g.ldb + C) * 2u; }
    const size_t kstep = (size_t)(BK * 2);
    const size_t hstep = (size_t)HALF * g.ldb * 2;
    const int bsplit = g.bsplit;
    const size_t tstep = 2 * hstep;
    const unsigned ldsw = (unsigned)wid * 1024u;
    const int aoff = lds_byte(wr * 64 + fr, fq * 8), boff = lds_byte(wc * 32 + fr, fq * 8);
    const char* const Ab = (const char*)g.A;
#define PG8_SA(b, h) (((b) * 2 + (h)) * HTB)
#define PG8_SB(b, h) ((4 + (b) * 2 + (h)) * HTB)
#define PG8_STAGE(bufoff, gbase, voff) do { _Pragma("unroll") for (int _i = 0; _i < 2; ++_i) \
        __builtin_amdgcn_global_load_lds((const unsigned*)((const char*)(gbase) + (voff)[_i]), (LAS unsigned*)(lds + (bufoff) + ldsw + _i * 8192), 16, 0, 0); } while (0)
#define PG8_LDA(dst, b, h) do { _Pragma("unroll") for (int m = 0; m < 4; ++m) _Pragma("unroll") for (int k = 0; k < 2; ++k) dst[m][k] = *(const LAS bf16x8*)(lds + PG8_SA(b, h) + aoff + m * 2048 + k * 1024); } while (0)
#define PG8_LDB(dst, b, h) do { _Pragma("unroll") for (int n = 0; n < 2; ++n) _Pragma("unroll") for (int k = 0; k < 2; ++k) dst[n][k] = *(const LAS bf16x8*)(lds + PG8_SB(b, h) + boff + n * 2048 + k * 1024); } while (0)
#define PG8_MMA(ai, bj, At, Bt) do { __builtin_amdgcn_s_setprio(1); _Pragma("unroll") for (int m = 0; m < 4; ++m) _Pragma("unroll") for (int n = 0; n < 2; ++n) _Pragma("unroll") for (int k = 0; k < 2; ++k) \
        acc[ai][bj][m][n] = __builtin_amdgcn_mfma_f32_16x16x32_bf16(Bt[n][k], At[m][k], acc[ai][bj][m][n], 0, 0, 0); __builtin_amdgcn_s_setprio(0); } while (0)
#define PG8_WAIT_V(n) asm volatile("s_waitcnt vmcnt(" #n ")" ::: "memory")
#define PG8_WAIT_L(n) asm volatile("s_waitcnt lgkmcnt(" #n ")" ::: "memory")
#define PG8_BAR __builtin_amdgcn_s_barrier()
#define PG8_SCHED __builtin_amdgcn_sched_barrier(0)
    Unit cur, nxt; int ui = 0;
    if (!S.next(0, cur)) return;
    f32x4 acc[2][2][4][2];
#pragma unroll
    for (int a = 0; a < 2; ++a)
#pragma unroll
        for (int b = 0; b < 2; ++b)
#pragma unroll
            for (int m = 0; m < 4; ++m)
#pragma unroll
                for (int n = 0; n < 2; ++n) acc[a][b][m][n] = (f32x4){0.f, 0.f, 0.f, 0.f};
    bf16x8 At[4][2], B0[2][2], B1[2][2];
    unsigned ca[2][2];
#pragma unroll
    for (int i = 0; i < 2; ++i) { int R, C; stage_rc(tid * 16 + i * 8192, R, C);
#pragma unroll
        for (int h = 0; h < 2; ++h) ca[h][i] = AM.rowoff(cur, h, R) + (unsigned)C * 2u; }
    const char* cB = (const char*)g.Bt + (size_t)cur.e * g.bstride + (size_t)cur.pn * tstep;
    const char* cB2 = (const char*)g.Bt + (size_t)cur.e2 * g.bstride + (size_t)cur.pn * tstep;
    PG8_STAGE(PG8_SB(0, 0), cB, voffB); PG8_STAGE(PG8_SB(0, 1), cB + hstep, voffB); PG8_STAGE(PG8_SA(0, 0), Ab, ca[0]); PG8_STAGE(PG8_SA(0, 1), Ab, ca[1]);
    if (wr == 1) PG8_BAR;
    PG8_WAIT_V(2); PG8_BAR;
    PG8_STAGE(PG8_SB(1, 0), cB + kstep, voffB); PG8_STAGE(PG8_SA(1, 0), Ab + kstep, ca[0]); PG8_STAGE(PG8_SB(1, 1), cB + hstep + kstep, voffB);
    PG8_WAIT_V(6); PG8_BAR;
    for (;;) {
        const bool has_next = S.next(ui + 1, nxt);
        const char* nB = has_next ? (const char*)g.Bt + (size_t)nxt.e * g.bstride + (size_t)nxt.pn * tstep : cB;
        for (int t = 0; t < nt; t += 2) {
            const bool last = (t == nt - 2);
            unsigned a2[2][2];
#pragma unroll
            for (int h = 0; h < 2; ++h)
#pragma unroll
                for (int i = 0; i < 2; ++i) a2[h][i] = ca[h][i];
            if (last && has_next) {
                int tq = tid; asm volatile("" : "+v"(tq));
#pragma unroll
                for (int i = 0; i < 2; ++i) { int R, C; stage_rc(tq * 16 + i * 8192, R, C);
#pragma unroll
                    for (int h = 0; h < 2; ++h) a2[h][i] = AM.rowoff(nxt, h, R) + (unsigned)C * 2u; }
            }
            const char* a1 = Ab + (size_t)(t + 1) * kstep;
            const char* a2b = last ? Ab : Ab + (size_t)(t + 2) * kstep;
            const char* b2 = last ? nB : ((bsplit > 0 && t + 2 >= bsplit) ? cB2 + (size_t)(t + 2 - bsplit) * kstep : cB + (size_t)(t + 2) * kstep);
            const char* a3b = a2b + kstep; const char* b3 = b2 + kstep;
            PG8_LDB(B0, 0, 0); PG8_LDB(B1, 0, 1); PG8_SCHED; PG8_LDA(At, 0, 0); PG8_STAGE(PG8_SA(1, 1), a1, ca[1]);
            PG8_WAIT_V(8); PG8_WAIT_L(0); PG8_BAR; PG8_MMA(0, 0, At, B0); PG8_MMA(0, 1, At, B1); PG8_BAR; PG8_SCHED;
            PG8_LDA(At, 0, 1); PG8_STAGE(PG8_SB(0, 0), b2, voffB); PG8_STAGE(PG8_SB(0, 1), b2 + hstep, voffB); PG8_STAGE(PG8_SA(0, 0), a2b, a2[0]);
            PG8_WAIT_V(8); PG8_WAIT_L(0); PG8_BAR; PG8_MMA(1, 0, At, B0); PG8_MMA(1, 1, At, B1); PG8_BAR; PG8_SCHED;
            PG8_LDB(B0, 1, 0); PG8_LDB(B1, 1, 1); PG8_SCHED; PG8_LDA(At, 1, 0); PG8_STAGE(PG8_SA(0, 1), a2b, a2[1]);
            PG8_WAIT_V(8); PG8_WAIT_L(0); PG8_BAR; PG8_MMA(0, 0, At, B0); PG8_MMA(0, 1, At, B1); PG8_BAR; PG8_SCHED;
            PG8_LDA(At, 1, 1); PG8_STAGE(PG8_SB(1, 0), b3, voffB); PG8_STAGE(PG8_SB(1, 1), b3 + hstep, voffB); PG8_STAGE(PG8_SA(1, 0), a3b, a2[0]);
            PG8_WAIT_V(8); PG8_WAIT_L(0); PG8_BAR; PG8_MMA(1, 0, At, B0); PG8_MMA(1, 1, At, B1); PG8_BAR; PG8_SCHED;
            if (last) {
#pragma unroll
                for (int h = 0; h < 2; ++h)
#pragma unroll
                    for (int i = 0; i < 2; ++i) ca[h][i] = a2[h][i];
            }
        }
        if constexpr (ALIGN_EPI) { if (wr == 0) PG8_BAR; }
        if constexpr (!Epi::AFTER_DRAIN) { E(acc, cur, wr, wc, fr, fq); }
        if (!has_next) break;
#pragma unroll
        for (int a = 0; a < 2; ++a)
#pragma unroll
            for (int b = 0; b < 2; ++b)
#pragma unroll
                for (int m = 0; m < 4; ++m)
#pragma unroll
                    for (int n = 0; n < 2; ++n) acc[a][b][m][n] = (f32x4){0.f, 0.f, 0.f, 0.f};
        cur = nxt; cB = nB; cB2 = (const char*)g.Bt + (size_t)cur.e2 * g.bstride + (size_t)cur.pn * tstep; ++ui;
        if constexpr (ALIGN_EPI) { if (wr == 1) PG8_BAR; }
    }
    PG8_WAIT_V(0);
    if constexpr (!ALIGN_EPI) { if (wr == 0) PG8_BAR; }
    PG8_BAR;
    if constexpr (Epi::AFTER_DRAIN) { E.fused(acc, cur, wr, wc, fr, fq, lds, wid, lane); }
#undef PG8_SA
#undef PG8_SB
#undef PG8_STAGE
#undef PG8_LDA
#undef PG8_LDB
#undef PG8_MMA
#undef PG8_WAIT_V
#undef PG8_WAIT_L
#undef PG8_BAR
#undef PG8_SCHED
}
}

struct EpiInProjF { static constexpr bool PERM = true, AFTER_DRAIN = false;
    bf16* proj; const LAS float* gains; float* dab;
    __device__ __forceinline__ void operator()(const f32x4 (&acc)[2][2][4][2], const pg8::Unit& u, int wr, int wc, int fr, int fq) const {
        if (u.pn == 14) {
            if (wc == 0) {
#pragma unroll
                for (int ai = 0; ai < 2; ++ai)
#pragma unroll
                    for (int m = 0; m < 4; ++m) { const int row = u.pm * 256 + ai * 128 + wr * 64 + m * 16 + fr;
#pragma unroll
                        for (int n = 0; n < 2; ++n) { f32x4 t = acc[ai][0][m][n];
#pragma unroll
                            for (int i = 0; i < 4; ++i) t[i] += __shfl_xor(t[i], 32);
                            if (fq < 2) *(f32x4*)(dab + (size_t)row * 16 + 8 * fq + 4 * n) = t; } }
            }
            return;
        }
        const int mode = u.pn < 2 ? 0 : (u.pn < 4 ? 1 : 2);
        float one = 1.f; asm volatile("" : "+v"(one));
        f32x4 gv[2][2];
        if (mode < 2) {
#pragma unroll
            for (int bj = 0; bj < 2; ++bj)
#pragma unroll
                for (int n = 0; n < 2; ++n) gv[bj][n] = *(const LAS f32x4*)(gains + mode * 64 + 32 * bj + 8 * fq + 4 * n);
        }
#pragma unroll
        for (int ai = 0; ai < 2; ++ai)
#pragma unroll
            for (int m = 0; m < 4; ++m) {
                const int row = u.pm * 256 + ai * 128 + wr * 64 + m * 16 + fr;
                f32x4 v[2][2];
#pragma unroll
                for (int bj = 0; bj < 2; ++bj)
#pragma unroll
                    for (int n = 0; n < 2; ++n) v[bj][n] = acc[ai][bj][m][n];
                if (mode >= 2) {
#pragma unroll
                    for (int bj = 0; bj < 2; ++bj)
#pragma unroll
                        for (int n = 0; n < 2; ++n) v[bj][n] = v[bj][n] * one;
                }
                if (mode < 2) {
                    float ss = 0.f;
#pragma unroll
                    for (int bj = 0; bj < 2; ++bj)
#pragma unroll
                        for (int n = 0; n < 2; ++n) ss += (v[bj][n][0] * v[bj][n][0] + v[bj][n][1] * v[bj][n][1]) + (v[bj][n][2] * v[bj][n][2] + v[bj][n][3] * v[bj][n][3]);
                    ss += __shfl_xor(ss, 16); ss += __shfl_xor(ss, 32);
                    const float rstd = rsqrtf(ss * (1.f / 64) + EPS);
#pragma unroll
                    for (int bj = 0; bj < 2; ++bj)
#pragma unroll
                        for (int n = 0; n < 2; ++n) v[bj][n] = v[bj][n] * rstd * gv[bj][n];
                }
                bf16* rp = proj + (size_t)row * PC + u.pn * 256 + wc * 64 + 8 * fq;
#pragma unroll
                for (int bj = 0; bj < 2; ++bj) { u32x4 w; w.x = cvt_pk_bf16_asm(v[bj][0][0], v[bj][0][1]); w.y = cvt_pk_bf16_asm(v[bj][0][2], v[bj][0][3]); w.z = cvt_pk_bf16_asm(v[bj][1][0], v[bj][1][1]); w.w = cvt_pk_bf16_asm(v[bj][1][2], v[bj][1][3]);
                    *(u32x4*)(rp + 32 * bj) = w; }
            }
    }
};
struct EpiOutF { static constexpr bool PERM = true, AFTER_DRAIN = false;
    const float* x; float* out; bf16* x2b; float* ssq2;
    __device__ __forceinline__ void operator()(const f32x4 (&acc)[2][2][4][2], const pg8::Unit& u, int wr, int wc, int fr, int fq) const {
#pragma unroll
        for (int ai = 0; ai < 2; ++ai)
#pragma unroll
            for (int m = 0; m < 4; ++m) {
                const int row = u.pm * 256 + ai * 128 + wr * 64 + m * 16 + fr; float ss = 0.f;
#pragma unroll
                for (int bj = 0; bj < 2; ++bj) { const size_t off = (size_t)row * DM + u.pn * 256 + bj * 128 + wc * 32 + 8 * fq;
                    const f32x4 r0 = *(const f32x4*)(x + off) + acc[ai][bj][m][0], r1 = *(const f32x4*)(x + off + 4) + acc[ai][bj][m][1];
                    ss += (r0[0] * r0[0] + r0[1] * r0[1]) + (r0[2] * r0[2] + r0[3] * r0[3]) + (r1[0] * r1[0] + r1[1] * r1[1]) + (r1[2] * r1[2] + r1[3] * r1[3]);
                    u32x4 w; w.x = cvt_pk_bf16_asm(r0[0], r0[1]); w.y = cvt_pk_bf16_asm(r0[2], r0[3]); w.z = cvt_pk_bf16_asm(r1[0], r1[1]); w.w = cvt_pk_bf16_asm(r1[2], r1[3]);
                    *(u32x4*)(x2b + off) = w; }
                ss += __shfl_xor(ss, 16); ss += __shfl_xor(ss, 32);
                if (fq == 0) ssq2[(size_t)(u.pn * 4 + wc) * NT + row] = ss;
            }
    }
};
struct EpiRouterF { static constexpr bool PERM = true, AFTER_DRAIN = true;
    const float* ssq2; const float* bg; const float* be; int* toke; float* tokg; float* rstd2; int* bidx; unsigned* cnt;
    __device__ __forceinline__ void fused(const f32x4 (&acc)[2][2][4][2], const pg8::Unit& u, int wr, int wc, int fr, int fq, LAS unsigned char* lds, int wid, int lane) const {
        LAS float* LG = (LAS float*)lds;
        LAS unsigned* cl = (LAS unsigned*)(lds + 80 * 1024);
        LAS unsigned* clp = cl + 128;
        const int tid = threadIdx.x;
        if (tid < 128) cl[tid] = 0u;
        if (tid < 448) clp[tid] = 0u;
        if (wc == 0) {
#pragma unroll
            for (int ai = 0; ai < 2; ++ai)
#pragma unroll
                for (int m = 0; m < 4; ++m) { const int r = ai * 128 + wr * 64 + m * 16 + fr;
#pragma unroll
                    for (int bj = 0; bj < 2; ++bj)
#pragma unroll
                        for (int n = 0; n < 2; ++n)
#pragma unroll
                            for (int i = 0; i < 4; ++i) LG[r * 73 + 32 * bj + 8 * fq + 4 * n + i] = acc[ai][bj][m][n][i]; }
        } else if (wc == 1 && fq == 0) {
#pragma unroll
            for (int ai = 0; ai < 2; ++ai)
#pragma unroll
                for (int m = 0; m < 4; ++m) { const int r = ai * 128 + wr * 64 + m * 16 + fr;
#pragma unroll
                    for (int n = 0; n < 2; ++n)
#pragma unroll
                        for (int i = 0; i < 4; ++i) LG[r * 73 + 64 + 4 * n + i] = acc[ai][0][m][n][i]; }
        }
        __syncthreads();
        int e0 = 0, e1 = 0, pb = 0, slo = 0; unsigned r0 = 0, r1 = 0, rp = 0; const int tok = u.pm * 256 + tid;
        if (tid < 256) {
            float ss = 0.f;
#pragma unroll
            for (int p = 0; p < 16; ++p) ss += ssq2[(size_t)p * NT + tok];
            const float rstd = rsqrtf(ss * (1.f / DM) + EPS);
            const LAS float* lg = LG + tid * 73;
            float gl[8];
#pragma unroll
            for (int n = 0; n < 8; ++n) gl[n] = lg[64 + n] * rstd + bg[n];
            int gs = 0; float gm = gl[0];
#pragma unroll
            for (int n = 1; n < 8; ++n) if (gl[n] > gm) { gm = gl[n]; gs = n; }
            float den = 0.f;
#pragma unroll
            for (int n = 0; n < 8; ++n) den += __expf(gl[n] - gm);
            const float gp = 1.f / den;
            float el[8];
#pragma unroll
            for (int n = 0; n < 8; ++n) el[n] = lg[gs * 8 + n] * rstd + be[gs * 8 + n];
            int i1 = 0; float v1 = el[0];
#pragma unroll
            for (int n = 1; n < 8; ++n) if (el[n] > v1) { v1 = el[n]; i1 = n; }
            int i2 = 0; float v2 = -3.0e38f;
#pragma unroll
            for (int n = 0; n < 8; ++n) if (n != i1 && el[n] > v2) { v2 = el[n]; i2 = n; }
            const float ex = __expf(v2 - v1), p1 = 1.f / (1.f + ex), p2 = ex * p1;
            e0 = gs * 8 + i1; e1 = gs * 8 + i2;
            tokg[tok * 2] = gp * p1; tokg[tok * 2 + 1] = gp * p2; rstd2[tok] = rstd;
            r0 = __hip_atomic_fetch_add(cl + e0, 1u, __ATOMIC_RELAXED, __HIP_MEMORY_SCOPE_WORKGROUP);
            r1 = __hip_atomic_fetch_add(cl + e1, 1u, __ATOMIC_RELAXED, __HIP_MEMORY_SCOPE_WORKGROUP);
            { const int lo = i1 < i2 ? i1 : i2, hi = i1 < i2 ? i2 : i1; slo = i1 < i2 ? 0 : 1; pb = gs * 28 + (lo * (15 - lo)) / 2 + (hi - lo - 1); }
            rp = __hip_atomic_fetch_add(clp + pb, 1u, __ATOMIC_RELAXED, __HIP_MEMORY_SCOPE_WORKGROUP);
        }
        __syncthreads();
        if (tid < 64) { const unsigned c = cl[tid]; cl[64 + tid] = c ? __hip_atomic_fetch_add(cnt + tid, c, __ATOMIC_RELAXED, __HIP_MEMORY_SCOPE_AGENT) : 0u; }
        else if (tid >= 256 && tid < 256 + 224) { const int q = tid - 256; const unsigned c = clp[q]; clp[224 + q] = c ? __hip_atomic_fetch_add(cnt + (CW_PCNT - CW_CNT) + q, c, __ATOMIC_RELAXED, __HIP_MEMORY_SCOPE_AGENT) : 0u; }
        __syncthreads();
        if (tid < 256) { bidx[(size_t)e0 * 65536 + cl[64 + e0] + r0] = tok; bidx[(size_t)e1 * 65536 + cl[64 + e1] + r1] = tok | (1 << 16);
            toke[tok] = (int)(clp[224 + pb] + rp) | (pb << 16) | (slo << 24); }
    }
};
struct EpiMoe1F { static constexpr bool PERM = true, AFTER_DRAIN = false;
    bf16* hid2; const LAS float* rscale; const LAS unsigned* dest; const LAS float* gate;
    __device__ __forceinline__ void operator()(const f32x4 (&acc)[2][2][4][2], const pg8::Unit& u, int wr, int wc, int fr, int fq) const {
#pragma unroll
        for (int ai = 0; ai < 2; ++ai)
#pragma unroll
            for (int m = 0; m < 4; ++m) { const int r = ai * 128 + wr * 64 + m * 16 + fr; const float rs = rscale[u.ts * 256 + r], gt = gate[u.ts * 256 + r]; const unsigned d = dest[u.ts * 256 + r];
                float h[8];
#pragma unroll
                for (int n = 0; n < 2; ++n)
#pragma unroll
                    for (int i = 0; i < 4; ++i) { const float gv = acc[ai][0][m][n][i] * rs, up = acc[ai][1][m][n][i] * rs; h[4 * n + i] = gv * up * gt * __builtin_amdgcn_rcpf(1.f + __expf(-gv)); }
                u32x4 w; w.x = cvt_pk_bf16_asm(h[0], h[1]); w.y = cvt_pk_bf16_asm(h[2], h[3]); w.z = cvt_pk_bf16_asm(h[4], h[5]); w.w = cvt_pk_bf16_asm(h[6], h[7]);
                if (d != 0xffffffffu) *(u32x4*)((char*)hid2 + d + (unsigned)((u.pn * 128 + wc * 32 + 8 * fq) * 2)) = w;
                __builtin_amdgcn_sched_barrier(0); }
    }
};
struct EpiMoe2F { static constexpr bool PERM = true, AFTER_DRAIN = false;
    const bf16* x2b; float* out; const LAS unsigned* tokp1;
    __device__ __forceinline__ void operator()(const f32x4 (&acc)[2][2][4][2], const pg8::Unit& u, int wr, int wc, int fr, int fq) const {
#pragma unroll
        for (int ai = 0; ai < 2; ++ai) {
            unsigned off0[4]; u32x4 xr[4][2];
#pragma unroll
            for (int m = 0; m < 4; ++m) { const unsigned t1 = tokp1[u.ts * 256 + ai * 128 + wr * 64 + m * 16 + fr];
                off0[m] = t1 ? (t1 - 1u) * (unsigned)DM + (unsigned)(u.pn * 256 + wc * 32 + 8 * fq) : 0xffffffffu;
#pragma unroll
                for (int bj = 0; bj < 2; ++bj) xr[m][bj] = *(const u32x4*)(x2b + (t1 ? off0[m] + bj * 128 : 0u)); }
#pragma unroll
            for (int m = 0; m < 4; ++m) if (off0[m] != 0xffffffffu) {
#pragma unroll
                for (int bj = 0; bj < 2; ++bj) { const unsigned off = off0[m] + bj * 128; const u32x4 x = xr[m][bj];
                    f32x4 o0, o1; o0[0] = __builtin_bit_cast(float, x.x << 16); o0[1] = __builtin_bit_cast(float, x.x & 0xffff0000u); o0[2] = __builtin_bit_cast(float, x.y << 16); o0[3] = __builtin_bit_cast(float, x.y & 0xffff0000u);
                    o1[0] = __builtin_bit_cast(float, x.z << 16); o1[1] = __builtin_bit_cast(float, x.z & 0xffff0000u); o1[2] = __builtin_bit_cast(float, x.w << 16); o1[3] = __builtin_bit_cast(float, x.w & 0xffff0000u);
                    __builtin_nontemporal_store(o0 + acc[ai][bj][m][0], (f32x4*)(out + off)); __builtin_nontemporal_store(o1 + acc[ai][bj][m][1], (f32x4*)(out + off + 4)); } }
            __builtin_amdgcn_sched_barrier(0); }
    }
};
struct MoeSched { const LAS int* tab; int n;
    __device__ __forceinline__ bool next(int i, pg8::Unit& u) const { if (i >= n) return false;
        u.pm = __builtin_amdgcn_readfirstlane(tab[8 * i]); u.pn = __builtin_amdgcn_readfirstlane(tab[8 * i + 1]); u.e = __builtin_amdgcn_readfirstlane(tab[8 * i + 2]); u.ts = __builtin_amdgcn_readfirstlane(tab[8 * i + 3]);
        u.e2 = __builtin_amdgcn_readfirstlane(tab[8 * i + 4]); return true; }
};

struct Args { const float* in[20]; float* out; unsigned char* ws; int ph_lo, ph_hi; };
struct Frame { LAS unsigned char* lds; int tid, lane, wave, vcu, G; unsigned char* ws; };

template <class RowMap>
__device__ __forceinline__ void p0_transpose_item(const float* W, int ldw, int k0, int n0, const float* ksc, bf16* dst, int Kd, const RowMap& rm, LAS float* scr, int lane) {
    const int kr = lane >> 4, nq = lane & 15;
    f32x4 tv[16];
#pragma unroll
    for (int i = 0; i < 16; ++i) tv[i] = *(const f32x4*)(W + (size_t)(k0 + 4 * i + kr) * ldw + n0 + 4 * nq);
    if (ksc) {
#pragma unroll
        for (int i = 0; i < 16; ++i) tv[i] = tv[i] * ksc[k0 + 4 * i + kr]; }
#pragma unroll
    for (int i = 0; i < 16; ++i) { LAS float* d = scr + (4 * i + kr) * 65 + 4 * nq; d[0] = tv[i][0]; d[1] = tv[i][1]; d[2] = tv[i][2]; d[3] = tv[i][3]; }
    LDS_WAIT(); asm volatile("" ::: "memory");
    const int c = lane & 7;
#pragma unroll
    for (int j = 0; j < 8; ++j) { const int n = (lane >> 3) + 8 * j; const LAS float* sp = scr + (8 * c) * 65 + n;
        u32x4 o; o.x = cvt_pk_bf16(sp[0 * 65], sp[1 * 65]); o.y = cvt_pk_bf16(sp[2 * 65], sp[3 * 65]); o.z = cvt_pk_bf16(sp[4 * 65], sp[5 * 65]); o.w = cvt_pk_bf16(sp[6 * 65], sp[7 * 65]);
        *(u32x4*)(dst + (size_t)rm(n0 + n) * Kd + k0 + 8 * c) = o; }
    LDS_WAIT(); asm volatile("" ::: "memory");
}
struct RmIn  { __device__ __forceinline__ int operator()(int n) const { const int pn = n >> 8, lc = n & 255; return pn * 256 + 128 * ((lc >> 5) & 1) + 32 * (lc >> 6) + (lc & 31); } };
struct RmId  { int off; __device__ __forceinline__ int operator()(int n) const { return off + n; } };
struct RmGU  { int e, u; __device__ __forceinline__ int operator()(int n) const { return e * 512 + 256 * (n >> 7) + 128 * u + (n & 127); } };

__device__ __forceinline__ void phase0(const Frame& F, const Args& a) {
    const float* x = a.in[0]; const float* ln1_g = a.in[1]; const float* w_in = a.in[2];
    const float* w_out = a.in[11]; const float* ln2_g = a.in[12]; const float* wg_r = a.in[13]; const float* we_r = a.in[15];
    const float* w_gate = a.in[17]; const float* w_up = a.in[18]; const float* w_down = a.in[19];
    bf16* WinT = (bf16*)(F.ws + WS_WIN); bf16* WoT = (bf16*)(F.ws + WS_WO); bf16* WrT = (bf16*)(F.ws + WS_WR); bf16* WguT = (bf16*)(F.ws + WS_WGU); bf16* WdT = (bf16*)(F.ws + WS_WD);
    bf16* XN = (bf16*)(F.ws + WS_A);
    LAS float* scr = (LAS float*)(F.lds + F.wave * 16640);
    const int gw = F.vcu * NWAVES + F.wave, NGW = F.G * NWAVES;
    constexpr int I_IN = 16 * 56, I_O = 16 * 16, I_G = 64 * 16 * 4, I_D = 64 * 4 * 16, I_R = 512;
    constexpr int NITEMS = I_IN + I_O + 2 * I_G + I_D + I_R;
#ifndef P0_REP_ITEMS
#define P0_REP_ITEMS 1
#endif
#ifndef P0_REP_ROWS
#define P0_REP_ROWS 1
#endif
#ifndef P0_NOITEMS
    for (int rep = 0; rep < P0_REP_ITEMS; ++rep)
    for (int it = gw; it < NITEMS; it += NGW) {
        int r = it;
        if (r < I_IN) { p0_transpose_item(w_in, INC, 64 * (r / 56), 64 * (r % 56), nullptr, WinT, DM, RmIn{}, scr, F.lane); continue; } r -= I_IN;
        if (r < I_O) { p0_transpose_item(w_out, DM, 64 * (r / 16), 64 * (r % 16), nullptr, WoT, DM, RmId{0}, scr, F.lane); continue; } r -= I_O;
        if (r < 2 * I_G) { const int u = r / I_G; r -= u * I_G; const int e = r / 64, q = r % 64;
            p0_transpose_item((u ? w_up : w_gate) + (size_t)e * DM * DE, DE, 64 * (q / 4), 64 * (q % 4), ln2_g, WguT, DM, RmGU{e, u}, scr, F.lane); continue; } r -= 2 * I_G;
        if (r < I_D) { const int e = r / 64, q = r % 64; p0_transpose_item(w_down + (size_t)e * DE * DM, DM, 64 * (q / 16), 64 * (q % 16), nullptr, WdT, DE, RmId{e * DM}, scr, F.lane); continue; } r -= I_D;
        if (r >= 256) {
            r -= 256; unsigned w[8];
#pragma unroll
            for (int j = 0; j < 8; ++j) { float v0 = 0.f, v1 = 0.f; const int k = F.lane * 16 + 2 * j;
                if (r < 32) { v0 = w_in[(size_t)k * INC + PC + (r & 15)]; v1 = w_in[(size_t)(k + 1) * INC + PC + (r & 15)];
                    if (r >= 16) { v0 -= __builtin_bit_cast(float, (unsigned)f2bf(v0) << 16); v1 -= __builtin_bit_cast(float, (unsigned)f2bf(v1) << 16); } }
                w[j] = pk2(v0, v1); }
            u32x4* dp = (u32x4*)(WinT + (size_t)(PC + r) * DM + F.lane * 16);
            dp[0] = (u32x4){w[0], w[1], w[2], w[3]}; dp[1] = (u32x4){w[4], w[5], w[6], w[7]};
            continue; }
        {
            const float* src = nullptr; int ld = 0, col = 0;
            if (r < 32) { src = we_r; ld = 64; col = r; } else if (r >= 128 && r < 160) { src = we_r; ld = 64; col = 32 + (r - 128); } else if (r >= 32 && r < 40) { src = wg_r; ld = 8; col = r - 32; }
            unsigned w[8];
#pragma unroll
            for (int j = 0; j < 8; ++j) { const int k = F.lane * 16 + 2 * j; float v0 = 0.f, v1 = 0.f; if (src) { v0 = src[(size_t)k * ld + col] * ln2_g[k]; v1 = src[(size_t)(k + 1) * ld + col] * ln2_g[k + 1]; } w[j] = pk2(v0, v1); }
            u32x4* dp = (u32x4*)(WrT + (size_t)r * DM + F.lane * 16);
            dp[0] = (u32x4){w[0], w[1], w[2], w[3]}; dp[1] = (u32x4){w[4], w[5], w[6], w[7]};
        }
    }
#endif
#ifndef P0_NOROWS
    {
    const f32x4* gr = (const f32x4*)ln1_g + F.lane;
    f32x4 nx[4], ny[4];
    if (gw < NT) { const f32x4* xr = (const f32x4*)(x + (size_t)gw * DM) + F.lane;
#pragma unroll
        for (int j = 0; j < 4; ++j) nx[j] = xr[64 * j]; }
    if (gw + NGW < NT) { const f32x4* xr = (const f32x4*)(x + (size_t)(gw + NGW) * DM) + F.lane;
#pragma unroll
        for (int j = 0; j < 4; ++j) ny[j] = xr[64 * j]; }
    for (int rep = 0; rep < P0_REP_ROWS; ++rep)
    for (int m = gw; m < NT; m += NGW) {
        f32x4 v[4]; float s = 0.f;
#pragma unroll
        for (int j = 0; j < 4; ++j) { v[j] = nx[j]; s += (v[j].x * v[j].x + v[j].y * v[j].y) + (v[j].z * v[j].z + v[j].w * v[j].w); }
#pragma unroll
        for (int j = 0; j < 4; ++j) nx[j] = ny[j];
        if (m + 2 * NGW < NT) { const f32x4* xr = (const f32x4*)(x + (size_t)(m + 2 * NGW) * DM) + F.lane;
#pragma unroll
            for (int j = 0; j < 4; ++j) ny[j] = xr[64 * j]; }
        const float rstd = rsqrtf(wave_sum(s) * (1.f / DM) + EPS);
        unsigned long long* o8 = (unsigned long long*)(XN + (size_t)m * DM) + F.lane;
#pragma unroll
        for (int j = 0; j < 4; ++j) { v[j] = v[j] * rstd * gr[64 * j];
            o8[64 * j] = (unsigned long long)cvt_pk_bf16(v[j].x, v[j].y) | ((unsigned long long)cvt_pk_bf16(v[j].z, v[j].w) << 32); }
    }
    }
#endif
}

constexpr int TB_PRE = 0  , TB_UT = 512  , TB_PT = 1024  , TB_T = 2048  ;
__device__ __forceinline__ void moe_prefixes(const Frame& F) {
    const unsigned* cnt = (const unsigned*)(F.ws + WS_CTL) + CW_CNT; const unsigned* pcnt = (const unsigned*)(F.ws + WS_CTL) + CW_PCNT;
    LAS int* pre = (LAS int*)(F.lds + TAB_OFF + TB_PRE); LAS int* pt = (LAS int*)(F.lds + TAB_OFF + TB_PT);
    if (F.tid < 64) pre[F.tid] = (int)((__hip_atomic_load(cnt + F.tid, RLX_AGENT) + 255u) >> 8);
    else if (F.tid >= 128 && F.tid < 128 + 224) pt[F.tid - 128] = (int)((__hip_atomic_load(pcnt + (F.tid - 128), RLX_AGENT) + 255u) >> 8);
    __syncthreads();
    if (F.tid == 0) { int s = 0; for (int e = 0; e < 64; ++e) { const int t = pre[e]; pre[e] = s; s += t; } pre[64] = s; }
    if (F.tid == 64) { int s = 0; for (int q = 0; q < 224; ++q) { const int t = pt[q]; pt[q] = s; s += t; } pt[224] = s; }
    __syncthreads();
}
__device__ __forceinline__ int moe_setup1(const Frame& F) {
    const unsigned* cnt = (const unsigned*)(F.ws + WS_CTL) + CW_CNT;
    LAS int* pre = (LAS int*)(F.lds + TAB_OFF + TB_PRE); LAS int* pt = (LAS int*)(F.lds + TAB_OFF + TB_PT); LAS int* ut = (LAS int*)(F.lds + TAB_OFF + TB_UT);
    LAS unsigned* t0 = (LAS unsigned*)(F.lds + TAB_OFF + TB_T); LAS float* t1 = (LAS float*)(t0 + 6 * 256); LAS unsigned* t2 = t0 + 12 * 256; LAS float* t3 = (LAS float*)(t0 + 18 * 256);
    const int* bidx = (const int*)(F.ws + WS_BIDX); const float* rstd2 = (const float*)(F.ws + WS_RSTD2); const float* tokg = (const float*)(F.ws + WS_TOKG); const int* tokp = (const int*)(F.ws + WS_TOKP);
    unsigned* r2t = (unsigned*)(F.ws + WS_R2T);
    moe_prefixes(F);
    for (int tok = F.vcu * NTHR + F.tid; tok < NT; tok += F.G * NTHR) { const int tp = tokp[tok]; r2t[256 * pt[(tp >> 16) & 0xff] + (tp & 0xffff)] = (unsigned)tok + 1u; }
    const int total = pre[64] * 2;
    int n = 0; for (int i = 0; i < 6; ++i) if ((long)i * F.G + F.vcu < total) n = i + 1;
    if (F.tid < n) { const int L = F.tid * F.G + F.vcu; const int rtg = L >> 1, pn = L & 1; int e = 0; for (int q = 0; q < 64; ++q) if (pre[q + 1] <= rtg) e = q + 1;
        ut[8 * F.tid] = rtg; ut[8 * F.tid + 1] = pn; ut[8 * F.tid + 2] = e; ut[8 * F.tid + 3] = F.tid; ut[8 * F.tid + 4] = e; }
    __syncthreads();
    { int ts3[3]; bool val3[3]; int tp3[3]; float rs3[3], g3[3];
#pragma unroll
      for (int k = 0; k < 3; ++k) { const int x = F.tid + NTHR * k; ts3[k] = 0; val3[k] = false;
          if (x < n * 256) { const int i = x >> 8, r = x & 255, rtg = ut[8 * i], e = ut[8 * i + 2]; const int idx = (rtg - pre[e]) * 256 + r; const int c = (int)__hip_atomic_load(cnt + e, RLX_AGENT);
              val3[k] = idx < c; ts3[k] = bidx[(size_t)e * 65536 + (val3[k] ? idx : 0)]; } }
#pragma unroll
      for (int k = 0; k < 3; ++k) { const int tok = ts3[k] & 0xffff, slot = ts3[k] >> 16; tp3[k] = tokp[tok]; rs3[k] = rstd2[tok]; g3[k] = tokg[tok * 2 + slot]; }
#pragma unroll
      for (int k = 0; k < 3; ++k) { const int x = F.tid + NTHR * k;
          if (x < n * 256) { const int tok = ts3[k] & 0xffff, slot = ts3[k] >> 16, tp = tp3[k];
              t0[x] = (unsigned)tok * (unsigned)(DM * 2); t1[x] = val3[k] ? rs3[k] : 0.f;
              t2[x] = val3[k] ? (unsigned)(256 * pt[(tp >> 16) & 0xff] + (tp & 0xffff)) * 1024u + (slot == ((tp >> 24) & 1) ? 0u : 512u) : 0xffffffffu;
              t3[x] = g3[k]; } } }
    __syncthreads();
    return n;
}
__device__ __forceinline__ int moe_setup2(const Frame& F) {
    LAS int* pt = (LAS int*)(F.lds + TAB_OFF + TB_PT); LAS int* ut = (LAS int*)(F.lds + TAB_OFF + TB_UT); LAS unsigned* t0 = (LAS unsigned*)(F.lds + TAB_OFF + TB_T);
    const unsigned* r2t = (const unsigned*)(F.ws + WS_R2T);
    moe_prefixes(F);
    const int total = pt[224] * 4;
    int n = 0; for (int i = 0; i < 8; ++i) if ((long)i * F.G + F.vcu < total) n = i + 1;
    if (F.tid < n) { const int L = F.tid * F.G + F.vcu; const int rtg = L >> 2, pn = L & 3; int pb = 0; for (int q = 0; q < 224; ++q) if (pt[q + 1] <= rtg) pb = q + 1;
        const int gs = pb / 28, pi = pb - 28 * gs; int lo = 0; for (int l = 0; l < 7; ++l) if (pi >= (l * (15 - l)) / 2) lo = l; const int hi = lo + 1 + pi - (lo * (15 - lo)) / 2;
        ut[8 * F.tid] = rtg; ut[8 * F.tid + 1] = pn; ut[8 * F.tid + 2] = gs * 8 + lo; ut[8 * F.tid + 3] = F.tid; ut[8 * F.tid + 4] = gs * 8 + hi; }
    __syncthreads();
    { unsigned v4[4];
#pragma unroll
      for (int k = 0; k < 4; ++k) { const int x = F.tid + NTHR * k; v4[k] = 0u; if (x < n * 256) v4[k] = r2t[(size_t)ut[8 * (x >> 8)] * 256 + (x & 255)]; }
#pragma unroll
      for (int k = 0; k < 4; ++k) { const int x = F.tid + NTHR * k; if (x < n * 256) t0[x] = v4[k]; } }
    __syncthreads();
    return n;
}

typedef short v4i16_t __attribute__((ext_vector_type(4)));
constexpr int NA_SLOT = 16384, NA_NSLOT = 9, NA_MRG = NA_NSLOT * NA_SLOT, NA_MRGL = NA_MRG + 8192, NA_BT = NA_MRGL + 1024;
__device__ __forceinline__ int na_swz(int key) { return ((key >> 1) & 3) << 1; }
__device__ __forceinline__ void na_stage_row(const Frame& F, const bf16* pbh, int bandrow) {
    const int key = 8 * F.wave + (F.lane >> 3), c = (F.lane & 7) ^ na_swz(key);
    const bf16* src = pbh + (size_t)(bandrow * GW + key) * PC + c * 8;
    LAS unsigned char* dst = F.lds + (bandrow % NA_NSLOT) * NA_SLOT + F.wave * 1024;
    __builtin_amdgcn_global_load_lds((const unsigned*)(src + C_AK), (LAS unsigned*)dst, 16, 0, 0);
    __builtin_amdgcn_global_load_lds((const unsigned*)(src + C_AV), (LAS unsigned*)(dst + 8192), 16, 0, 0);
}
__device__ __forceinline__ void phase_na(const Frame& F, const Args& a) {
    const bf16* PROJ = (const bf16*)(F.ws + WS_PROJ); bf16* MIX = (bf16*)(F.ws + WS_MIX); const float* rpb = a.in[5];
    const int j = F.wave & 3, bh = F.wave >> 2, g = F.lane >> 4, li = F.lane & 15, c = 16 * j + li;
    const int ks0 = j == 0 ? 0 : (j == 1 ? 8 : (j == 2 ? 24 : 32));
    int c0 = c - KW / 2; c0 = c0 < 0 ? 0 : (c0 > GW - KW ? GW - KW : c0);
    LAS float* bt = (LAS float*)(F.lds + NA_BT);
    for (int unit = F.vcu; unit < BATCH * AH * 2; unit += F.G) {
        const int b = unit >> 4, h = (unit >> 1) & 7, rs = (unit & 1) * 32;
        const bf16* pbh = PROJ + (size_t)b * SEQ * PC + h * ADH;
        float mq = fabsf(a.in[3][F.lane]), mk = fabsf(a.in[4][F.lane]);
#pragma unroll
        for (int o = 1; o < 64; o <<= 1) { mq = fmaxf(mq, __shfl_xor(mq, o)); mk = fmaxf(mk, __shfl_xor(mk, o)); }
        float mb = 0.f; for (int i = F.lane; i < 15 * 31; i += 64) mb = fmaxf(mb, fabsf(rpb[h * 465 + i]));
#pragma unroll
        for (int o = 1; o < 64; o <<= 1) mb = fmaxf(mb, __shfl_xor(mb, o));
        const float cshift = 64.f * 0.125f * LOG2E * mq * mk + mb * LOG2E;
        __syncthreads();
        for (int i = F.tid; i < 15 * 31; i += NTHR) bt[i] = rpb[h * 465 + i] * LOG2E - cshift;
        int r0 = rs - KH / 2; r0 = r0 < 0 ? 0 : (r0 > ROWS - KH ? ROWS - KH : r0);
        for (int i = 0; i < KH; ++i) na_stage_row(F, pbh, r0 + i);
        VM_WAIT(); __syncthreads();
        const int pkey = 8 * F.wave + (F.lane >> 3), pch = (F.lane & 7) ^ na_swz(pkey);
        auto r0_of = [](int r) { int v = r - KH / 2; return v < 0 ? 0 : (v > ROWS - KH ? ROWS - KH : v); };
        u32x4 pk = {0u, 0u, 0u, 0u}, pv = {0u, 0u, 0u, 0u};
        if (rs + 1 < rs + 32 && r0_of(rs + 1) != r0_of(rs)) { const bf16* src = pbh + (size_t)((r0_of(rs + 1) + KH - 1) * GW + pkey) * PC + pch * 8; pk = *(const u32x4*)(src + C_AK); pv = *(const u32x4*)(src + C_AV); }
        float bias[8][4]; int prev_ro = -100;
        bf16x8 qn[2];
#pragma unroll
        for (int ks = 0; ks < 2; ++ks) qn[ks] = *(const bf16x8*)(PROJ + ((size_t)b * SEQ + rs * GW + c) * PC + C_AQ + h * ADH + 32 * ks + 8 * g);
        for (int r = rs; r < rs + 32; ++r) {
            r0 = r - KH / 2; r0 = r0 < 0 ? 0 : (r0 > ROWS - KH ? ROWS - KH : r0);
            if (r + 1 < rs + 32 && r0_of(r + 1) != r0) { LAS unsigned char* dst = F.lds + ((r0_of(r + 1) + KH - 1) % NA_NSLOT) * NA_SLOT + F.wave * 1024 + F.lane * 16;
                *(LAS u32x4*)dst = pk; *(LAS u32x4*)(dst + 8192) = pv; }
            if (r + 2 < rs + 32 && r0_of(r + 2) != r0_of(r + 1)) { const bf16* src = pbh + (size_t)((r0_of(r + 2) + KH - 1) * GW + pkey) * PC + pch * 8; pk = *(const u32x4*)(src + C_AK); pv = *(const u32x4*)(src + C_AV); }
            const int ro = r0 - r + (KH - 1) + 4 * bh;
            if (ro != prev_ro) { prev_ro = ro;
#pragma unroll
                for (int i4 = 0; i4 < 4; ++i4)
#pragma unroll
                    for (int t = 0; t < 2; ++t)
#pragma unroll
                        for (int q = 0; q < 4; ++q) { const int kc = ks0 + 16 * t + 4 * g + q; const bool valid = kc >= c0 && kc < c0 + KW;
                            bias[i4 * 2 + t][q] = valid ? bt[(ro + i4) * 31 + (kc - c + KW - 1)] : -1.0e30f; } }
            const size_t qtok = (size_t)b * SEQ + r * GW + c;
            bf16x8 qf[2]; qf[0] = qn[0]; qf[1] = qn[1];
            { const size_t ntok = qtok + (r + 1 < rs + 32 ? GW : 0);
#pragma unroll
              for (int ks = 0; ks < 2; ++ks) qn[ks] = *(const bf16x8*)(PROJ + ntok * PC + C_AQ + h * ADH + 32 * ks + 8 * g); }
            f32x4 sacc[8];
#pragma unroll
            for (int i4 = 0; i4 < 4; ++i4) { const LAS unsigned char* ks_ = F.lds + ((r0 + 4 * bh + i4) % NA_NSLOT) * NA_SLOT;
#pragma unroll
                for (int t = 0; t < 2; ++t) { const int row = ks0 + 16 * t + li; f32x4 acc = {bias[i4 * 2 + t][0], bias[i4 * 2 + t][1], bias[i4 * 2 + t][2], bias[i4 * 2 + t][3]};
#pragma unroll
                    for (int ks = 0; ks < 2; ++ks) { const bf16x8 kf = *(const LAS bf16x8*)(ks_ + row * 128 + (((g + 4 * ks) ^ na_swz(row)) << 4));
                        acc = __builtin_amdgcn_mfma_f32_16x16x32_bf16(kf, qf[ks], acc, 0, 0, 0); }
                    sacc[i4 * 2 + t] = acc; } }
            f32x2_t ls2 = {0.f, 0.f};
#pragma unroll
            for (int x = 0; x < 8; ++x) {
#pragma unroll
                for (int q = 0; q < 4; ++q) sacc[x][q] = __builtin_amdgcn_exp2f(sacc[x][q]);
                ls2 += (f32x2_t){sacc[x][0], sacc[x][1]}; ls2 += (f32x2_t){sacc[x][2], sacc[x][3]}; }
            float lsum = ls2[0] + ls2[1];
            f32x4 oacc[4];
#pragma unroll
            for (int dt = 0; dt < 4; ++dt) oacc[dt] = (f32x4){0.f, 0.f, 0.f, 0.f};
#pragma unroll
            for (int m = 0; m < 4; ++m) {
                const int xa = 2 * m, xb = 2 * m + 1;
                bf16x8 pf; { const unsigned w0 = cvt_pk_bf16(sacc[xa][0], sacc[xa][1]), w1 = cvt_pk_bf16(sacc[xa][2], sacc[xa][3]), w2 = cvt_pk_bf16(sacc[xb][0], sacc[xb][1]), w3 = cvt_pk_bf16(sacc[xb][2], sacc[xb][3]);
                    pf = __builtin_bit_cast(bf16x8, (u32x4){w0, w1, w2, w3}); }
                const LAS unsigned char* va = F.lds + ((r0 + 4 * bh + m) % NA_NSLOT) * NA_SLOT + 8192; const LAS unsigned char* vb = va;
                const int rowa = ks0 + 4 * g + (li >> 2), rowb = ks0 + 16 + 4 * g + (li >> 2);
#pragma unroll
                for (int dt = 0; dt < 4; ++dt) { const int cc = 2 * dt + ((li & 3) >> 1), hb = (li & 1) * 8;
                    const v4i16_t ta = __builtin_amdgcn_ds_read_tr16_b64_v4i16((LAS v4i16_t*)(va + rowa * 128 + ((cc ^ na_swz(rowa)) << 4) + hb));
                    const v4i16_t tb = __builtin_amdgcn_ds_read_tr16_b64_v4i16((LAS v4i16_t*)(vb + rowb * 128 + ((cc ^ na_swz(rowb)) << 4) + hb));
                    bf16x8 vf; vf[0] = ta[0]; vf[1] = ta[1]; vf[2] = ta[2]; vf[3] = ta[3]; vf[4] = tb[0]; vf[5] = tb[1]; vf[6] = tb[2]; vf[7] = tb[3];
                    oacc[dt] = __builtin_amdgcn_mfma_f32_16x16x32_bf16(vf, pf, oacc[dt], 0, 0, 0); }
            }
            LAS unsigned char* mrg = F.lds + NA_MRG + (j * 64 + F.lane) * 32; LAS float* mrl = (LAS float*)(F.lds + NA_MRGL) + j * 64 + F.lane;
            if (bh == 1) {
                u32x4 w0, w1; w0.x = cvt_pk_bf16(oacc[0][0], oacc[0][1]); w0.y = cvt_pk_bf16(oacc[0][2], oacc[0][3]); w0.z = cvt_pk_bf16(oacc[1][0], oacc[1][1]); w0.w = cvt_pk_bf16(oacc[1][2], oacc[1][3]);
                w1.x = cvt_pk_bf16(oacc[2][0], oacc[2][1]); w1.y = cvt_pk_bf16(oacc[2][2], oacc[2][3]); w1.z = cvt_pk_bf16(oacc[3][0], oacc[3][1]); w1.w = cvt_pk_bf16(oacc[3][2], oacc[3][3]);
                *(LAS u32x4*)mrg = w0; *(LAS u32x4*)(mrg + 16) = w1; *mrl = lsum;
            }
            LDS_BAR();
            if (bh == 0) {
                const u32x4 w0 = *(const LAS u32x4*)mrg, w1 = *(const LAS u32x4*)(mrg + 16); lsum += *mrl;
                lsum += __shfl_xor(lsum, 16); lsum += __shfl_xor(lsum, 32);
                const float inv = 1.f / lsum;
                bf16* op = MIX + qtok * DM + h * ADH + 4 * g;
#pragma unroll
                for (int dt = 0; dt < 4; ++dt) { const unsigned pa = dt < 2 ? (dt == 0 ? w0.x : w0.z) : (dt == 2 ? w1.x : w1.z), pb = dt < 2 ? (dt == 0 ? w0.y : w0.w) : (dt == 2 ? w1.y : w1.w);
                    const float o0 = (oacc[dt][0] + __builtin_bit_cast(float, pa << 16)) * inv, o1 = (oacc[dt][1] + __builtin_bit_cast(float, pa & 0xffff0000u)) * inv;
                    const float o2 = (oacc[dt][2] + __builtin_bit_cast(float, pb << 16)) * inv, o3 = (oacc[dt][3] + __builtin_bit_cast(float, pb & 0xffff0000u)) * inv;
                    *(unsigned long long*)(op + 16 * dt) = (unsigned long long)cvt_pk_bf16(o0, o1) | ((unsigned long long)cvt_pk_bf16(o2, o3) << 32); }
            }
            LDS_BAR();
        }
    }
}


typedef float f32x16 __attribute__((ext_vector_type(16)));
constexpr size_t WS_GCL = WS_G, WS_BETAL = WS_BETA;
constexpr int P3_QN = 0, P3_KN = 16384, P3_LF = 32768, P3_LB = P3_LF + 17408, P3_TF = P3_LB + 17408, P3_TB = P3_TF + 17408, P3_CW = P3_TB + 17408, P3_SC = P3_CW + 7680, P3_RAW = P3_SC + 1024, LST = 68;
__device__ __forceinline__ unsigned off_b(unsigned row, unsigned ch) { return 256u * row + 16u * (ch ^ (((row & 3) << 2) | ((row >> 2) & 3))); }
__device__ __forceinline__ unsigned rowread_b(unsigned lane, unsigned rowbase, unsigned s) { return off_b(rowbase + (lane & 31), 2 * s + (lane >> 5)); }
__device__ __forceinline__ void dn_inverse(LAS float* LS, LAS float* TS, int lane) {
    for (int i = lane; i < 64 * LST / 4; i += 64) ((LAS f32x4*)TS)[i] = (f32x4){0.f, 0.f, 0.f, 0.f};
    { const int blk = lane >> 4, col = lane & 15; float xa[16];
#pragma unroll
      for (int i = 0; i < 16; ++i) xa[i] = (i == col) ? 1.f : 0.f;
#pragma unroll
      for (int k = 0; k < 16; ++k) { const float xk = xa[k]; TS[(16 * blk + k) * LST + 16 * blk + col] = xk;
#pragma unroll
          for (int i = k + 1; i < 16; ++i) xa[i] -= LS[(16 * blk + i) * LST + 16 * blk + k] * xk; } }
    __builtin_amdgcn_sched_barrier(0);
#pragma unroll
    for (int p = 0; p < 2; ++p) { const int base = 32 * p, r = lane & 15, kq = lane >> 4;
        float a1[4], b1[4];
#pragma unroll
        for (int s4 = 0; s4 < 4; ++s4) { a1[s4] = LS[(base + 16 + r) * LST + base + kq + 4 * s4]; b1[s4] = TS[(base + kq + 4 * s4) * LST + base + r]; }
        const f32x4 a2 = *(const LAS f32x4*)(TS + (base + 16 + r) * LST + base + 16 + 4 * kq);
        __builtin_amdgcn_sched_barrier(0);
        f32x4 M = {0.f, 0.f, 0.f, 0.f};
#pragma unroll
        for (int s4 = 0; s4 < 4; ++s4) M = __builtin_amdgcn_mfma_f32_16x16x4f32(a1[s4], b1[s4], M, 0, 0, 0);
        f32x4 R = {0.f, 0.f, 0.f, 0.f};
#pragma unroll
        for (int s4 = 0; s4 < 4; ++s4) R = __builtin_amdgcn_mfma_f32_16x16x4f32(a2[s4], M[s4], R, 0, 0, 0);
#pragma unroll
        for (int e = 0; e < 4; ++e) TS[(base + 16 + 4 * kq + e) * LST + base + r] = -R[e]; }
    __builtin_amdgcn_sched_barrier(0);
    { const int r = lane & 31, kh = lane >> 5;
      bf16x8 a1[2], b1[2], a2[2];
#pragma unroll
      for (int sx = 0; sx < 2; ++sx) {
          const f32x4 l0 = *(const LAS f32x4*)(LS + (32 + r) * LST + 16 * sx + 8 * kh), l1 = *(const LAS f32x4*)(LS + (32 + r) * LST + 16 * sx + 8 * kh + 4);
          a1[sx] = __builtin_bit_cast(bf16x8, (u32x4){cvt_pk_bf16(l0[0], l0[1]), cvt_pk_bf16(l0[2], l0[3]), cvt_pk_bf16(l1[0], l1[1]), cvt_pk_bf16(l1[2], l1[3])});
          float tb[8];
#pragma unroll
          for (int j = 0; j < 8; ++j) tb[j] = TS[(16 * sx + 8 * kh + j) * LST + r];
          b1[sx] = __builtin_bit_cast(bf16x8, (u32x4){cvt_pk_bf16(tb[0], tb[1]), cvt_pk_bf16(tb[2], tb[3]), cvt_pk_bf16(tb[4], tb[5]), cvt_pk_bf16(tb[6], tb[7])});
          const f32x4 t0 = *(const LAS f32x4*)(TS + (32 + r) * LST + 32 + 16 * sx + 4 * kh), t1 = *(const LAS f32x4*)(TS + (32 + r) * LST + 32 + 16 * sx + 8 + 4 * kh);
          a2[sx] = __builtin_bit_cast(bf16x8, (u32x4){cvt_pk_bf16(t0[0], t0[1]), cvt_pk_bf16(t0[2], t0[3]), cvt_pk_bf16(t1[0], t1[1]), cvt_pk_bf16(t1[2], t1[3])}); }
      __builtin_amdgcn_sched_barrier(0);
      f32x16 M;
#pragma unroll
      for (int e = 0; e < 16; ++e) M[e] = 0.f;
#pragma unroll
      for (int sx = 0; sx < 2; ++sx) M = __builtin_amdgcn_mfma_f32_32x32x16_bf16(a1[sx], b1[sx], M, 0, 0, 0);
      f32x16 R;
#pragma unroll
      for (int e = 0; e < 16; ++e) R[e] = 0.f;
#pragma unroll
      for (int sx = 0; sx < 2; ++sx) { const bf16x8 mb = __builtin_bit_cast(bf16x8, (u32x4){cvt_pk_bf16(M[8 * sx], M[8 * sx + 1]), cvt_pk_bf16(M[8 * sx + 2], M[8 * sx + 3]), cvt_pk_bf16(M[8 * sx + 4], M[8 * sx + 5]), cvt_pk_bf16(M[8 * sx + 6], M[8 * sx + 7])});
          R = __builtin_amdgcn_mfma_f32_32x32x16_bf16(a2[sx], mb, R, 0, 0, 0); }
#pragma unroll
      for (int e = 0; e < 16; ++e) TS[(32 + (e & 3) + 8 * (e >> 2) + 4 * kh) * LST + r] = -R[e]; }
}
__device__ __forceinline__ void phase_dnprep(const Frame& F, const Args& a) {
    const bf16* PROJ = (const bf16*)(F.ws + WS_PROJ); bf16* QKVN = (bf16*)a.out; bf16* TQK = (bf16*)(F.ws + WS_TQK);
    const float* DABp = (const float*)(F.ws + WS_DAB); const float* a_log = a.in[8]; const float* dt_bias = a.in[9]; float* GCL = (float*)(F.ws + WS_GCL); float* BETAL = (float*)(F.ws + WS_BETAL);
    const float* conv_w = a.in[7];
    LAS float* CW = (LAS float*)(F.lds + P3_CW); LAS float* SC = (LAS float*)(F.lds + P3_SC);
    LAS float* LFp = (LAS float*)(F.lds + P3_LF); LAS float* LBp = (LAS float*)(F.lds + P3_LB); LAS float* TFp = (LAS float*)(F.lds + P3_TF); LAS float* TBp = (LAS float*)(F.lds + P3_TB);
    const int hh = F.lane >> 5;
    static_assert(P3_RAW + 68 * 768 <= LDSCTL_OFF, "P3 LDS map");
    const bf16* zsrc = (const bf16*)(F.ws + WS_CTL + 900 * 1024);
    auto stage_raw = [&](int un) { const int tc_ = un & 63, h_ = (un >> 6) & 3, b_ = un >> 8, t0_ = tc_ * 64;
        for (int p = F.wave; p < 51; p += 8) { const int c = 64 * p + F.lane, row = c / 48, cc = c - 48 * row, tt = t0_ - 2 + row;
            const bf16* src = (tt >= 0 && tt < SEQ) ? PROJ + ((size_t)b_ * SEQ + tt) * PC + C_DQ + (cc >> 4) * 512 + h_ * 128 + (cc & 15) * 8 : zsrc;
            __builtin_amdgcn_global_load_lds((const unsigned*)src, (LAS unsigned*)(F.lds + P3_RAW + p * 1024), 16, 0, 0); } };
    const int unit0 = F.vcu * 16, unit_end = (unit0 + 16 < BATCH * DH * 64) ? unit0 + 16 : BATCH * DH * 64;
    if (unit0 >= unit_end) return;
    { const int h = (unit0 >> 6) & 3;
      for (int i = F.tid; i < 3 * 5 * 128; i += NTHR) { const int part = i / 640, tap = (i / 128) % 5, ch = i & 127; CW[i] = conv_w[tap * 1536 + part * 512 + h * 128 + ch]; } }
    stage_raw(unit0);
    auto gate_sc = [&](int un, float pa, float pb) { const int dir = F.wave - 2, h_ = (un >> 6) & 3, b_ = un >> 8, t0_ = (un & 63) * 64; const size_t go = (((size_t)dir * BATCH + b_) * DH + h_) * SEQ;
        float gv = -__expf(a_log[dir * 4 + h_]) * softplus_f(pa + dt_bias[dir * 4 + h_]); const float bv = sigmoid_f(pb);
#pragma unroll
        for (int o = 1; o < 64; o <<= 1) { const float t = __shfl_up(gv, o); if (F.lane >= o) gv += t; }
        const float glv = __builtin_bit_cast(float, __builtin_amdgcn_readlane(__builtin_bit_cast(int, gv), 63));
        SC[dir * 64 + F.lane] = gv; SC[128 + dir * 64 + F.lane] = bv; GCL[go + t0_ + F.lane] = __expf(gv); BETAL[go + t0_ + F.lane] = bv; ((float*)(F.ws + WS_EDL))[go + t0_ + F.lane] = __expf(glv - gv); };
    if (F.wave == 2 || F.wave == 3) { const int dir = F.wave - 2, tl = dir ? 63 - F.lane : F.lane, h_ = (unit0 >> 6) & 3;
        const float* dp = DABp + ((size_t)(unit0 >> 8) * SEQ + (unit0 & 63) * 64 + tl) * 16 + dir * 4 + h_; gate_sc(unit0, dp[0], dp[8]); }
    for (int unit = unit0; unit < unit_end; ++unit) {
        const int tc = unit & 63, h = (unit >> 6) & 3, b = unit >> 8, t0 = tc * 64; const size_t tokb = (size_t)b * SEQ + t0;
        if (unit == unit0) VM_WAIT(); else asm volatile("s_waitcnt vmcnt(4)" ::: "memory");
        LDS_BAR();
        { const int tl2 = F.lane >> 4, cg = F.lane & 15, tk = 8 * F.wave + 2 * tl2;
#ifndef P3_REP_CONV
#define P3_REP_CONV 1
#endif
#pragma unroll 1
          for (int part_ = 0; part_ < 3 * P3_REP_CONV; ++part_) { const int part = part_ % 3;
              u32x4 rawp[6];
#pragma unroll
              for (int rr = 0; rr < 6; ++rr) rawp[rr] = *(const LAS u32x4*)(F.lds + P3_RAW + (tk + rr) * 768 + part * 256 + cg * 16);
              float o[2][8];
#pragma unroll
              for (int e2 = 0; e2 < 4; ++e2) {
                  float lo[6], hi[6];
#pragma unroll
                  for (int rr = 0; rr < 6; ++rr) { lo[rr] = __builtin_bit_cast(float, rawp[rr][e2] << 16); hi[rr] = __builtin_bit_cast(float, rawp[rr][e2] & 0xffff0000u); }
                  float a0 = 0.f, a1 = 0.f, b0 = 0.f, b1 = 0.f;
#pragma unroll
                  for (int tap = 0; tap < 5; ++tap) { const f32x2_t w01 = *(const LAS f32x2_t*)(CW + (part * 5 + tap) * 128 + 8 * cg + 2 * e2); const float w0 = w01[0], w1 = w01[1];
                      a0 += lo[tap] * w0; a1 += hi[tap] * w1; b0 += lo[tap + 1] * w0; b1 += hi[tap + 1] * w1; }
                  o[0][2 * e2] = a0; o[0][2 * e2 + 1] = a1; o[1][2 * e2] = b0; o[1][2 * e2 + 1] = b1;
                  __builtin_amdgcn_sched_barrier(0); }
#pragma unroll
              for (int u = 0; u < 2; ++u) { float ss = 0.f;
#pragma unroll
                  for (int e = 0; e < 8; ++e) { const float x = o[u][e]; const float y = x * __builtin_amdgcn_rcpf(1.f + __expf(-x)); o[u][e] = y; ss += y * y; }
                  if (part < 2) { ss = row16_sum(ss);
                      const float sc = rsqrtf(ss + EPS) * (part == 0 ? 0.08838834764831845f : 1.f);
#pragma unroll
                      for (int e = 0; e < 8; ++e) o[u][e] *= sc; }
                  u32x4 w; w.x = cvt_pk_bf16(o[u][0], o[u][1]); w.y = cvt_pk_bf16(o[u][2], o[u][3]); w.z = cvt_pk_bf16(o[u][4], o[u][5]); w.w = cvt_pk_bf16(o[u][6], o[u][7]);
                  *(u32x4*)(QKVN + ((size_t)((b * 4 + h) * 3 + part) * SEQ + t0 + tk + u) * 128 + 8 * cg) = w;
                  if (part < 2) *(LAS u32x4*)(F.lds + (part == 0 ? P3_QN : P3_KN) + off_b(tk + u, cg)) = w; }
          } }
        LDS_BAR();
        if (unit + 1 < unit_end) stage_raw(unit + 1);
        { const int mat = F.wave >> 2, ti = (F.wave >> 1) & 1, tj = F.wave & 1;
          f32x16 acc;
#pragma unroll
          for (int e = 0; e < 16; ++e) acc[e] = 0.f;
#pragma unroll
          for (int s8 = 0; s8 < 8; ++s8) { const bf16x8 af = *(const LAS bf16x8*)(F.lds + (mat ? P3_QN : P3_KN) + rowread_b(F.lane, 32 * ti, s8)), bfr = *(const LAS bf16x8*)(F.lds + P3_KN + rowread_b(F.lane, 32 * tj, s8));
              acc = __builtin_amdgcn_mfma_f32_32x32x16_bf16(af, bfr, acc, 0, 0, 0); }
          LAS float* dstp = (mat ? TBp : TFp) + 32 * tj + (F.lane & 31);
#pragma unroll
          for (int e = 0; e < 16; ++e) dstp[(32 * ti + (e & 3) + 8 * (e >> 2) + 4 * hh) * LST] = acc[e]; }
        LDS_BAR();
        if (unit + 1 < unit_end && (F.wave == 2 || F.wave == 3)) {
            const int un = unit + 1, dir = F.wave - 2, tl = dir ? 63 - F.lane : F.lane; const float* dp = DABp + ((size_t)(un >> 8) * SEQ + (un & 63) * 64 + tl) * 16 + dir * 4 + ((un >> 6) & 3);
            __builtin_amdgcn_global_load_lds((const unsigned*)dp, (LAS unsigned*)(F.lds + P3_KN + dir * 512), 4, 0, 0); __builtin_amdgcn_global_load_lds((const unsigned*)(dp + 8), (LAS unsigned*)(F.lds + P3_KN + dir * 512 + 256), 4, 0, 0); }
        { LAS bf16* qkf = (LAS bf16*)(F.lds + P3_QN); LAS bf16* qkb = (LAS bf16*)(F.lds + P3_QN + 8192);
          const int jn = F.tid & 63, jr = 63 - jn; const float gfj = SC[jn], gbj = SC[64 + jr];
#ifndef P3_REP_EW
#define P3_REP_EW 1
#endif
          for (int rep = 0; rep < P3_REP_EW; ++rep)
#pragma unroll 2
          for (int i = F.tid >> 6; i < 64; i += 8) { const int ir = 63 - i; const float gv = TFp[i * LST + jn], pv = TBp[i * LST + jn];
              const float df = __expf(SC[i] - gfj), db = __expf(SC[64 + ir] - gbj);
              if (i > jn) LFp[i * LST + jn] = SC[128 + i] * gv * df;
              if (i < jn) LBp[ir * LST + jr] = SC[192 + ir] * gv * db;
              qkf[i * 64 + jn] = f2bf(i >= jn ? pv * df : 0.f); qkb[ir * 64 + jr] = f2bf(i <= jn ? pv * db : 0.f); } }
        LDS_BAR();
#ifndef P3_REP_INV
#define P3_REP_INV 1
#endif
        for (int rep = 0; rep < P3_REP_INV; ++rep) if (F.wave < 2) dn_inverse(F.wave ? LBp : LFp, F.wave ? TBp : TFp, F.lane);
        if (unit + 1 < unit_end && (F.wave == 2 || F.wave == 3)) {
            VM_WAIT(); const LAS float* ab = (const LAS float*)(F.lds + P3_KN + (F.wave - 2) * 512); gate_sc(unit + 1, ab[F.lane], ab[64 + F.lane]); }
        LDS_BAR();
        for (int it = F.tid; it < 1024; it += NTHR) { const int m = it >> 9, i = (it >> 3) & 63, c8 = it & 7; const LAS float* tp = (m ? TBp : TFp) + i * LST + 8 * c8;
            const f32x4 x0 = *(const LAS f32x4*)tp, x1 = *(const LAS f32x4*)(tp + 4);
            u32x4 w; w.x = cvt_pk_bf16(x0[0], x0[1]); w.y = cvt_pk_bf16(x0[2], x0[3]); w.z = cvt_pk_bf16(x1[0], x1[1]); w.w = cvt_pk_bf16(x1[2], x1[3]);
            *(u32x4*)(TQK + ((size_t)unit * 4 + 2 * m) * 4096 + i * 64 + 8 * c8) = w;
            *(u32x4*)(TQK + ((size_t)unit * 4 + 2 * m + 1) * 4096 + i * 64 + 8 * c8) = *(const LAS u32x4*)(F.lds + P3_QN + m * 8192 + i * 128 + c8 * 16); }
    }
}
constexpr int P4_BUF = 57344, P4_KN = 0, P4_QN = 16384, P4_VN = 32768, P4_T = 40960, P4_QK = 49152, P4_ST = 114688, P4_RT = 131072, P4_VNT = 139264, P4_VDT = 147456, P4_SC = 155648;
__device__ __forceinline__ unsigned off_s(unsigned row, unsigned ch) { return 128u * row + (((ch ^ ((row >> 1) & 7u))) << 4); }
__device__ __forceinline__ unsigned rowread_s(unsigned lane, unsigned rowbase, unsigned s) { return off_s(rowbase + (lane & 31), 2 * s + (lane >> 5)); }
__device__ __forceinline__ void p4_stage(const Frame& F, const bf16* QKVN, const bf16* TQK, const float* GCL, const float* BETAL, int b, int h, int dir, int dvh, int n, int buf) {
    const int tc = dir ? 63 - n : n, t0 = tc * 64; const size_t tokb = (size_t)t0, pl0 = (size_t)((b * 4 + h) * 3) * SEQ; const size_t u3 = (size_t)((b * 4 + h) * 64 + tc);
    LAS unsigned char* B = F.lds + buf * P4_BUF; const int L = F.lane, w = F.wave;
    {
#pragma unroll
      for (int k = 0; k < 2; ++k) { const int q = w + 8 * k, row = 4 * q + (L >> 4), pos = L & 15, ch = pos ^ (((row & 3) << 2) | ((row >> 2) & 3)); const size_t tok = tokb + (dir ? 63 - row : row);
          __builtin_amdgcn_global_load_lds((const unsigned*)(QKVN + (pl0 + SEQ + tok) * 128 + ch * 8), (LAS unsigned*)(B + P4_KN + q * 1024), 16, 0, 0);
          __builtin_amdgcn_global_load_lds((const unsigned*)(QKVN + (pl0 + tok) * 128 + ch * 8), (LAS unsigned*)(B + P4_QN + q * 1024), 16, 0, 0); } }
    { const int row = 8 * w + (L >> 3), pos = L & 7, chs = pos ^ ((row >> 1) & 7); const size_t tok = tokb + (dir ? 63 - row : row);
      __builtin_amdgcn_global_load_lds((const unsigned*)(QKVN + (pl0 + 2 * SEQ + tok) * 128 + dvh * 64 + pos * 8), (LAS unsigned*)(B + P4_VN + w * 1024), 16, 0, 0);
      __builtin_amdgcn_global_load_lds((const unsigned*)(TQK + (u3 * 4 + 2 * dir) * 4096 + row * 64 + chs * 8), (LAS unsigned*)(B + P4_T + w * 1024), 16, 0, 0);
      __builtin_amdgcn_global_load_lds((const unsigned*)(TQK + (u3 * 4 + 2 * dir + 1) * 4096 + row * 64 + chs * 8), (LAS unsigned*)(B + P4_QK + w * 1024), 16, 0, 0); }
    if (w == 0) { const size_t go = (((size_t)dir * BATCH + b) * DH + h) * SEQ + t0; LAS unsigned char* sc = F.lds + P4_SC + buf * 1024;
        __builtin_amdgcn_global_load_lds((const unsigned*)(GCL + go + L), (LAS unsigned*)sc, 4, 0, 0); __builtin_amdgcn_global_load_lds((const unsigned*)(BETAL + go + L), (LAS unsigned*)(sc + 256), 4, 0, 0);
        __builtin_amdgcn_global_load_lds((const unsigned*)((const float*)(F.ws + WS_EDL) + go + L), (LAS unsigned*)(sc + 512), 4, 0, 0); }
}
__device__ __forceinline__ void phase_dnscan(const Frame& F, const Args& a) {
    const bf16* QKVN = (const bf16*)a.out; const bf16* TQK = (const bf16*)(F.ws + WS_TQK); const float* GCL = (const float*)(F.ws + WS_GCL); const float* BETAL = (const float*)(F.ws + WS_BETAL);
    bf16* O = (bf16*)(F.ws + WS_A);
    const int w = F.wave, L = F.lane, hh = L >> 5, l31 = L & 31;
    const int mat = w >> 2, ti = (w >> 1) & 1, tj = w & 1, kt = w >> 1, nt = w & 1;
    for (int unit = F.vcu; unit < BATCH * DH * 4; unit += F.G) {
        const int dvh = unit & 1, dir = (unit >> 1) & 1, h = (unit >> 2) & 3, b = unit >> 4;
        __syncthreads();
        for (int i = F.tid; i < 16384 / 16; i += NTHR) ((LAS u32x4*)(F.lds + P4_ST))[i] = (u32x4){0u, 0u, 0u, 0u};
        p4_stage(F, QKVN, TQK, GCL, BETAL, b, h, dir, dvh, 0, 0);
        f32x16 sacc;
#pragma unroll
        for (int e = 0; e < 16; ++e) sacc[e] = 0.f;
        VM_WAIT(); __syncthreads();
        f32x16 accO; bf16x8 oqk[4], ovn[4];
#pragma unroll
        for (int e = 0; e < 16; ++e) accO[e] = 0.f;
#pragma unroll
        for (int s4 = 0; s4 < 4; ++s4) { oqk[s4] = (bf16x8){0, 0, 0, 0, 0, 0, 0, 0}; ovn[s4] = (bf16x8){0, 0, 0, 0, 0, 0, 0, 0}; }
        auto finish_o = [&](int nprev) {
#pragma unroll
            for (int s4 = 0; s4 < 4; ++s4) accO = __builtin_amdgcn_mfma_f32_32x32x16_bf16(oqk[s4], ovn[s4], accO, 0, 0, 0);
            unsigned dwv = DW, i0v = 32 * ti + 4 * hh; asm volatile("" : "+v"(dwv), "+v"(i0v));
            const int tc = dir ? 63 - nprev : nprev; bf16* op = O + ((size_t)dir * NT + (size_t)b * SEQ + tc * 64) * DW + h * 128 + dvh * 64 + 32 * tj + l31;
#pragma unroll
            for (int e = 0; e < 16; ++e) { const int i = (int)i0v + (e & 3) + 8 * (e >> 2); op[(unsigned)(dir ? 63 - i : i) * dwv] = f2bf(accO[e]); } };
        for (int n = 0; n < 64; ++n) {
            const int cb = n & 1; const LAS unsigned char* B = F.lds + cb * P4_BUF; const LAS float* sc = (const LAS float*)(F.lds + P4_SC + cb * 1024);
            if (n + 1 < 64) p4_stage(F, QKVN, TQK, GCL, BETAL, b, h, dir, dvh, n + 1, cb ^ 1);
            f32x16 acc1;
#pragma unroll
            for (int e = 0; e < 16; ++e) acc1[e] = 0.f;
#pragma unroll
            for (int hb = 0; hb < 2; ++hb) { bf16x8 fa[4], fb[4];
#pragma unroll
              for (int s4 = 0; s4 < 4; ++s4) { const int s8 = 4 * hb + s4; fa[s4] = *(const LAS bf16x8*)(B + (mat ? P4_QN : P4_KN) + rowread_b(L, 32 * ti, s8)); fb[s4] = *(const LAS bf16x8*)(F.lds + P4_ST + rowread_b(L, 32 * tj, s8)); }
              __builtin_amdgcn_sched_barrier(0);
#pragma unroll
              for (int s4 = 0; s4 < 4; ++s4) acc1 = __builtin_amdgcn_mfma_f32_32x32x16_bf16(fa[s4], fb[s4], acc1, 0, 0, 0);
              __builtin_amdgcn_sched_barrier(0); }
            const int ncol = 32 * tj + l31;
            if (mat == 0) {
                bf16 vraw[16];
#pragma unroll
                for (int e = 0; e < 16; ++e) vraw[e] = *(const LAS bf16*)(B + P4_VN + (32 * ti + 8 * (e >> 2) + 4 * hh + (e & 3)) * 128 + ncol * 2);
                __builtin_amdgcn_sched_barrier(0);
#pragma unroll
                for (int rg = 0; rg < 4; ++rg) { float r4[4];
#pragma unroll
                    for (int q = 0; q < 4; ++q) { const int i = 32 * ti + 8 * rg + 4 * hh + q; const float vv = bf2f(vraw[4 * rg + q]);
                        r4[q] = sc[64 + i] * (vv - sc[i] * acc1[4 * rg + q]); }
                    *(LAS unsigned long long*)(F.lds + P4_RT + off_s(ncol, 4 * ti + rg) + 8 * hh) = (unsigned long long)cvt_pk_bf16(r4[0], r4[1]) | ((unsigned long long)cvt_pk_bf16(r4[2], r4[3]) << 32); }
            } else {
#pragma unroll
                for (int e = 0; e < 16; ++e) { const int i = 32 * ti + (e & 3) + 8 * (e >> 2) + 4 * hh; acc1[e] *= sc[i]; }
            }
            LDS_BAR();
            if (mat == 0) {
                f32x16 va;
#pragma unroll
                for (int e = 0; e < 16; ++e) va[e] = 0.f;
                { bf16x8 fa[4], fb[4];
#pragma unroll
                  for (int s4 = 0; s4 < 4; ++s4) { fa[s4] = *(const LAS bf16x8*)(B + P4_T + rowread_s(L, 32 * ti, s4)); fb[s4] = *(const LAS bf16x8*)(F.lds + P4_RT + rowread_s(L, 32 * tj, s4)); }
                  __builtin_amdgcn_sched_barrier(0);
#pragma unroll
                  for (int s4 = 0; s4 < 4; ++s4) va = __builtin_amdgcn_mfma_f32_32x32x16_bf16(fa[s4], fb[s4], va, 0, 0, 0); }
#pragma unroll
                for (int rg = 0; rg < 4; ++rg) { float d4[4];
#pragma unroll
                    for (int q = 0; q < 4; ++q) d4[q] = va[4 * rg + q] * sc[128 + 32 * ti + 8 * rg + 4 * hh + q];
                    const unsigned o8 = off_s(ncol, 4 * ti + rg) + 8 * hh;
                    *(LAS unsigned long long*)(F.lds + P4_VNT + o8) = (unsigned long long)cvt_pk_bf16(va[4 * rg], va[4 * rg + 1]) | ((unsigned long long)cvt_pk_bf16(va[4 * rg + 2], va[4 * rg + 3]) << 32);
                    *(LAS unsigned long long*)(F.lds + P4_VDT + o8) = (unsigned long long)cvt_pk_bf16(d4[0], d4[1]) | ((unsigned long long)cvt_pk_bf16(d4[2], d4[3]) << 32); }
            } else if (n > 0) finish_o(n - 1);
            LDS_BAR();
            if (mat == 1) {
#pragma unroll
                for (int s4 = 0; s4 < 4; ++s4) { oqk[s4] = *(const LAS bf16x8*)(B + P4_QK + rowread_s(L, 32 * ti, s4)); ovn[s4] = *(const LAS bf16x8*)(F.lds + P4_VNT + rowread_s(L, 32 * tj, s4)); }
                accO = acc1;
            }
            { const float egl = sc[63];
#pragma unroll
              for (int e = 0; e < 16; ++e) sacc[e] *= egl;
              const unsigned blk = (L >> 4) & 1, q4 = (L & 15) >> 2, p4 = L & 3;
              bf16x8 fv[4];
#pragma unroll
              for (int s4 = 0; s4 < 4; ++s4) fv[s4] = *(const LAS bf16x8*)(F.lds + P4_VDT + rowread_s(L, 32 * nt, s4));
              v4i16_t tv[8];
              { const unsigned kb = (unsigned)(size_t)(B + P4_KN), a0 = kb + off_b(8 * hh + q4, 4 * kt + 2 * blk + (p4 >> 1)) + 8 * (p4 & 1), a1 = kb + off_b(8 * hh + 4 + q4, 4 * kt + 2 * blk + (p4 >> 1)) + 8 * (p4 & 1);
                asm volatile("ds_read_b64_tr_b16 %0, %8\n\tds_read_b64_tr_b16 %1, %9\n\tds_read_b64_tr_b16 %2, %8 offset:4096\n\tds_read_b64_tr_b16 %3, %9 offset:4096\n\t"
                             "ds_read_b64_tr_b16 %4, %8 offset:8192\n\tds_read_b64_tr_b16 %5, %9 offset:8192\n\tds_read_b64_tr_b16 %6, %8 offset:12288\n\tds_read_b64_tr_b16 %7, %9 offset:12288\n\ts_waitcnt lgkmcnt(0)"
                             : "=&v"(tv[0]), "=&v"(tv[1]), "=&v"(tv[2]), "=&v"(tv[3]), "=&v"(tv[4]), "=&v"(tv[5]), "=&v"(tv[6]), "=&v"(tv[7]) : "v"(a0), "v"(a1) : "memory"); }
#pragma unroll
              for (int s4 = 0; s4 < 4; ++s4) { const v4i16_t t0v = tv[2 * s4], t1v = tv[2 * s4 + 1];
                  bf16x8 af; af[0] = t0v[0]; af[1] = t0v[1]; af[2] = t0v[2]; af[3] = t0v[3]; af[4] = t1v[0]; af[5] = t1v[1]; af[6] = t1v[2]; af[7] = t1v[3];
                  sacc = __builtin_amdgcn_mfma_f32_32x32x16_bf16(af, fv[s4], sacc, 0, 0, 0); }
              const int nn = 32 * nt + l31;
#pragma unroll
              for (int rg = 0; rg < 4; ++rg)
                  *(LAS unsigned long long*)(F.lds + P4_ST + off_b(nn, 4 * kt + rg) + 8 * hh) = (unsigned long long)cvt_pk_bf16(sacc[4 * rg], sacc[4 * rg + 1]) | ((unsigned long long)cvt_pk_bf16(sacc[4 * rg + 2], sacc[4 * rg + 3]) << 32);
            }
            if (mat == 1 && n > 0) asm volatile("s_waitcnt vmcnt(16)" ::: "memory"); else VM_WAIT();
            LDS_BAR();
        }
        if (mat == 1) finish_o(63);
        VM_WAIT();
    }
}
__device__ __forceinline__ void phase_post(const Frame& F, const Args& a) {
    bf16* MIX = (bf16*)(F.ws + WS_MIX); const bf16* O = (const bf16*)(F.ws + WS_A); const bf16* PROJ = (const bf16*)(F.ws + WS_PROJ); const float* ag = a.in[6]; const float* dg = a.in[10];
    const int gw = F.vcu * NWAVES + F.wave, NGW = F.G * NWAVES, lane = F.lane;
    const f32x4 g0 = *(const f32x4*)(ag + lane * 8), g1 = *(const f32x4*)(ag + lane * 8 + 4);
    const f32x4 d0 = *(const f32x4*)(dg + (lane & 15) * 8), d1 = *(const f32x4*)(dg + (lane & 15) * 8 + 4);
    u32x4 nav, nof, nob, nzv;
    if (gw < NT) { nav = *(const u32x4*)(MIX + (size_t)gw * DM + lane * 8); nof = *(const u32x4*)(O + (size_t)gw * DW + lane * 8); nob = *(const u32x4*)(O + ((size_t)NT + gw) * DW + lane * 8); nzv = *(const u32x4*)(PROJ + (size_t)gw * PC + C_DZ + lane * 8); }
    for (int tok = gw; tok < NT; tok += NGW) {
        bf16* mp = MIX + (size_t)tok * DM;
        const u32x4 av = nav, of = nof, ob = nob, zv = nzv;
        { const int tn = tok + NGW < NT ? tok + NGW : tok;
          nav = *(const u32x4*)(MIX + (size_t)tn * DM + lane * 8); nof = *(const u32x4*)(O + (size_t)tn * DW + lane * 8); nob = *(const u32x4*)(O + ((size_t)NT + tn) * DW + lane * 8); nzv = *(const u32x4*)(PROJ + (size_t)tn * PC + C_DZ + lane * 8); }
        float x[8]; float ss = 0.f;
#pragma unroll
        for (int e = 0; e < 4; ++e) { x[2 * e] = __builtin_bit_cast(float, av[e] << 16); x[2 * e + 1] = __builtin_bit_cast(float, av[e] & 0xffff0000u); ss += x[2 * e] * x[2 * e] + x[2 * e + 1] * x[2 * e + 1]; }
        const float rstd = rsqrtf(wave_sum(ss) * (1.f / 512) + EPS);
        u32x4 w; w.x = cvt_pk_bf16(x[0] * rstd * g0[0], x[1] * rstd * g0[1]); w.y = cvt_pk_bf16(x[2] * rstd * g0[2], x[3] * rstd * g0[3]); w.z = cvt_pk_bf16(x[4] * rstd * g1[0], x[5] * rstd * g1[1]); w.w = cvt_pk_bf16(x[6] * rstd * g1[2], x[7] * rstd * g1[3]);
        *(u32x4*)(mp + lane * 8) = w;
        float o[8], z[8]; float s2 = 0.f;
#pragma unroll
        for (int e = 0; e < 4; ++e) { o[2 * e] = __builtin_bit_cast(float, of[e] << 16) + __builtin_bit_cast(float, ob[e] << 16); o[2 * e + 1] = __builtin_bit_cast(float, of[e] & 0xffff0000u) + __builtin_bit_cast(float, ob[e] & 0xffff0000u);
            z[2 * e] = __builtin_bit_cast(float, zv[e] << 16); z[2 * e + 1] = __builtin_bit_cast(float, zv[e] & 0xffff0000u); s2 += o[2 * e] * o[2 * e] + o[2 * e + 1] * o[2 * e + 1]; }
        s2 = row16_sum(s2);
        const float r2 = rsqrtf(s2 * (1.f / 128) + EPS);
        float y[8];
#pragma unroll
        for (int e = 0; e < 8; ++e) y[e] = o[e] * r2 * (e < 4 ? d0[e] : d1[e - 4]) * z[e] * __builtin_amdgcn_rcpf(1.f + __expf(-z[e]));
        u32x4 w2; w2.x = cvt_pk_bf16(y[0], y[1]); w2.y = cvt_pk_bf16(y[2], y[3]); w2.z = cvt_pk_bf16(y[4], y[5]); w2.w = cvt_pk_bf16(y[6], y[7]);
        *(u32x4*)(mp + 512 + lane * 8) = w2;
    }
}

__global__ void __launch_bounds__(NTHR, 2) fwd(Args args) {
    extern __shared__ __attribute__((aligned(16))) unsigned char lds_raw[];
    Frame F; F.lds = (LAS unsigned char*)lds_raw; F.tid = threadIdx.x; F.lane = F.tid & 63; F.wave = __builtin_amdgcn_readfirstlane(F.tid >> 6);
    F.G = gridDim.x; { const int bx = blockIdx.x; F.vcu = (F.G % 8 == 0) ? (bx % 8) * (F.G / 8) + bx / 8 : bx; } F.ws = args.ws;
    gu32* ctl = (gu32*)(F.ws + WS_CTL);
    for (int u = F.tid; u < 128; u += NTHR) ((LAS unsigned*)(F.lds + LDSCTL_OFF))[u] = 0u;
    __syncthreads();
    const int lo = args.ph_lo, hi = args.ph_hi;
    XcdBarrier bar; bar.bar = (unsigned*)ctl + CW_BAR; bar.x = 0; bar.st = nullptr;
    if (hi - lo > 1) bar = xcd_barrier_post((unsigned*)ctl + CW_BAR, (volatile LAS unsigned*)(F.lds + MISC_OFF));
#ifndef PH_MASK
#define PH_MASK 0xffff
#endif
#define IN(k) (((PH_MASK >> (k)) & 1) && lo <= (k) && (k) < hi)
#define SEAM(k) do { if (IN(k) && IN((k) + 1)) xcd_barrier(bar); } while (0)
#ifndef ALIGN1
#define ALIGN1 false
#endif
#ifndef ALIGN6
#define ALIGN6 true
#endif
#ifndef ALIGN8
#define ALIGN8 true
#endif
#ifndef ALIGN9
#define ALIGN9 true
#endif
#ifndef DBL_MASK
#define DBL_MASK 0
#endif
#define DBL(k) (((DBL_MASK >> (k)) & 1) != 0)
    bf16* XN = (bf16*)(F.ws + WS_A); bf16* X2B = (bf16*)(F.ws + WS_A); bf16* PROJ = (bf16*)(F.ws + WS_PROJ); bf16* MIX = (bf16*)(F.ws + WS_MIX);
    bf16* HID = (bf16*)(F.ws + WS_HID); bf16* Y = (bf16*)(F.ws + WS_Y); float* SSQ2 = (float*)(F.ws + WS_SSQ2);
    if (IN(0)) { phase0(F, args); if (DBL(0)) { xcd_barrier(bar); phase0(F, args); } } SEAM(0);
    if (IN(1)) {
        LAS float* gains = (LAS float*)(F.lds + TAB_OFF);
        if (F.tid < 64) gains[F.tid] = args.in[3][F.tid] * (0.125f * LOG2E); else if (F.tid < 128) gains[F.tid] = args.in[4][F.tid - 64];
        __syncthreads();
        pg8::Gemm g{XN, (const bf16*)(F.ws + WS_WIN), DM, 0, DM, 0}; pg8::StaticOrder S; S.init(NT, PC + 256, F.G, (int)blockIdx.x);
        pg8::gemm_phase<EpiInProjF, pg8::StaticOrder, pg8::DenseA, ALIGN1>(F.lds, g, S, pg8::DenseA{DM}, EpiInProjF{PROJ, gains, (float*)(F.ws + WS_DAB)});
    } SEAM(1);
    if (IN(2)) { phase_na(F, args); if (DBL(2)) { xcd_barrier(bar); phase_na(F, args); } }
    __syncthreads();
    if (IN(3)) { phase_dnprep(F, args); if (DBL(3)) { xcd_barrier(bar); phase_dnprep(F, args); } } SEAM(3);
    if (IN(4)) { phase_dnscan(F, args); if (DBL(4)) { xcd_barrier(bar); phase_dnscan(F, args); } } SEAM(4);
    if (IN(5)) { phase_post(F, args); } SEAM(5);
    if (IN(6)) {
        pg8::Gemm g{MIX, (const bf16*)(F.ws + WS_WO), DM, 0, DM, 0}; pg8::StaticOrder S; S.init(NT, DM, F.G, (int)blockIdx.x);
        pg8::gemm_phase<EpiOutF, pg8::StaticOrder, pg8::DenseA, ALIGN6>(F.lds, g, S, pg8::DenseA{DM}, EpiOutF{args.in[0], args.out, X2B, SSQ2});
    } SEAM(6);
    if (IN(7)) {
        pg8::Gemm g{X2B, (const bf16*)(F.ws + WS_WR), DM, 0, DM, 0}; pg8::StaticOrder S; S.init(NT, 256, F.G, (int)blockIdx.x);
        EpiRouterF E{SSQ2, args.in[14], args.in[16], (int*)(F.ws + WS_TOKE), (float*)(F.ws + WS_TOKG), (float*)(F.ws + WS_RSTD2), (int*)(F.ws + WS_BIDX), (unsigned*)ctl + CW_CNT};
        pg8::gemm_phase<EpiRouterF, pg8::StaticOrder, pg8::DenseA, false>(F.lds, g, S, pg8::DenseA{DM}, E);
    } SEAM(7);
    if (IN(8)) {
        const int n = moe_setup1(F);
        pg8::Gemm g{X2B, (const bf16*)(F.ws + WS_WGU), DM, (size_t)512 * DM * 2, DM, 0};
        MoeSched S{(const LAS int*)(F.lds + TAB_OFF + TB_UT), n};
        const LAS unsigned* t0 = (const LAS unsigned*)(F.lds + TAB_OFF + TB_T);
        pg8::gemm_phase<EpiMoe1F, MoeSched, pg8::GatherA, ALIGN8>(F.lds, g, S, pg8::GatherA{t0}, EpiMoe1F{HID, (const LAS float*)(t0 + 6 * 256), t0 + 12 * 256, (const LAS float*)(t0 + 18 * 256)});
    } SEAM(8);
    if (IN(9)) {
        const int n = moe_setup2(F);
        pg8::Gemm g{HID, (const bf16*)(F.ws + WS_WD), 2 * DE, (size_t)DM * DE * 2, DE, 4};
        MoeSched S{(const LAS int*)(F.lds + TAB_OFF + TB_UT), n};
        pg8::gemm_phase<EpiMoe2F, MoeSched, pg8::DenseA, ALIGN9>(F.lds, g, S, pg8::DenseA{2 * DE}, EpiMoe2F{X2B, args.out, (const LAS unsigned*)(F.lds + TAB_OFF + TB_T)});
    }
#undef IN
#undef SEAM
}


extern "C" void kernel_launch(void* const* d_in, const int* in_sizes, int n_in, void* d_out, int out_size, void* d_ws, size_t ws_size, hipStream_t stream) {
    static int grid = 0;
    if (grid == 0) {
        if (n_in != 20 || in_sizes[0] != NT * DM || out_size != NT * DM || ws_size < WS_END2) { fprintf(stderr, "kernel_launch: unexpected n_in %d / sizes / ws_size %zu (need %zu)\n", n_in, ws_size, (size_t)WS_END2); grid = -1; return; }
        int dev = 0, cus = 0, per_cu = 0;
        if (hipGetDevice(&dev) != hipSuccess || hipDeviceGetAttribute(&cus, hipDeviceAttributeMultiprocessorCount, dev) != hipSuccess) { grid = -1; return; }
        if (hipFuncSetAttribute((const void*)fwd, hipFuncAttributeMaxDynamicSharedMemorySize, LDS_BYTES) != hipSuccess) { fprintf(stderr, "kernel_launch: hipFuncSetAttribute failed\n"); grid = -1; return; }
        if (hipOccupancyMaxActiveBlocksPerMultiprocessor(&per_cu, (const void*)fwd, NTHR, LDS_BYTES) != hipSuccess || per_cu < 1) fprintf(stderr, "kernel_launch: occupancy query says %d\n", per_cu);
        (void)hipGetLastError();
        grid = cus;
    }
    if (grid < 0) return;
    (void)hipMemsetAsync((unsigned char*)d_ws + WS_CTL, 0, 1 * MiB, stream);
    Args a{}; for (int i = 0; i < 20; ++i) a.in[i] = (const float*)d_in[i]; a.out = (float*)d_out; a.ws = (unsigned char*)d_ws;
#define FWD(lo_, hi_) do { a.ph_lo = (lo_); a.ph_hi = (hi_); hipLaunchKernelGGL(fwd, dim3(grid), dim3(NTHR), LDS_BYTES, stream, a); } while (0)
#if defined(PROBE_EXTRA)
    for (int k = 0; k < 10; ++k) { FWD(k, k + 1); if (k == PROBE_EXTRA) FWD(k, k + 1); }
#else
    FWD(0, 10);
#endif
}
```

```cpp
#include <hip/hip_runtime.h>
#include <cstdio>
#include <cstdint>

typedef unsigned short bf16;
typedef unsigned u32x4 __attribute__((ext_vector_type(4)));
typedef float f32x4 __attribute__((ext_vector_type(4)));

constexpr int BATCH = 16, SEQ = 4096, DM = 1024, NT = BATCH * SEQ;
constexpr int GW = 64, ROWS = SEQ / GW, KH = 8, KW = 16;
constexpr int AH = 8, ADH = 64, AW = 512;
constexpr int DH = 4, DHD = 128, DW = 512, DCONV = 5, DCHUNK = 64;
constexpr int INC = 3600, PC = 3584;
constexpr int NG = 8, EPG = 8, NE = 64, DE = 256;
constexpr float EPS = 1e-6f;
constexpr float LOG2E = 1.4426950408889634f;
constexpr int C_AQ = 0, C_AK = 512, C_AV = 1024, C_DQ = 1536, C_DK = 2048, C_DV = 2560, C_DZ = 3072;

constexpr size_t MiB = 1ull << 20;
constexpr size_t WS_CTL   = 0;
constexpr size_t WS_WIN   = 1 * MiB;
constexpr size_t WS_WO    = 8 * MiB + 512 * 1024;
constexpr size_t WS_WR    = 10 * MiB + 512 * 1024;
constexpr size_t WS_WGU   = 11 * MiB;
constexpr size_t WS_WD    = 75 * MiB;
constexpr size_t WS_A     = 107 * MiB;
constexpr size_t WS_PROJ  = 235 * MiB;
constexpr size_t WS_MIX   = 683 * MiB;
constexpr size_t WS_TQK   = 811 * MiB;
constexpr size_t WS_DAB   = 939 * MiB;
constexpr size_t WS_G     = 943 * MiB;
constexpr size_t WS_BETA  = 945 * MiB;
constexpr size_t WS_TOKE  = 947 * MiB;
constexpr size_t WS_TOKG  = 948 * MiB;
constexpr size_t WS_RSTD2 = 949 * MiB;
constexpr size_t WS_BIDX  = 950 * MiB;
constexpr size_t WS_END   = 966 * MiB;
constexpr size_t WS_HID   = WS_PROJ;
constexpr size_t WS_Y     = WS_PROJ + 80 * MiB;
constexpr int CW_CNT = 1024;

__device__ __forceinline__ float bf2f(bf16 v) { return __builtin_bit_cast(float, (unsigned)v << 16); }
__device__ __forceinline__ bf16 f2bf(float f) { unsigned u = __builtin_bit_cast(unsigned, f); return (bf16)((u + 0x7fffu + ((u >> 16) & 1u)) >> 16); }
template <int CTRL> __device__ __forceinline__ float dpp_f(float v) { return __builtin_bit_cast(float, __builtin_amdgcn_update_dpp(0, __builtin_bit_cast(int, v), CTRL, 0xf, 0xf, false)); }
__device__ __forceinline__ float row16_sum(float v) {
    v += dpp_f<0xB1>(v);
    v += dpp_f<0x4E>(v);
    v += dpp_f<0x141>(v);
    v += dpp_f<0x140>(v);
    return v;
}
__device__ __forceinline__ float wave_sum(float v) {
    const int b = __builtin_bit_cast(int, row16_sum(v));
    return (__builtin_bit_cast(float, __builtin_amdgcn_readlane(b, 0)) + __builtin_bit_cast(float, __builtin_amdgcn_readlane(b, 16))) + (__builtin_bit_cast(float, __builtin_amdgcn_readlane(b, 32)) + __builtin_bit_cast(float, __builtin_amdgcn_readlane(b, 48)));
}
__device__ __forceinline__ float silu_f(float x) { return x / (1.f + __expf(-x)); }
__device__ __forceinline__ float sigmoid_f(float x) { return 1.f / (1.f + __expf(-x)); }
__device__ __forceinline__ float softplus_f(float x) { return fmaxf(x, 0.f) + log1pf(__expf(-fabsf(x))); }

#define LAS __attribute__((address_space(3)))
#define GAS __attribute__((address_space(1)))
typedef short bf16x8 __attribute__((ext_vector_type(8)));
typedef GAS unsigned gu32;
constexpr int NWAVES = 8, NTHR = 512;
constexpr int LDS_BYTES = 163840, RING_BYTES = 131072, LDSCTL_OFF = 163328, MISC_OFF = LDSCTL_OFF + 64, TAB_OFF = 132096;
constexpr size_t WS_SSQ2 = 966 * MiB;
constexpr size_t WS_EDL  = 970 * MiB;
constexpr size_t WS_GCR  = 972 * MiB;
constexpr size_t WS_END2 = 974 * MiB;
constexpr int CW_TMO = 0, CW_BAR = 4096;
constexpr int CW_PCNT = 1280;
constexpr size_t WS_R2T = WS_CTL + 256 * 1024;
constexpr size_t WS_TOKP = WS_TOKE;
#define RLX_AGENT __ATOMIC_RELAXED, __HIP_MEMORY_SCOPE_AGENT
#define LDS_WAIT() asm volatile("s_waitcnt lgkmcnt(0)" ::: "memory")
#define VM_WAIT() asm volatile("s_waitcnt vmcnt(0)" ::: "memory")
#define LDS_BAR() do { asm volatile("s_waitcnt lgkmcnt(0)" ::: "memory"); __builtin_amdgcn_s_barrier(); asm volatile("" ::: "memory"); } while (0)
__device__ __forceinline__ unsigned pk2(float lo, float hi) { return (unsigned)f2bf(lo) | ((unsigned)f2bf(hi) << 16); }
typedef float f32x2_t __attribute__((ext_vector_type(2)));
typedef __bf16 bf16x2_t __attribute__((ext_vector_type(2)));
__device__ __forceinline__ unsigned cvt_pk_bf16_asm(float lo, float hi) { unsigned r; asm volatile("v_cvt_pk_bf16_f32 %0, %1, %2" : "=v"(r) : "v"(lo), "v"(hi)); return r; }
__device__ __forceinline__ unsigned cvt_pk_bf16(float lo, float hi) { const f32x2_t v = {lo, hi}; const bf16x2_t b = __builtin_convertvector(v, bf16x2_t); return __builtin_bit_cast(unsigned, b); }

#define XB_TMO      128
#define XB_XCNT(j)  (256  + 64 * (j))
#define XB_XSUB(j)  (1280 + 64 * (j))
#define XB_XGEN(j)  (2304 + 64 * (j))
#define XB_TOP      3328
#define XB_TOPGEN   3392
#define XCD_BAR_WORDS 3456
#define XB_SPIN_CAP (1u << 22)
__device__ __forceinline__ unsigned xb_ld(unsigned* p)              { return __hip_atomic_load(p, __ATOMIC_RELAXED, __HIP_MEMORY_SCOPE_AGENT); }
__device__ __forceinline__ unsigned xb_add(unsigned* p, unsigned v) { return __hip_atomic_fetch_add(p, v, __ATOMIC_RELAXED, __HIP_MEMORY_SCOPE_AGENT); }
__device__ __forceinline__ unsigned xb_xcc_id() { return (unsigned)__builtin_amdgcn_s_getreg((3 << 11) | 20) & 0xFu; }
#define XB_SPIN(cond, bar) do { unsigned _sp = 0; while (cond) { __builtin_amdgcn_s_sleep(1); \
    if ((++_sp & 255u) == 0u) { if (xb_ld(&(bar)[XB_TMO])) break; if (_sp > XB_SPIN_CAP) { atomicAdd(&(bar)[XB_TMO], 1u); break; } } } } while (0)
struct XcdBarrier { unsigned* bar; unsigned x; volatile LAS unsigned* st; };
__device__ __forceinline__ XcdBarrier xcd_barrier_post(unsigned* bar, volatile LAS unsigned* st) {
    XcdBarrier b; b.bar = bar; b.x = xb_xcc_id(); b.st = st;
    if (threadIdx.x == 0) (void)xb_add(&bar[XB_XCNT(b.x)], 1u);
    return b;
}
__device__ __forceinline__ void xcd_barrier_complete(unsigned* bar, unsigned x, unsigned& nloc, unsigned& nx) {
    const unsigned G = gridDim.x * gridDim.y * gridDim.z;
    unsigned sum, cnt, mine, sp = 0u;
    for (;;) {
        sum = 0u; cnt = 0u; mine = 0u;
#pragma unroll
        for (unsigned j = 0; j < 16; ++j) { const unsigned c = xb_ld(&bar[XB_XCNT(j)]); sum += c; cnt += (c > 0u) ? 1u : 0u; mine = (j == x) ? c : mine; }
        if (sum == G) break;
        __builtin_amdgcn_s_sleep(1);
        if ((++sp & 255u) == 0u) { if (xb_ld(&bar[XB_TMO])) break; if (sp > XB_SPIN_CAP) { atomicAdd(&bar[XB_TMO], 1u); break; } }
    }
    nloc = mine > 0u ? mine : 1u; nx = cnt > 0u ? cnt : 1u;
}
__device__ __forceinline__ void xcd_barrier(const XcdBarrier& b) {
    asm volatile("s_waitcnt vmcnt(0)" ::: "memory");
    __syncthreads();
    if (threadIdx.x == 0) {
        unsigned* bar = b.bar;
        __builtin_amdgcn_s_waitcnt(0);
        unsigned nloc = b.st[0], nx = b.st[1];
        if (nloc == 0u) { xcd_barrier_complete(bar, b.x, nloc, nx); b.st[0] = nloc; b.st[1] = nx; }
        const unsigned old = xb_add(&bar[XB_XSUB(b.x)], 1u);
        const unsigned gen = old / nloc;
        if (old + 1u == (gen + 1u) * nloc) {
            __builtin_amdgcn_fence(__ATOMIC_RELEASE, "agent");
            asm volatile("s_waitcnt vmcnt(0)" ::: "memory");
            const unsigned og = xb_add(&bar[XB_TOP], 1u);
            const unsigned tg = og / nx;
            if (og + 1u == (tg + 1u) * nx) xb_add(&bar[XB_TOPGEN], 1u);
            else XB_SPIN(xb_ld(&bar[XB_TOPGEN]) == tg, bar);
            __builtin_amdgcn_fence(__ATOMIC_ACQUIRE, "agent");
            xb_add(&bar[XB_XGEN(b.x)], 1u);
            asm volatile("s_waitcnt vmcnt(0)" ::: "memory");
        } else {
            XB_SPIN(xb_ld(&bar[XB_XGEN(b.x)]) == gen, bar);
            __builtin_amdgcn_fence(__ATOMIC_ACQUIRE, "agent");
            asm volatile("s_waitcnt vmcnt(0)" ::: "memory");
        }
    }
    __syncthreads();
}

namespace pg8 {
constexpr int BM = 256, BK = 64, HALF = 128, HTB = HALF * BK * 2, NXCD = 8, WGM = 8;
__host__ __device__ __forceinline__ int lds_byte(int r, int c) { const int st = (r >> 4) * 2 + (c >> 5), rr = r & 15, cc = c & 31, ob = rr * 64 + cc * 2; return st * 1024 + (ob ^ (((ob >> 9) & 1) << 5)); }
__host__ __device__ __forceinline__ void stage_rc(int b, int& R, int& C) { const int st = b / 1024, sb = b % 1024, swz = sb ^ (((sb >> 9) & 1) << 5); R = (st >> 1) * 16 + swz / 64; C = (st & 1) * 32 + (swz % 64) / 2; }
__host__ __device__ __forceinline__ int perm32(int rho) { const int n = rho >> 4, i = rho & 15; return 8 * (i >> 2) + 4 * n + (i & 3); }
struct Unit { int pm, pn, e, ts, e2; };
struct Gemm { const bf16* A; const bf16* Bt; int K; size_t bstride; int ldb, bsplit; };
struct StaticOrder {
    int nM, nN, nwg, G, c;
    __device__ void init(int M, int N, int G_, int c_) { nM = M / BM; nN = N / BM; nwg = nM * nN; G = G_; c = c_; }
    __device__ bool next(int i, Unit& u) const {
        const long L = (long)i * G + c; if (L >= nwg) return false;
        int wgid = (int)L; { const int q = nwg / NXCD, r = nwg % NXCD, xcd = wgid % NXCD, off = wgid / NXCD; wgid = (xcd < r ? xcd * (q + 1) : r * (q + 1) + (xcd - r) * q) + off; }
        const int nig = WGM * nN, gid = wgid / nig, fm = gid * WGM, gsz = (nM - fm) < WGM ? (nM - fm) : WGM;
        u.pm = fm + ((wgid % nig) % gsz); u.pn = (wgid % nig) / gsz; u.e = 0; u.ts = 0; u.e2 = 0; return true;
    }
};
struct DenseA { int K; __device__ __forceinline__ unsigned rowoff(const Unit& u, int h, int R) const { return (unsigned)(u.pm * BM + h * HALF + R) * (unsigned)(K * 2); } };
struct GatherA { const LAS unsigned* tab; __device__ __forceinline__ unsigned rowoff(const Unit& u, int h, int R) const { return tab[u.ts * BM + h * HALF + R]; } };

template <class Epi, class Sched, class AMap, bool ALIGN_EPI>
__device__ __forceinline__ void gemm_phase(LAS unsigned char* lds, const Gemm g, const Sched& S, const AMap& AM, const Epi& E) {
    const int tid = threadIdx.x, wid = __builtin_amdgcn_readfirstlane(tid >> 6), lane = tid & 63, wr = wid >> 2, wc = wid & 3, fr = lane & 15, fq = lane >> 4;
    const int K = g.K, nt = K / BK;
    unsigned voffB[2];
#pragma unroll
    for (int i = 0; i < 2; ++i) { int R, C; stage_rc(tid * 16 + i * 8192, R, C); const int Rb = Epi::PERM ? ((R & ~31) + perm32(R & 31)) : R;
        voffB[i] = (unsigned)(Rb * g.ldb + C) * 2u; }
    const size_t kstep = (size_t)(BK * 2);
    const size_t hstep = (size_t)HALF * g.ldb * 2;
    const int bsplit = g.bsplit;
    const size_t tstep = 2 * hstep;
    const unsigned ldsw = (unsigned)wid * 1024u;
    const int aoff = lds_byte(wr * 64 + fr, fq * 8), boff = lds_byte(wc * 32 + fr, fq * 8);
    const char* const Ab = (const char*)g.A;
#define PG8_SA(b, h) (((b) * 2 + (h)) * HTB)
#define PG8_SB(b, h) ((4 + (b) * 2 + (h)) * HTB)
#define PG8_STAGE(bufoff, gbase, voff) do { _Pragma("unroll") for (int _i = 0; _i < 2; ++_i) \
        __builtin_amdgcn_global_load_lds((const unsigned*)((const char*)(gbase) + (voff)[_i]), (LAS unsigned*)(lds + (bufoff) + ldsw + _i * 8192), 16, 0, 0); } while (0)
#define PG8_LDA(dst, b, h) do { _Pragma("unroll") for (int m = 0; m < 4; ++m) _Pragma("unroll") for (int k = 0; k < 2; ++k) dst[m][k] = *(const LAS bf16x8*)(lds + PG8_SA(b, h) + aoff + m * 2048 + k * 1024); } while (0)
#define PG8_LDB(dst, b, h) do { _Pragma("unroll") for (int n = 0; n < 2; ++n) _Pragma("unroll") for (int k = 0; k < 2; ++k) dst[n][k] = *(const LAS bf16x8*)(lds + PG8_SB(b, h) + boff + n * 2048 + k * 1024); } while (0)
#define PG8_MMA(ai, bj, At, Bt) do { __builtin_amdgcn_s_setprio(1); _Pragma("unroll") for (int m = 0; m < 4; ++m) _Pragma("unroll") for (int n = 0; n < 2; ++n) _Pragma("unroll") for (int k = 0; k < 2; ++k) \
        acc[ai][bj][m][n] = __builtin_amdgcn_mfma_f32_16x16x32_bf16(Bt[n][k], At[m][k], acc[ai][bj][m][n], 0, 0, 0); __builtin_amdgcn_s_setprio(0); } while (0)
#define PG8_WAIT_V(n) asm volatile("s_waitcnt vmcnt(" #n ")" ::: "memory")
#define PG8_WAIT_L(n) asm volatile("s_waitcnt lgkmcnt(" #n ")" ::: "memory")
#define PG8_BAR __builtin_amdgcn_s_barrier()
#define PG8_SCHED __builtin_amdgcn_sched_barrier(0)
    Unit cur, nxt; int ui = 0;
    if (!S.next(0, cur)) return;
    f32x4 acc[2][2][4][2];
#pragma unroll
    for (int a = 0; a < 2; ++a)
#pragma unroll
        for (int b = 0; b < 2; ++b)
#pragma unroll
            for (int m = 0; m < 4; ++m)
#pragma unroll
                for (int n = 0; n < 2; ++n) acc[a][b][m][n] = (f32x4){0.f, 0.f, 0.f, 0.f};
    bf16x8 At[4][2], B0[2][2], B1[2][2];
    unsigned ca[2][2];
#pragma unroll
    for (int i = 0; i < 2; ++i) { int R, C; stage_rc(tid * 16 + i * 8192, R, C);
#pragma unroll
        for (int h = 0; h < 2; ++h) ca[h][i] = AM.rowoff(cur, h, R) + (unsigned)C * 2u; }
    const char* cB = (const char*)g.Bt + (size_t)cur.e * g.bstride + (size_t)cur.pn * tstep;
    const char* cB2 = (const char*)g.Bt + (size_t)cur.e2 * g.bstride + (size_t)cur.pn * tstep;
    PG8_STAGE(PG8_SB(0, 0), cB, voffB); PG8_STAGE(PG8_SB(0, 1), cB + hstep, voffB); PG8_STAGE(PG8_SA(0, 0), Ab, ca[0]); PG8_STAGE(PG8_SA(0, 1), Ab, ca[1]);
    if (wr == 1) PG8_BAR;
    PG8_WAIT_V(2); PG8_BAR;
    PG8_STAGE(PG8_SB(1, 0), cB + kstep, voffB); PG8_STAGE(PG8_SA(1, 0), Ab + kstep, ca[0]); PG8_STAGE(PG8_SB(1, 1), cB + hstep + kstep, voffB);
    PG8_WAIT_V(6); PG8_BAR;
    for (;;) {
        const bool has_next = S.next(ui + 1, nxt);
        const char* nB = has_next ? (const char*)g.Bt + (size_t)nxt.e * g.bstride + (size_t)nxt.pn * tstep : cB;
        for (int t = 0; t < nt; t += 2) {
            const bool last = (t == nt - 2);
            unsigned a2[2][2];
#pragma unroll
            for (int h = 0; h < 2; ++h)
#pragma unroll
                for (int i = 0; i < 2; ++i) a2[h][i] = ca[h][i];
            if (last && has_next) {
                int tq = tid; asm volatile("" : "+v"(tq));
#pragma unroll
                for (int i = 0; i < 2; ++i) { int R, C; stage_rc(tq * 16 + i * 8192, R, C);
#pragma unroll
                    for (int h = 0; h < 2; ++h) a2[h][i] = AM.rowoff(nxt, h, R) + (unsigned)C * 2u; }
            }
            const char* a1 = Ab + (size_t)(t + 1) * kstep;
            const char* a2b = last ? Ab : Ab + (size_t)(t + 2) * kstep;
            const char* b2 = last ? nB : ((bsplit > 0 && t + 2 >= bsplit) ? cB2 + (size_t)(t + 2 - bsplit) * kstep : cB + (size_t)(t + 2) * kstep);
            const char* a3b = a2b + kstep; const char* b3 = b2 + kstep;
            PG8_LDB(B0, 0, 0); PG8_LDB(B1, 0, 1); PG8_SCHED; PG8_LDA(At, 0, 0); PG8_STAGE(PG8_SA(1, 1), a1, ca[1]);
            PG8_WAIT_V(8); PG8_WAIT_L(0); PG8_BAR; PG8_MMA(0, 0, At, B0); PG8_MMA(0, 1, At, B1); PG8_BAR; PG8_SCHED;
            PG8_LDA(At, 0, 1); PG8_STAGE(PG8_SB(0, 0), b2, voffB); PG8_STAGE(PG8_SB(0, 1), b2 + hstep, voffB); PG8_STAGE(PG8_SA(0, 0), a2b, a2[0]);
            PG8_WAIT_V(8); PG8_WAIT_L(0); PG8_BAR; PG8_MMA(1, 0, At, B0); PG8_MMA(1, 1, At, B1); PG8_BAR; PG8_SCHED;
            PG8_LDB(B0, 1, 0); PG8_LDB(B1, 1, 1); PG8_SCHED; PG8_LDA(At, 1, 0); PG8_STAGE(PG8_SA(0, 1), a2b, a2[1]);
            PG8_WAIT_V(8); PG8_WAIT_L(0); PG8_BAR; PG8_MMA(0, 0, At, B0); PG8_MMA(0, 1, At, B1); PG8_BAR; PG8_SCHED;
            PG8_LDA(At, 1, 1); PG8_STAGE(PG8_SB(1, 0), b3, voffB); PG8_STAGE(PG8_SB(1, 1), b3 + hstep, voffB); PG8_STAGE(PG8_SA(1, 0), a3b, a2[0]);
            PG8_WAIT_V(8); PG8_WAIT_L(0); PG8_BAR; PG8_MMA(1, 0, At, B0); PG8_MMA(1, 1, At, B1); PG8_BAR; PG8_SCHED;
            if (last) {
#pragma unroll
                for (int h = 0; h < 2; ++h)
#pragma unroll
                    for (int i = 0; i < 2; ++i) ca[h][i] = a2[h][i];
            }
        }
        if constexpr (ALIGN_EPI) { if (wr == 0) PG8_BAR; }
        if constexpr (!Epi::AFTER_DRAIN) { E(acc, cur, wr, wc, fr, fq); }
        if (!has_next) break;
#pragma unroll
        for (int a = 0; a < 2; ++a)
#pragma unroll
            for (int b = 0; b < 2; ++b)
#pragma unroll
                for (int m = 0; m < 4; ++m)
#pragma unroll
                    for (int n = 0; n < 2; ++n) acc[a][b][m][n] = (f32x4){0.f, 0.f, 0.f, 0.f};
        cur = nxt; cB = nB; cB2 = (const char*)g.Bt + (size_t)cur.e2 * g.bstride + (size_t)cur.pn * tstep; ++ui;
        if constexpr (ALIGN_EPI) { if (wr == 1) PG8_BAR; }
    }
    PG8_WAIT_V(0);
    if constexpr (!ALIGN_EPI) { if (wr == 0) PG8_BAR; }
    PG8_BAR;
    if constexpr (Epi::AFTER_DRAIN) { E.fused(acc, cur, wr, wc, fr, fq, lds, wid, lane); }
#undef PG8_SA
#undef PG8_SB
#undef PG8_STAGE
#undef PG8_LDA
#undef PG8_LDB
#undef PG8_MMA
#undef PG8_WAIT_V
#undef PG8_WAIT_L
#undef PG8_BAR
#undef PG8_SCHED
}
}

struct EpiInProjF { static constexpr bool PERM = true, AFTER_DRAIN = false;
    bf16* proj; const LAS float* gains; float* dab;
    __device__ __forceinline__ void operator()(const f32x4 (&acc)[2][2][4][2], const pg8::Unit& u, int wr, int wc, int fr, int fq) const {
        if (u.pn == 14) {
            if (wc == 0) {
#pragma unroll
                for (int ai = 0; ai < 2; ++ai)
#pragma unroll
                    for (int m = 0; m < 4; ++m) { const int row = u.pm * 256 + ai * 128 + wr * 64 + m * 16 + fr;
#pragma unroll
                        for (int n = 0; n < 2; ++n) { f32x4 t = acc[ai][0][m][n];
#pragma unroll
                            for (int i = 0; i < 4; ++i) t[i] += __shfl_xor(t[i], 32);
                            if (fq < 2) *(f32x4*)(dab + (size_t)row * 16 + 8 * fq + 4 * n) = t; } }
            }
            return;
        }
        const int mode = u.pn < 2 ? 0 : (u.pn < 4 ? 1 : 2);
        float one = 1.f; asm volatile("" : "+v"(one));
        f32x4 gv[2][2];
        if (mode < 2) {
#pragma unroll
            for (int bj = 0; bj < 2; ++bj)
#pragma unroll
                for (int n = 0; n < 2; ++n) gv[bj][n] = *(const LAS f32x4*)(gains + mode * 64 + 32 * bj + 8 * fq + 4 * n);
        }
#pragma unroll
        for (int ai = 0; ai < 2; ++ai)
#pragma unroll
            for (int m = 0; m < 4; ++m) {
                const int row = u.pm * 256 + ai * 128 + wr * 64 + m * 16 + fr;
                f32x4 v[2][2];
#pragma unroll
                for (int bj = 0; bj < 2; ++bj)
#pragma unroll
                    for (int n = 0; n < 2; ++n) v[bj][n] = acc[ai][bj][m][n];
                if (mode >= 2) {
#pragma unroll
                    for (int bj = 0; bj < 2; ++bj)
#pragma unroll
                        for (int n = 0; n < 2; ++n) v[bj][n] = v[bj][n] * one;
                }
                if (mode < 2) {
                    float ss = 0.f;
#pragma unroll
                    for (int bj = 0; bj < 2; ++bj)
#pragma unroll
                        for (int n = 0; n < 2; ++n) ss += (v[bj][n][0] * v[bj][n][0] + v[bj][n][1] * v[bj][n][1]) + (v[bj][n][2] * v[bj][n][2] + v[bj][n][3] * v[bj][n][3]);
                    ss += __shfl_xor(ss, 16); ss += __shfl_xor(ss, 32);
                    const float rstd = rsqrtf(ss * (1.f / 64) + EPS);
#pragma unroll
                    for (int bj = 0; bj < 2; ++bj)
#pragma unroll
                        for (int n = 0; n < 2; ++n) v[bj][n] = v[bj][n] * rstd * gv[bj][n];
                }
                bf16* rp = proj + (size_t)row * PC + u.pn * 256 + wc * 64 + 8 * fq;
#pragma unroll
                for (int bj = 0; bj < 2; ++bj) { u32x4 w; w.x = cvt_pk_bf16_asm(v[bj][0][0], v[bj][0][1]); w.y = cvt_pk_bf16_asm(v[bj][0][2], v[bj][0][3]); w.z = cvt_pk_bf16_asm(v[bj][1][0], v[bj][1][1]); w.w = cvt_pk_bf16_asm(v[bj][1][2], v[bj][1][3]);
                    *(u32x4*)(rp + 32 * bj) = w; }
            }
    }
};
struct EpiOutF { static constexpr bool PERM = true, AFTER_DRAIN = false;
    const float* x; float* out; bf16* x2b; float* ssq2;
    __device__ __forceinline__ void operator()(const f32x4 (&acc)[2][2][4][2], const pg8::Unit& u, int wr, int wc, int fr, int fq) const {
#pragma unroll
        for (int ai = 0; ai < 2; ++ai)
#pragma unroll
            for (int m = 0; m < 4; ++m) {
                const int row = u.pm * 256 + ai * 128 + wr * 64 + m * 16 + fr; float ss = 0.f;
#pragma unroll
                for (int bj = 0; bj < 2; ++bj) { const size_t off = (size_t)row * DM + u.pn * 256 + bj * 128 + wc * 32 + 8 * fq;
                    const f32x4 r0 = *(const f32x4*)(x + off) + acc[ai][bj][m][0], r1 = *(const f32x4*)(x + off + 4) + acc[ai][bj][m][1];
                    ss += (r0[0] * r0[0] + r0[1] * r0[1]) + (r0[2] * r0[2] + r0[3] * r0[3]) + (r1[0] * r1[0] + r1[1] * r1[1]) + (r1[2] * r1[2] + r1[3] * r1[3]);
                    u32x4 w; w.x = cvt_pk_bf16_asm(r0[0], r0[1]); w.y = cvt_pk_bf16_asm(r0[2], r0[3]); w.z = cvt_pk_bf16_asm(r1[0], r1[1]); w.w = cvt_pk_bf16_asm(r1[2], r1[3]);
                    *(u32x4*)(x2b + off) = w; }
                ss += __shfl_xor(ss, 16); ss += __shfl_xor(ss, 32);
                if (fq == 0) ssq2[(size_t)(u.pn * 4 + wc) * NT + row] = ss;
            }
    }
};
struct EpiRouterF { static constexpr bool PERM = true, AFTER_DRAIN = true;
    const float* ssq2; const float* bg; const float* be; int* toke; float* tokg; float* rstd2; int* bidx; unsigned* cnt;
    __device__ __forceinline__ void fused(const f32x4 (&acc)[2][2][4][2], const pg8::Unit& u, int wr, int wc, int fr, int fq, LAS unsigned char* lds, int wid, int lane) const {
        LAS float* LG = (LAS float*)lds;
        LAS unsigned* cl = (LAS unsigned*)(lds + 80 * 1024);
        LAS unsigned* clp = cl + 128;
        const int tid = threadIdx.x;
        if (tid < 128) cl[tid] = 0u;
        if (tid < 448) clp[tid] = 0u;
        if (wc == 0) {
#pragma unroll
            for (int ai = 0; ai < 2; ++ai)
#pragma unroll
                for (int m = 0; m < 4; ++m) { const int r = ai * 128 + wr * 64 + m * 16 + fr;
#pragma unroll
                    for (int bj = 0; bj < 2; ++bj)
#pragma unroll
                        for (int n = 0; n < 2; ++n)
#pragma unroll
                            for (int i = 0; i < 4; ++i) LG[r * 73 + 32 * bj + 8 * fq + 4 * n + i] = acc[ai][bj][m][n][i]; }
        } else if (wc == 1 && fq == 0) {
#pragma unroll
            for (int ai = 0; ai < 2; ++ai)
#pragma unroll
                for (int m = 0; m < 4; ++m) { const int r = ai * 128 + wr * 64 + m * 16 + fr;
#pragma unroll
                    for (int n = 0; n < 2; ++n)
#pragma unroll
                        for (int i = 0; i < 4; ++i) LG[r * 73 + 64 + 4 * n + i] = acc[ai][0][m][n][i]; }
        }
        __syncthreads();
        int e0 = 0, e1 = 0, pb = 0, slo = 0; unsigned r0 = 0, r1 = 0, rp = 0; const int tok = u.pm * 256 + tid;
        if (tid < 256) {
            float ss = 0.f;
#pragma unroll
            for (int p = 0; p < 16; ++p) ss += ssq2[(size_t)p * NT + tok];
            const float rstd = rsqrtf(ss * (1.f / DM) + EPS);
            const LAS float* lg = LG + tid * 73;
            float gl[8];
#pragma unroll
            for (int n = 0; n < 8; ++n) gl[n] = lg[64 + n] * rstd + bg[n];
            int gs = 0; float gm = gl[0];
#pragma unroll
            for (int n = 1; n < 8; ++n) if (gl[n] > gm) { gm = gl[n]; gs = n; }
            float den = 0.f;
#pragma unroll
            for (int n = 0; n < 8; ++n) den += __expf(gl[n] - gm);
            const float gp = 1.f / den;
            float el[8];
#pragma unroll
            for (int n = 0; n < 8; ++n) el[n] = lg[gs * 8 + n] * rstd + be[gs * 8 + n];
            int i1 = 0; float v1 = el[0];
#pragma unroll
            for (int n = 1; n < 8; ++n) if (el[n] > v1) { v1 = el[n]; i1 = n; }
            int i2 = 0; float v2 = -3.0e38f;
#pragma unroll
            for (int n = 0; n < 8; ++n) if (n != i1 && el[n] > v2) { v2 = el[n]; i2 = n; }
            const float ex = __expf(v2 - v1), p1 = 1.f / (1.f + ex), p2 = ex * p1;
            e0 = gs * 8 + i1; e1 = gs * 8 + i2;
            tokg[tok * 2] = gp * p1; tokg[tok * 2 + 1] = gp * p2; rstd2[tok] = rstd;
            r0 = __hip_atomic_fetch_add(cl + e0, 1u, __ATOMIC_RELAXED, __HIP_MEMORY_SCOPE_WORKGROUP);
            r1 = __hip_atomic_fetch_add(cl + e1, 1u, __ATOMIC_RELAXED, __HIP_MEMORY_SCOPE_WORKGROUP);
            { const int lo = i1 < i2 ? i1 : i2, hi = i1 < i2 ? i2 : i1; slo = i1 < i2 ? 0 : 1; pb = gs * 28 + (lo * (15 - lo)) / 2 + (hi - lo - 1); }
            rp = __hip_atomic_fetch_add(clp + pb, 1u, __ATOMIC_RELAXED, __HIP_MEMORY_SCOPE_WORKGROUP);
        }
        __syncthreads();
        if (tid < 64) { const unsigned c = cl[tid]; cl[64 + tid] = c ? __hip_atomic_fetch_add(cnt + tid, c, __ATOMIC_RELAXED, __HIP_MEMORY_SCOPE_AGENT) : 0u; }
        else if (tid >= 256 && tid < 256 + 224) { const int q = tid - 256; const unsigned c = clp[q]; clp[224 + q] = c ? __hip_atomic_fetch_add(cnt + (CW_PCNT - CW_CNT) + q, c, __ATOMIC_RELAXED, __HIP_MEMORY_SCOPE_AGENT) : 0u; }
        __syncthreads();
        if (tid < 256) { bidx[(size_t)e0 * 65536 + cl[64 + e0] + r0] = tok; bidx[(size_t)e1 * 65536 + cl[64 + e1] + r1] = tok | (1 << 16);
            toke[tok] = (int)(clp[224 + pb] + rp) | (pb << 16) | (slo << 24); }
    }
};
struct EpiMoe1F { static constexpr bool PERM = true, AFTER_DRAIN = false;
    bf16* hid2; const LAS float* rscale; const LAS unsigned* dest; const LAS float* gate;
    __device__ __forceinline__ void operator()(const f32x4 (&acc)[2][2][4][2], const pg8::Unit& u, int wr, int wc, int fr, int fq) const {
#pragma unroll
        for (int ai = 0; ai < 2; ++ai)
#pragma unroll
            for (int m = 0; m < 4; ++m) { const int r = ai * 128 + wr * 64 + m * 16 + fr; const float rs = rscale[u.ts * 256 + r], gt = gate[u.ts * 256 + r]; const unsigned d = dest[u.ts * 256 + r];
                float h[8];
#pragma unroll
                for (int n = 0; n < 2; ++n)
#pragma unroll
                    for (int i = 0; i < 4; ++i) { const float gv = acc[ai][0][m][n][i] * rs, up = acc[ai][1][m][n][i] * rs; h[4 * n + i] = gv * up * gt * __builtin_amdgcn_rcpf(1.f + __expf(-gv)); }
                u32x4 w; w.x = cvt_pk_bf16_asm(h[0], h[1]); w.y = cvt_pk_bf16_asm(h[2], h[3]); w.z = cvt_pk_bf16_asm(h[4], h[5]); w.w = cvt_pk_bf16_asm(h[6], h[7]);
                if (d != 0xffffffffu) *(u32x4*)((char*)hid2 + d + (unsigned)((u.pn * 128 + wc * 32 + 8 * fq) * 2)) = w;
                __builtin_amdgcn_sched_barrier(0); }
    }
};
struct EpiMoe2F { static constexpr bool PERM = true, AFTER_DRAIN = false;
    const bf16* x2b; float* out; const LAS unsigned* tokp1;
    __device__ __forceinline__ void operator()(const f32x4 (&acc)[2][2][4][2], const pg8::Unit& u, int wr, int wc, int fr, int fq) const {
#pragma unroll
        for (int ai = 0; ai < 2; ++ai) {
            unsigned off0[4]; u32x4 xr[4][2];
#pragma unroll
            for (int m = 0; m < 4; ++m) { const unsigned t1 = tokp1[u.ts * 256 + ai * 128 + wr * 64 + m * 16 + fr];
                off0[m] = t1 ? (t1 - 1u) * (unsigned)DM + (unsigned)(u.pn * 256 + wc * 32 + 8 * fq) : 0xffffffffu;
#pragma unroll
                for (int bj = 0; bj < 2; ++bj) xr[m][bj] = *(const u32x4*)(x2b + (t1 ? off0[m] + bj * 128 : 0u)); }
#pragma unroll
            for (int m = 0; m < 4; ++m) if (off0[m] != 0xffffffffu) {
#pragma unroll
                for (int bj = 0; bj < 2; ++bj) { const unsigned off = off0[m] + bj * 128; const u32x4 x = xr[m][bj];
                    f32x4 o0, o1; o0[0] = __builtin_bit_cast(float, x.x << 16); o0[1] = __builtin_bit_cast(float, x.x & 0xffff0000u); o0[2] = __builtin_bit_cast(float, x.y << 16); o0[3] = __builtin_bit_cast(float, x.y & 0xffff0000u);
                    o1[0] = __builtin_bit_cast(float, x.z << 16); o1[1] = __builtin_bit_cast(float, x.z & 0xffff0000u); o1[2] = __builtin_bit_cast(float, x.w << 16); o1[3] = __builtin_bit_cast(float, x.w & 0xffff0000u);
                    __builtin_nontemporal_store(o0 + acc[ai][bj][m][0], (f32x4*)(out + off)); __builtin_nontemporal_store(o1 + acc[ai][bj][m][1], (f32x4*)(out + off + 4)); } }
            __builtin_amdgcn_sched_barrier(0); }
    }
};
struct MoeSched { const LAS int* tab; int n;
    __device__ __forceinline__ bool next(int i, pg8::Unit& u) const { if (i >= n) return false;
        u.pm = __builtin_amdgcn_readfirstlane(tab[8 * i]); u.pn = __builtin_amdgcn_readfirstlane(tab[8 * i + 1]); u.e = __builtin_amdgcn_readfirstlane(tab[8 * i + 2]); u.ts = __builtin_amdgcn_readfirstlane(tab[8 * i + 3]);
        u.e2 = __builtin_amdgcn_readfirstlane(tab[8 * i + 4]); return true; }
};

struct Args { const float* in[20]; float* out; unsigned char* ws; int ph_lo, ph_hi; };
struct Frame { LAS unsigned char* lds; int tid, lane, wave, vcu, G; unsigned char* ws; };

template <class RowMap>
__device__ __forceinline__ void p0_transpose_item(const float* W, int ldw, int k0, int n0, const float* ksc, bf16* dst, int Kd, const RowMap& rm, LAS float* scr, int lane) {
    const int kr = lane >> 4, nq = lane & 15;
    f32x4 tv[16];
#pragma unroll
    for (int i = 0; i < 16; ++i) tv[i] = *(const f32x4*)(W + (size_t)(k0 + 4 * i + kr) * ldw + n0 + 4 * nq);
    if (ksc) {
#pragma unroll
        for (int i = 0; i < 16; ++i) tv[i] = tv[i] * ksc[k0 + 4 * i + kr]; }
#pragma unroll
    for (int i = 0; i < 16; ++i) { LAS float* d = scr + (4 * i + kr) * 65 + 4 * nq; d[0] = tv[i][0]; d[1] = tv[i][1]; d[2] = tv[i][2]; d[3] = tv[i][3]; }
    LDS_WAIT(); asm volatile("" ::: "memory");
    const int c = lane & 7;
#pragma unroll
    for (int j = 0; j < 8; ++j) { const int n = (lane >> 3) + 8 * j; const LAS float* sp = scr + (8 * c) * 65 + n;
        u32x4 o; o.x = cvt_pk_bf16(sp[0 * 65], sp[1 * 65]); o.y = cvt_pk_bf16(sp[2 * 65], sp[3 * 65]); o.z = cvt_pk_bf16(sp[4 * 65], sp[5 * 65]); o.w = cvt_pk_bf16(sp[6 * 65], sp[7 * 65]);
        *(u32x4*)(dst + (size_t)rm(n0 + n) * Kd + k0 + 8 * c) = o; }
    LDS_WAIT(); asm volatile("" ::: "memory");
}
struct RmIn  { __device__ __forceinline__ int operator()(int n) const { const int pn = n >> 8, lc = n & 255; return pn * 256 + 128 * ((lc >> 5) & 1) + 32 * (lc >> 6) + (lc & 31); } };
struct RmId  { int off; __device__ __forceinline__ int operator()(int n) const { return off + n; } };
struct RmGU  { int e, u; __device__ __forceinline__ int operator()(int n) const { return e * 512 + 256 * (n >> 7) + 128 * u + (n & 127); } };

__device__ __forceinline__ void phase0(const Frame& F, const Args& a) {
    const float* x = a.in[0]; const float* ln1_g = a.in[1]; const float* w_in = a.in[2];
    const float* w_out = a.in[11]; const float* ln2_g = a.in[12]; const float* wg_r = a.in[13]; const float* we_r = a.in[15];
    const float* w_gate = a.in[17]; const float* w_up = a.in[18]; const float* w_down = a.in[19];
    bf16* WinT = (bf16*)(F.ws + WS_WIN); bf16* WoT = (bf16*)(F.ws + WS_WO); bf16* WrT = (bf16*)(F.ws + WS_WR); bf16* WguT = (bf16*)(F.ws + WS_WGU); bf16* WdT = (bf16*)(F.ws + WS_WD);
    bf16* XN = (bf16*)(F.ws + WS_A);
    LAS float* scr = (LAS float*)(F.lds + F.wave * 16640);
    const int gw = F.vcu * NWAVES + F.wave, NGW = F.G * NWAVES;
    constexpr int I_IN = 16 * 56, I_O = 16 * 16, I_G = 64 * 16 * 4, I_D = 64 * 4 * 16, I_R = 512;
    constexpr int NITEMS = I_IN + I_O + 2 * I_G + I_D + I_R;
#ifndef P0_REP_ITEMS
#define P0_REP_ITEMS 1
#endif
#ifndef P0_REP_ROWS
#define P0_REP_ROWS 1
#endif
#ifndef P0_NOITEMS
    for (int rep = 0; rep < P0_REP_ITEMS; ++rep)
    for (int it = gw; it < NITEMS; it += NGW) {
        int r = it;
        if (r < I_IN) { p0_transpose_item(w_in, INC, 64 * (r / 56), 64 * (r % 56), nullptr, WinT, DM, RmIn{}, scr, F.lane); continue; } r -= I_IN;
        if (r < I_O) { p0_transpose_item(w_out, DM, 64 * (r / 16), 64 * (r % 16), nullptr, WoT, DM, RmId{0}, scr, F.lane); continue; } r -= I_O;
        if (r < 2 * I_G) { const int u = r / I_G; r -= u * I_G; const int e = r / 64, q = r % 64;
            p0_transpose_item((u ? w_up : w_gate) + (size_t)e * DM * DE, DE, 64 * (q / 4), 64 * (q % 4), ln2_g, WguT, DM, RmGU{e, u}, scr, F.lane); continue; } r -= 2 * I_G;
        if (r < I_D) { const int e = r / 64, q = r % 64; p0_transpose_item(w_down + (size_t)e * DE * DM, DM, 64 * (q / 16), 64 * (q % 16), nullptr, WdT, DE, RmId{e * DM}, scr, F.lane); continue; } r -= I_D;
        if (r >= 256) {
            r -= 256; unsigned w[8];
#pragma unroll
            for (int j = 0; j < 8; ++j) { float v0 = 0.f, v1 = 0.f; const int k = F.lane * 16 + 2 * j;
                if (r < 32) { v0 = w_in[(size_t)k * INC + PC + (r & 15)]; v1 = w_in[(size_t)(k + 1) * INC + PC + (r & 15)];
                    if (r >= 16) { v0 -= __builtin_bit_cast(float, (unsigned)f2bf(v0) << 16); v1 -= __builtin_bit_cast(float, (unsigned)f2bf(v1) << 16); } }
                w[j] = pk2(v0, v1); }
            u32x4* dp = (u32x4*)(WinT + (size_t)(PC + r) * DM + F.lane * 16);
            dp[0] = (u32x4){w[0], w[1], w[2], w[3]}; dp[1] = (u32x4){w[4], w[5], w[6], w[7]};
            continue; }
        {
            const float* src = nullptr; int ld = 0, col = 0;
            if (r < 32) { src = we_r; ld = 64; col = r; } else if (r >= 128 && r < 160) { src = we_r; ld = 64; col = 32 + (r - 128); } else if (r >= 32 && r < 40) { src = wg_r; ld = 8; col = r - 32; }
            unsigned w[8];
#pragma unroll
            for (int j = 0; j < 8; ++j) { const int k = F.lane * 16 + 2 * j; float v0 = 0.f, v1 = 0.f; if (src) { v0 = src[(size_t)k * ld + col] * ln2_g[k]; v1 = src[(size_t)(k + 1) * ld + col] * ln2_g[k + 1]; } w[j] = pk2(v0, v1); }
            u32x4* dp = (u32x4*)(WrT + (size_t)r * DM + F.lane * 16);
            dp[0] = (u32x4){w[0], w[1], w[2], w[3]}; dp[1] = (u32x4){w[4], w[5], w[6], w[7]};
        }
    }
#endif
#ifndef P0_NOROWS
    {
    const f32x4* gr = (const f32x4*)ln1_g + F.lane;
    f32x4 nx[4], ny[4];
    if (gw < NT) { const f32x4* xr = (const f32x4*)(x + (size_t)gw * DM) + F.lane;
#pragma unroll
        for (int j = 0; j < 4; ++j) nx[j] = xr[64 * j]; }
    if (gw + NGW < NT) { const f32x4* xr = (const f32x4*)(x + (size_t)(gw + NGW) * DM) + F.lane;
#pragma unroll
        for (int j = 0; j < 4; ++j) ny[j] = xr[64 * j]; }
    for (int rep = 0; rep < P0_REP_ROWS; ++rep)
    for (int m = gw; m < NT; m += NGW) {
        f32x4 v[4]; float s = 0.f;
#pragma unroll
        for (int j = 0; j < 4; ++j) { v[j] = nx[j]; s += (v[j].x * v[j].x + v[j].y * v[j].y) + (v[j].z * v[j].z + v[j].w * v[j].w); }
#pragma unroll
        for (int j = 0; j < 4; ++j) nx[j] = ny[j];
        if (m + 2 * NGW < NT) { const f32x4* xr = (const f32x4*)(x + (size_t)(m + 2 * NGW) * DM) + F.lane;
#pragma unroll
            for (int j = 0; j < 4; ++j) ny[j] = xr[64 * j]; }
        const float rstd = rsqrtf(wave_sum(s) * (1.f / DM) + EPS);
        unsigned long long* o8 = (unsigned long long*)(XN + (size_t)m * DM) + F.lane;
#pragma unroll
        for (int j = 0; j < 4; ++j) { v[j] = v[j] * rstd * gr[64 * j];
            o8[64 * j] = (unsigned long long)cvt_pk_bf16(v[j].x, v[j].y) | ((unsigned long long)cvt_pk_bf16(v[j].z, v[j].w) << 32); }
    }
    }
#endif
}

constexpr int TB_PRE = 0  , TB_UT = 512  , TB_PT = 1024  , TB_T = 2048  ;
__device__ __forceinline__ void moe_prefixes(const Frame& F) {
    const unsigned* cnt = (const unsigned*)(F.ws + WS_CTL) + CW_CNT; const unsigned* pcnt = (const unsigned*)(F.ws + WS_CTL) + CW_PCNT;
    LAS int* pre = (LAS int*)(F.lds + TAB_OFF + TB_PRE); LAS int* pt = (LAS int*)(F.lds + TAB_OFF + TB_PT);
    if (F.tid < 64) pre[F.tid] = (int)((__hip_atomic_load(cnt + F.tid, RLX_AGENT) + 255u) >> 8);
    else if (F.tid >= 128 && F.tid < 128 + 224) pt[F.tid - 128] = (int)((__hip_atomic_load(pcnt + (F.tid - 128), RLX_AGENT) + 255u) >> 8);
    __syncthreads();
    if (F.tid == 0) { int s = 0; for (int e = 0; e < 64; ++e) { const int t = pre[e]; pre[e] = s; s += t; } pre[64] = s; }
    if (F.tid == 64) { int s = 0; for (int q = 0; q < 224; ++q) { const int t = pt[q]; pt[q] = s; s += t; } pt[224] = s; }
    __syncthreads();
}
__device__ __forceinline__ int moe_setup1(const Frame& F) {
    const unsigned* cnt = (const unsigned*)(F.ws + WS_CTL) + CW_CNT;
    LAS int* pre = (LAS int*)(F.lds + TAB_OFF + TB_PRE); LAS int* pt = (LAS int*)(F.lds + TAB_OFF + TB_PT); LAS int* ut = (LAS int*)(F.lds + TAB_OFF + TB_UT);
    LAS unsigned* t0 = (LAS unsigned*)(F.lds + TAB_OFF + TB_T); LAS float* t1 = (LAS float*)(t0 + 6 * 256); LAS unsigned* t2 = t0 + 12 * 256; LAS float* t3 = (LAS float*)(t0 + 18 * 256);
    const int* bidx = (const int*)(F.ws + WS_BIDX); const float* rstd2 = (const float*)(F.ws + WS_RSTD2); const float* tokg = (const float*)(F.ws + WS_TOKG); const int* tokp = (const int*)(F.ws + WS_TOKP);
    unsigned* r2t = (unsigned*)(F.ws + WS_R2T);
    moe_prefixes(F);
    for (int tok = F.vcu * NTHR + F.tid; tok < NT; tok += F.G * NTHR) { const int tp = tokp[tok]; r2t[256 * pt[(tp >> 16) & 0xff] + (tp & 0xffff)] = (unsigned)tok + 1u; }
    const int total = pre[64] * 2;
    int n = 0; for (int i = 0; i < 6; ++i) if ((long)i * F.G + F.vcu < total) n = i + 1;
    if (F.tid < n) { const int L = F.tid * F.G + F.vcu; const int rtg = L >> 1, pn = L & 1; int e = 0; for (int q = 0; q < 64; ++q) if (pre[q + 1] <= rtg) e = q + 1;
        ut[8 * F.tid] = rtg; ut[8 * F.tid + 1] = pn; ut[8 * F.tid + 2] = e; ut[8 * F.tid + 3] = F.tid; ut[8 * F.tid + 4] = e; }
    __syncthreads();
    { int ts3[3]; bool val3[3]; int tp3[3]; float rs3[3], g3[3];
#pragma unroll
      for (int k = 0; k < 3; ++k) { const int x = F.tid + NTHR * k; ts3[k] = 0; val3[k] = false;
          if (x < n * 256) { const int i = x >> 8, r = x & 255, rtg = ut[8 * i], e = ut[8 * i + 2]; const int idx = (rtg - pre[e]) * 256 + r; const int c = (int)__hip_atomic_load(cnt + e, RLX_AGENT);
              val3[k] = idx < c; ts3[k] = bidx[(size_t)e * 65536 + (val3[k] ? idx : 0)]; } }
#pragma unroll
      for (int k = 0; k < 3; ++k) { const int tok = ts3[k] & 0xffff, slot = ts3[k] >> 16; tp3[k] = tokp[tok]; rs3[k] = rstd2[tok]; g3[k] = tokg[tok * 2 + slot]; }
#pragma unroll
      for (int k = 0; k < 3; ++k) { const int x = F.tid + NTHR * k;
          if (x < n * 256) { const int tok = ts3[k] & 0xffff, slot = ts3[k] >> 16, tp = tp3[k];
              t0[x] = (unsigned)tok * (unsigned)(DM * 2); t1[x] = val3[k] ? rs3[k] : 0.f;
              t2[x] = val3[k] ? (unsigned)(256 * pt[(tp >> 16) & 0xff] + (tp & 0xffff)) * 1024u + (slot == ((tp >> 24) & 1) ? 0u : 512u) : 0xffffffffu;
              t3[x] = g3[k]; } } }
    __syncthreads();
    return n;
}
__device__ __forceinline__ int moe_setup2(const Frame& F) {
    LAS int* pt = (LAS int*)(F.lds + TAB_OFF + TB_PT); LAS int* ut = (LAS int*)(F.lds + TAB_OFF + TB_UT); LAS unsigned* t0 = (LAS unsigned*)(F.lds + TAB_OFF + TB_T);
    const unsigned* r2t = (const unsigned*)(F.ws + WS_R2T);
    moe_prefixes(F);
    const int total = pt[224] * 4;
    int n = 0; for (int i = 0; i < 8; ++i) if ((long)i * F.G + F.vcu < total) n = i + 1;
    if (F.tid < n) { const int L = F.tid * F.G + F.vcu; const int rtg = L >> 2, pn = L & 3; int pb = 0; for (int q = 0; q < 224; ++q) if (pt[q + 1] <= rtg) pb = q + 1;
        const int gs = pb / 28, pi = pb - 28 * gs; int lo = 0; for (int l = 0; l < 7; ++l) if (pi >= (l * (15 - l)) / 2) lo = l; const int hi = lo + 1 + pi - (lo * (15 - lo)) / 2;
        ut[8 * F.tid] = rtg; ut[8 * F.tid + 1] = pn; ut[8 * F.tid + 2] = gs * 8 + lo; ut[8 * F.tid + 3] = F.tid; ut[8 * F.tid + 4] = gs * 8 + hi; }
    __syncthreads();
    { unsigned v4[4];
#pragma unroll
      for (int k = 0; k < 4; ++k) { const int x = F.tid + NTHR * k; v4[k] = 0u; if (x < n * 256) v4[k] = r2t[(size_t)ut[8 * (x >> 8)] * 256 + (x & 255)]; }
#pragma unroll
      for (int k = 0; k < 4; ++k) { const int x = F.tid + NTHR * k; if (x < n * 256) t0[x] = v4[k]; } }
    __syncthreads();
    return n;
}

typedef short v4i16_t __attribute__((ext_vector_type(4)));
constexpr int NA_SLOT = 16384, NA_NSLOT = 9, NA_MRG = NA_NSLOT * NA_SLOT, NA_MRGL = NA_MRG + 8192, NA_BT = NA_MRGL + 1024;
__device__ __forceinline__ int na_swz(int key) { return ((key >> 1) & 3) << 1; }
__device__ __forceinline__ void na_stage_row(const Frame& F, const bf16* pbh, int bandrow) {
    const int key = 8 * F.wave + (F.lane >> 3), c = (F.lane & 7) ^ na_swz(key);
    const bf16* src = pbh + (size_t)(bandrow * GW + key) * PC + c * 8;
    LAS unsigned char* dst = F.lds + (bandrow % NA_NSLOT) * NA_SLOT + F.wave * 1024;
    __builtin_amdgcn_global_load_lds((const unsigned*)(src + C_AK), (LAS unsigned*)dst, 16, 0, 0);
    __builtin_amdgcn_global_load_lds((const unsigned*)(src + C_AV), (LAS unsigned*)(dst + 8192), 16, 0, 0);
}
__device__ __forceinline__ void phase_na(const Frame& F, const Args& a) {
    const bf16* PROJ = (const bf16*)(F.ws + WS_PROJ); bf16* MIX = (bf16*)(F.ws + WS_MIX); const float* rpb = a.in[5];
    const int j = F.wave & 3, bh = F.wave >> 2, g = F.lane >> 4, li = F.lane & 15, c = 16 * j + li;
    const int ks0 = j == 0 ? 0 : (j == 1 ? 8 : (j == 2 ? 24 : 32));
    int c0 = c - KW / 2; c0 = c0 < 0 ? 0 : (c0 > GW - KW ? GW - KW : c0);
    LAS float* bt = (LAS float*)(F.lds + NA_BT);
    for (int unit = F.vcu; unit < BATCH * AH * 2; unit += F.G) {
        const int b = unit >> 4, h = (unit >> 1) & 7, rs = (unit & 1) * 32;
        const bf16* pbh = PROJ + (size_t)b * SEQ * PC + h * ADH;
        float mq = fabsf(a.in[3][F.lane]), mk = fabsf(a.in[4][F.lane]);
#pragma unroll
        for (int o = 1; o < 64; o <<= 1) { mq = fmaxf(mq, __shfl_xor(mq, o)); mk = fmaxf(mk, __shfl_xor(mk, o)); }
        float mb = 0.f; for (int i = F.lane; i < 15 * 31; i += 64) mb = fmaxf(mb, fabsf(rpb[h * 465 + i]));
#pragma unroll
        for (int o = 1; o < 64; o <<= 1) mb = fmaxf(mb, __shfl_xor(mb, o));
        const float cshift = 64.f * 0.125f * LOG2E * mq * mk + mb * LOG2E;
        __syncthreads();
        for (int i = F.tid; i < 15 * 31; i += NTHR) bt[i] = rpb[h * 465 + i] * LOG2E - cshift;
        int r0 = rs - KH / 2; r0 = r0 < 0 ? 0 : (r0 > ROWS - KH ? ROWS - KH : r0);
        for (int i = 0; i < KH; ++i) na_stage_row(F, pbh, r0 + i);
        VM_WAIT(); __syncthreads();
        const int pkey = 8 * F.wave + (F.lane >> 3), pch = (F.lane & 7) ^ na_swz(pkey);
        auto r0_of = [](int r) { int v = r - KH / 2; return v < 0 ? 0 : (v > ROWS - KH ? ROWS - KH : v); };
        u32x4 pk = {0u, 0u, 0u, 0u}, pv = {0u, 0u, 0u, 0u};
        if (rs + 1 < rs + 32 && r0_of(rs + 1) != r0_of(rs)) { const bf16* src = pbh + (size_t)((r0_of(rs + 1) + KH - 1) * GW + pkey) * PC + pch * 8; pk = *(const u32x4*)(src + C_AK); pv = *(const u32x4*)(src + C_AV); }
        float bias[8][4]; int prev_ro = -100;
        bf16x8 qn[2];
#pragma unroll
        for (int ks = 0; ks < 2; ++ks) qn[ks] = *(const bf16x8*)(PROJ + ((size_t)b * SEQ + rs * GW + c) * PC + C_AQ + h * ADH + 32 * ks + 8 * g);
        for (int r = rs; r < rs + 32; ++r) {
            r0 = r - KH / 2; r0 = r0 < 0 ? 0 : (r0 > ROWS - KH ? ROWS - KH : r0);
            if (r + 1 < rs + 32 && r0_of(r + 1) != r0) { LAS unsigned char* dst = F.lds + ((r0_of(r + 1) + KH - 1) % NA_NSLOT) * NA_SLOT + F.wave * 1024 + F.lane * 16;
                *(LAS u32x4*)dst = pk; *(LAS u32x4*)(dst + 8192) = pv; }
            if (r + 2 < rs + 32 && r0_of(r + 2) != r0_of(r + 1)) { const bf16* src = pbh + (size_t)((r0_of(r + 2) + KH - 1) * GW + pkey) * PC + pch * 8; pk = *(const u32x4*)(src + C_AK); pv = *(const u32x4*)(src + C_AV); }
            const int ro = r0 - r + (KH - 1) + 4 * bh;
            if (ro != prev_ro) { prev_ro = ro;
#pragma unroll
                for (int i4 = 0; i4 < 4; ++i4)
#pragma unroll
                    for (int t = 0; t < 2; ++t)
#pragma unroll
                        for (int q = 0; q < 4; ++q) { const int kc = ks0 + 16 * t + 4 * g + q; const bool valid = kc >= c0 && kc < c0 + KW;
                            bias[i4 * 2 + t][q] = valid ? bt[(ro + i4) * 31 + (kc - c + KW - 1)] : -1.0e30f; } }
            const size_t qtok = (size_t)b * SEQ + r * GW + c;
            bf16x8 qf[2]; qf[0] = qn[0]; qf[1] = qn[1];
            { const size_t ntok = qtok + (r + 1 < rs + 32 ? GW : 0);
#pragma unroll
              for (int ks = 0; ks < 2; ++ks) qn[ks] = *(const bf16x8*)(PROJ + ntok * PC + C_AQ + h * ADH + 32 * ks + 8 * g); }
            f32x4 sacc[8];
#pragma unroll
            for (int i4 = 0; i4 < 4; ++i4) { const LAS unsigned char* ks_ = F.lds + ((r0 + 4 * bh + i4) % NA_NSLOT) * NA_SLOT;
#pragma unroll
                for (int t = 0; t < 2; ++t) { const int row = ks0 + 16 * t + li; f32x4 acc = {bias[i4 * 2 + t][0], bias[i4 * 2 + t][1], bias[i4 * 2 + t][2], bias[i4 * 2 + t][3]};
#pragma unroll
                    for (int ks = 0; ks < 2; ++ks) { const bf16x8 kf = *(const LAS bf16x8*)(ks_ + row * 128 + (((g + 4 * ks) ^ na_swz(row)) << 4));
                        acc = __builtin_amdgcn_mfma_f32_16x16x32_bf16(kf, qf[ks], acc, 0, 0, 0); }
                    sacc[i4 * 2 + t] = acc; } }
            f32x2_t ls2 = {0.f, 0.f};
#pragma unroll
            for (int x = 0; x < 8; ++x) {
#pragma unroll
                for (int q = 0; q < 4; ++q) sacc[x][q] = __builtin_amdgcn_exp2f(sacc[x][q]);
                ls2 += (f32x2_t){sacc[x][0], sacc[x][1]}; ls2 += (f32x2_t){sacc[x][2], sacc[x][3]}; }
            float lsum = ls2[0] + ls2[1];
            f32x4 oacc[4];
#pragma unroll
            for (int dt = 0; dt < 4; ++dt) oacc[dt] = (f32x4){0.f, 0.f, 0.f, 0.f};
#pragma unroll
            for (int m = 0; m < 4; ++m) {
                const int xa = 2 * m, xb = 2 * m + 1;
                bf16x8 pf; { const unsigned w0 = cvt_pk_bf16(sacc[xa][0], sacc[xa][1]), w1 = cvt_pk_bf16(sacc[xa][2], sacc[xa][3]), w2 = cvt_pk_bf16(sacc[xb][0], sacc[xb][1]), w3 = cvt_pk_bf16(sacc[xb][2], sacc[xb][3]);
                    pf = __builtin_bit_cast(bf16x8, (u32x4){w0, w1, w2, w3}); }
                const LAS unsigned char* va = F.lds + ((r0 + 4 * bh + m) % NA_NSLOT) * NA_SLOT + 8192; const LAS unsigned char* vb = va;
                const int rowa = ks0 + 4 * g + (li >> 2), rowb = ks0 + 16 + 4 * g + (li >> 2);
#pragma unroll
                for (int dt = 0; dt < 4; ++dt) { const int cc = 2 * dt + ((li & 3) >> 1), hb = (li & 1) * 8;
                    const v4i16_t ta = __builtin_amdgcn_ds_read_tr16_b64_v4i16((LAS v4i16_t*)(va + rowa * 128 + ((cc ^ na_swz(rowa)) << 4) + hb));
                    const v4i16_t tb = __builtin_amdgcn_ds_read_tr16_b64_v4i16((LAS v4i16_t*)(vb + rowb * 128 + ((cc ^ na_swz(rowb)) << 4) + hb));
                    bf16x8 vf; vf[0] = ta[0]; vf[1] = ta[1]; vf[2] = ta[2]; vf[3] = ta[3]; vf[4] = tb[0]; vf[5] = tb[1]; vf[6] = tb[2]; vf[7] = tb[3];
                    oacc[dt] = __builtin_amdgcn_mfma_f32_16x16x32_bf16(vf, pf, oacc[dt], 0, 0, 0); }
            }
            LAS unsigned char* mrg = F.lds + NA_MRG + (j * 64 + F.lane) * 32; LAS float* mrl = (LAS float*)(F.lds + NA_MRGL) + j * 64 + F.lane;
            if (bh == 1) {
                u32x4 w0, w1; w0.x = cvt_pk_bf16(oacc[0][0], oacc[0][1]); w0.y = cvt_pk_bf16(oacc[0][2], oacc[0][3]); w0.z = cvt_pk_bf16(oacc[1][0], oacc[1][1]); w0.w = cvt_pk_bf16(oacc[1][2], oacc[1][3]);
                w1.x = cvt_pk_bf16(oacc[2][0], oacc[2][1]); w1.y = cvt_pk_bf16(oacc[2][2], oacc[2][3]); w1.z = cvt_pk_bf16(oacc[3][0], oacc[3][1]); w1.w = cvt_pk_bf16(oacc[3][2], oacc[3][3]);
                *(LAS u32x4*)mrg = w0; *(LAS u32x4*)(mrg + 16) = w1; *mrl = lsum;
            }
            LDS_BAR();
            if (bh == 0) {
                const u32x4 w0 = *(const LAS u32x4*)mrg, w1 = *(const LAS u32x4*)(mrg + 16); lsum += *mrl;
                lsum += __shfl_xor(lsum, 16); lsum += __shfl_xor(lsum, 32);
                const float inv = 1.f / lsum;
                bf16* op = MIX + qtok * DM + h * ADH + 4 * g;
#pragma unroll
                for (int dt = 0; dt < 4; ++dt) { const unsigned pa = dt < 2 ? (dt == 0 ? w0.x : w0.z) : (dt == 2 ? w1.x : w1.z), pb = dt < 2 ? (dt == 0 ? w0.y : w0.w) : (dt == 2 ? w1.y : w1.w);
                    const float o0 = (oacc[dt][0] + __builtin_bit_cast(float, pa << 16)) * inv, o1 = (oacc[dt][1] + __builtin_bit_cast(float, pa & 0xffff0000u)) * inv;
                    const float o2 = (oacc[dt][2] + __builtin_bit_cast(float, pb << 16)) * inv, o3 = (oacc[dt][3] + __builtin_bit_cast(float, pb & 0xffff0000u)) * inv;
                    *(unsigned long long*)(op + 16 * dt) = (unsigned long long)cvt_pk_bf16(o0, o1) | ((unsigned long long)cvt_pk_bf16(o2, o3) << 32); }
            }
            LDS_BAR();
        }
    }
}


typedef float f32x16 __attribute__((ext_vector_type(16)));
constexpr size_t WS_GCL = WS_G, WS_BETAL = WS_BETA;
constexpr int P3_QN = 0, P3_KN = 16384, P3_LF = 32768, P3_LB = P3_LF + 17408, P3_TF = P3_LB + 17408, P3_TB = P3_TF + 17408, P3_CW = P3_TB + 17408, P3_SC = P3_CW + 7680, P3_RAW = P3_SC + 1024, LST = 68;
__device__ __forceinline__ unsigned off_b(unsigned row, unsigned ch) { return 256u * row + 16u * (ch ^ (((row & 3) << 2) | ((row >> 2) & 3))); }
__device__ __forceinline__ unsigned rowread_b(unsigned lane, unsigned rowbase, unsigned s) { return off_b(rowbase + (lane & 31), 2 * s + (lane >> 5)); }
__device__ __forceinline__ void dn_inverse(LAS float* LS, LAS float* TS, int lane) {
    for (int i = lane; i < 64 * LST / 4; i += 64) ((LAS f32x4*)TS)[i] = (f32x4){0.f, 0.f, 0.f, 0.f};
    { const int blk = lane >> 4, col = lane & 15; float xa[16];
#pragma unroll
      for (int i = 0; i < 16; ++i) xa[i] = (i == col) ? 1.f : 0.f;
#pragma unroll
      for (int k = 0; k < 16; ++k) { const float xk = xa[k]; TS[(16 * blk + k) * LST + 16 * blk + col] = xk;
#pragma unroll
          for (int i = k + 1; i < 16; ++i) xa[i] -= LS[(16 * blk + i) * LST + 16 * blk + k] * xk; } }
    __builtin_amdgcn_sched_barrier(0);
#pragma unroll
    for (int p = 0; p < 2; ++p) { const int base = 32 * p, r = lane & 15, kq = lane >> 4;
        float a1[4], b1[4];
#pragma unroll
        for (int s4 = 0; s4 < 4; ++s4) { a1[s4] = LS[(base + 16 + r) * LST + base + kq + 4 * s4]; b1[s4] = TS[(base + kq + 4 * s4) * LST + base + r]; }
        const f32x4 a2 = *(const LAS f32x4*)(TS + (base + 16 + r) * LST + base + 16 + 4 * kq);
        __builtin_amdgcn_sched_barrier(0);
        f32x4 M = {0.f, 0.f, 0.f, 0.f};
#pragma unroll
        for (int s4 = 0; s4 < 4; ++s4) M = __builtin_amdgcn_mfma_f32_16x16x4f32(a1[s4], b1[s4], M, 0, 0, 0);
        f32x4 R = {0.f, 0.f, 0.f, 0.f};
#pragma unroll
        for (int s4 = 0; s4 < 4; ++s4) R = __builtin_amdgcn_mfma_f32_16x16x4f32(a2[s4], M[s4], R, 0, 0, 0);
#pragma unroll
        for (int e = 0; e < 4; ++e) TS[(base + 16 + 4 * kq + e) * LST + base + r] = -R[e]; }
    __builtin_amdgcn_sched_barrier(0);
    { const int r = lane & 31, kh = lane >> 5;
      bf16x8 a1[2], b1[2], a2[2];
#pragma unroll
      for (int sx = 0; sx < 2; ++sx) {
          const f32x4 l0 = *(const LAS f32x4*)(LS + (32 + r) * LST + 16 * sx + 8 * kh), l1 = *(const LAS f32x4*)(LS + (32 + r) * LST + 16 * sx + 8 * kh + 4);
          a1[sx] = __builtin_bit_cast(bf16x8, (u32x4){cvt_pk_bf16(l0[0], l0[1]), cvt_pk_bf16(l0[2], l0[3]), cvt_pk_bf16(l1[0], l1[1]), cvt_pk_bf16(l1[2], l1[3])});
          float tb[8];
#pragma unroll
          for (int j = 0; j < 8; ++j) tb[j] = TS[(16 * sx + 8 * kh + j) * LST + r];
          b1[sx] = __builtin_bit_cast(bf16x8, (u32x4){cvt_pk_bf16(tb[0], tb[1]), cvt_pk_bf16(tb[2], tb[3]), cvt_pk_bf16(tb[4], tb[5]), cvt_pk_bf16(tb[6], tb[7])});
          const f32x4 t0 = *(const LAS f32x4*)(TS + (32 + r) * LST + 32 + 16 * sx + 4 * kh), t1 = *(const LAS f32x4*)(TS + (32 + r) * LST + 32 + 16 * sx + 8 + 4 * kh);
          a2[sx] = __builtin_bit_cast(bf16x8, (u32x4){cvt_pk_bf16(t0[0], t0[1]), cvt_pk_bf16(t0[2], t0[3]), cvt_pk_bf16(t1[0], t1[1]), cvt_pk_bf16(t1[2], t1[3])}); }
      __builtin_amdgcn_sched_barrier(0);
      f32x16 M;
#pragma unroll
      for (int e = 0; e < 16; ++e) M[e] = 0.f;
#pragma unroll
      for (int sx = 0; sx < 2; ++sx) M = __builtin_amdgcn_mfma_f32_32x32x16_bf16(a1[sx], b1[sx], M, 0, 0, 0);
      f32x16 R;
#pragma unroll
      for (int e = 0; e < 16; ++e) R[e] = 0.f;
#pragma unroll
      for (int sx = 0; sx < 2; ++sx) { const bf16x8 mb = __builtin_bit_cast(bf16x8, (u32x4){cvt_pk_bf16(M[8 * sx], M[8 * sx + 1]), cvt_pk_bf16(M[8 * sx + 2], M[8 * sx + 3]), cvt_pk_bf16(M[8 * sx + 4], M[8 * sx + 5]), cvt_pk_bf16(M[8 * sx + 6], M[8 * sx + 7])});
          R = __builtin_amdgcn_mfma_f32_32x32x16_bf16(a2[sx], mb, R, 0, 0, 0); }
#pragma unroll
      for (int e = 0; e < 16; ++e) TS[(32 + (e & 3) + 8 * (e >> 2) + 4 * kh) * LST + r] = -R[e]; }
}
__device__ __forceinline__ void phase_dnprep(const Frame& F, const Args& a) {
    const bf16* PROJ = (const bf16*)(F.ws + WS_PROJ); bf16* QKVN = (bf16*)a.out; bf16* TQK = (bf16*)(F.ws + WS_TQK);
    const float* DABp = (const float*)(F.ws + WS_DAB); const float* a_log = a.in[8]; const float* dt_bias = a.in[9]; float* GCL = (float*)(F.ws + WS_GCL); float* BETAL = (float*)(F.ws + WS_BETAL);
    const float* conv_w = a.in[7];
    LAS float* CW = (LAS float*)(F.lds + P3_CW); LAS float* SC = (LAS float*)(F.lds + P3_SC);
    LAS float* LFp = (LAS float*)(F.lds + P3_LF); LAS float* LBp = (LAS float*)(F.lds + P3_LB); LAS float* TFp = (LAS float*)(F.lds + P3_TF); LAS float* TBp = (LAS float*)(F.lds + P3_TB);
    const int hh = F.lane >> 5;
    static_assert(P3_RAW + 68 * 768 <= LDSCTL_OFF, "P3 LDS map");
    const bf16* zsrc = (const bf16*)(F.ws + WS_CTL + 900 * 1024);
    auto stage_raw = [&](int un) { const int tc_ = un & 63, h_ = (un >> 6) & 3, b_ = un >> 8, t0_ = tc_ * 64;
        for (int p = F.wave; p < 51; p += 8) { const int c = 64 * p + F.lane, row = c / 48, cc = c - 48 * row, tt = t0_ - 2 + row;
            const bf16* src = (tt >= 0 && tt < SEQ) ? PROJ + ((size_t)b_ * SEQ + tt) * PC + C_DQ + (cc >> 4) * 512 + h_ * 128 + (cc & 15) * 8 : zsrc;
            __builtin_amdgcn_global_load_lds((const unsigned*)src, (LAS unsigned*)(F.lds + P3_RAW + p * 1024), 16, 0, 0); } };
    const int unit0 = F.vcu * 16, unit_end = (unit0 + 16 < BATCH * DH * 64) ? unit0 + 16 : BATCH * DH * 64;
    if (unit0 >= unit_end) return;
    { const int h = (unit0 >> 6) & 3;
      for (int i = F.tid; i < 3 * 5 * 128; i += NTHR) { const int part = i / 640, tap = (i / 128) % 5, ch = i & 127; CW[i] = conv_w[tap * 1536 + part * 512 + h * 128 + ch]; } }
    stage_raw(unit0);
    float* GCR = (float*)(F.ws + WS_GCR); float* EDLp = (float*)(F.ws + WS_EDL);
    { float pa[4], pb[4];
#pragma unroll
      for (int q4 = 0; q4 < 4; ++q4) { const int q = F.wave + 8 * q4, un = unit0 + (q >> 1), dir = q & 1, tl = dir ? 63 - F.lane : F.lane; pa[q4] = 0.f; pb[q4] = 0.f;
          if (un < unit_end) { const float* dp = DABp + ((size_t)(un >> 8) * SEQ + (un & 63) * 64 + tl) * 16 + dir * 4 + ((un >> 6) & 3); pa[q4] = dp[0]; pb[q4] = dp[8]; } }
#pragma unroll
      for (int q4 = 0; q4 < 4; ++q4) { const int q = F.wave + 8 * q4, un = unit0 + (q >> 1), dir = q & 1, h_ = (un >> 6) & 3, b_ = un >> 8, t0_ = (un & 63) * 64; const size_t go = (((size_t)dir * BATCH + b_) * DH + h_) * SEQ + t0_ + F.lane;
          float gv = -__expf(a_log[dir * 4 + h_]) * softplus_f(pa[q4] + dt_bias[dir * 4 + h_]); const float bv = sigmoid_f(pb[q4]);
#pragma unroll
          for (int o = 1; o < 64; o <<= 1) { const float t = __shfl_up(gv, o); if (F.lane >= o) gv += t; }
          const float glv = __builtin_bit_cast(float, __builtin_amdgcn_readlane(__builtin_bit_cast(int, gv), 63));
          if (un < unit_end) { GCR[go] = gv; GCL[go] = __expf(gv); EDLp[go] = __expf(glv - gv); BETAL[go] = bv; } }
      VM_WAIT(); __syncthreads(); }
    for (int unit = unit0; unit < unit_end; ++unit) {
        const int tc = unit & 63, h = (unit >> 6) & 3, b = unit >> 8, t0 = tc * 64; const size_t tokb = (size_t)b * SEQ + t0;
        if (unit == unit0) VM_WAIT(); else asm volatile("s_waitcnt vmcnt(10)" ::: "memory");
        LDS_BAR();
        if (F.wave == 2) { const size_t gf = (((size_t)b) * DH + h) * SEQ + t0 + F.lane, gb = (((size_t)BATCH + b) * DH + h) * SEQ + t0 + F.lane;
            __builtin_amdgcn_global_load_lds((const unsigned*)(GCR + gf), (LAS unsigned*)(F.lds + P3_SC), 4, 0, 0); __builtin_amdgcn_global_load_lds((const unsigned*)(GCR + gb), (LAS unsigned*)(F.lds + P3_SC + 256), 4, 0, 0);
            __builtin_amdgcn_global_load_lds((const unsigned*)(BETAL + gf), (LAS unsigned*)(F.lds + P3_SC + 512), 4, 0, 0); __builtin_amdgcn_global_load_lds((const unsigned*)(BETAL + gb), (LAS unsigned*)(F.lds + P3_SC + 768), 4, 0, 0);
            asm volatile("" ::: "memory"); }
        { const int tl2 = F.lane >> 4, cg = F.lane & 15, tk = 8 * F.wave + 2 * tl2;
#ifndef P3_REP_CONV
#define P3_REP_CONV 1
#endif
          u32x4 rawall[3][6];
#pragma unroll
          for (int part = 0; part < 3; ++part)
#pragma unroll
              for (int rr = 0; rr < 6; ++rr) rawall[part][rr] = *(const LAS u32x4*)(F.lds + P3_RAW + (tk + rr) * 768 + part * 256 + cg * 16);
          LDS_BAR();
          if (unit + 1 < unit_end) stage_raw(unit + 1);
          asm volatile("" ::: "memory");
#pragma unroll
          for (int part = 0; part < 3; ++part) {
              u32x4 rawp[6];
#pragma unroll
              for (int rr = 0; rr < 6; ++rr) rawp[rr] = rawall[part][rr];
              float o[2][8];
#pragma unroll
              for (int e2 = 0; e2 < 4; ++e2) {
                  float lo[6], hi[6];
#pragma unroll
                  for (int rr = 0; rr < 6; ++rr) { lo[rr] = __builtin_bit_cast(float, rawp[rr][e2] << 16); hi[rr] = __builtin_bit_cast(float, rawp[rr][e2] & 0xffff0000u); }
                  float a0 = 0.f, a1 = 0.f, b0 = 0.f, b1 = 0.f;
#pragma unroll
                  for (int tap = 0; tap < 5; ++tap) { const f32x2_t w01 = *(const LAS f32x2_t*)(CW + (part * 5 + tap) * 128 + 8 * cg + 2 * e2); const float w0 = w01[0], w1 = w01[1];
                      a0 += lo[tap] * w0; a1 += hi[tap] * w1; b0 += lo[tap + 1] * w0; b1 += hi[tap + 1] * w1; }
                  o[0][2 * e2] = a0; o[0][2 * e2 + 1] = a1; o[1][2 * e2] = b0; o[1][2 * e2 + 1] = b1;
                  __builtin_amdgcn_sched_barrier(0); }
#pragma unroll
              for (int u = 0; u < 2; ++u) { float ss = 0.f;
#pragma unroll
                  for (int e = 0; e < 8; ++e) { const float x = o[u][e]; const float y = x * __builtin_amdgcn_rcpf(1.f + __expf(-x)); o[u][e] = y; ss += y * y; }
                  if (part < 2) { ss = row16_sum(ss);
                      const float sc = rsqrtf(ss + EPS) * (part == 0 ? 0.08838834764831845f : 1.f);
#pragma unroll
                      for (int e = 0; e < 8; ++e) o[u][e] *= sc; }
                  u32x4 w; w.x = cvt_pk_bf16(o[u][0], o[u][1]); w.y = cvt_pk_bf16(o[u][2], o[u][3]); w.z = cvt_pk_bf16(o[u][4], o[u][5]); w.w = cvt_pk_bf16(o[u][6], o[u][7]);
                  *(u32x4*)(QKVN + ((size_t)((b * 4 + h) * 3 + part) * SEQ + t0 + tk + u) * 128 + 8 * cg) = w;
                  if (part < 2) *(LAS u32x4*)(F.lds + (part == 0 ? P3_QN : P3_KN) + off_b(tk + u, cg)) = w; }
              __builtin_amdgcn_sched_barrier(0);
          } }
        LDS_BAR();
        { const int mat = F.wave >> 2, ti = (F.wave >> 1) & 1, tj = F.wave & 1;
          f32x16 acc;
#pragma unroll
          for (int e = 0; e < 16; ++e) acc[e] = 0.f;
#pragma unroll
          for (int s8 = 0; s8 < 8; ++s8) { const bf16x8 af = *(const LAS bf16x8*)(F.lds + (mat ? P3_QN : P3_KN) + rowread_b(F.lane, 32 * ti, s8)), bfr = *(const LAS bf16x8*)(F.lds + P3_KN + rowread_b(F.lane, 32 * tj, s8));
              acc = __builtin_amdgcn_mfma_f32_32x32x16_bf16(af, bfr, acc, 0, 0, 0); }
          LAS float* dstp = (mat ? TBp : TFp) + 32 * tj + (F.lane & 31);
#pragma unroll
          for (int e = 0; e < 16; ++e) dstp[(32 * ti + (e & 3) + 8 * (e >> 2) + 4 * hh) * LST] = acc[e]; }
        if (F.wave == 2) { if (unit + 1 < unit_end) asm volatile("s_waitcnt vmcnt(13)" ::: "memory"); else asm volatile("s_waitcnt vmcnt(6)" ::: "memory"); }
        LDS_BAR();
        { const int i = F.tid >> 3, c8 = F.tid & 7, ir = 63 - i;
          const float gfi = SC[i], gbi = SC[64 + ir], bfi = SC[128 + i], bbi = SC[192 + ir];
          const f32x4 g0 = *(const LAS f32x4*)(TFp + i * LST + 8 * c8), g1 = *(const LAS f32x4*)(TFp + i * LST + 8 * c8 + 4), p0 = *(const LAS f32x4*)(TBp + i * LST + 8 * c8), p1 = *(const LAS f32x4*)(TBp + i * LST + 8 * c8 + 4);
          const f32x4 cf0 = *(const LAS f32x4*)(SC + 8 * c8), cf1 = *(const LAS f32x4*)(SC + 8 * c8 + 4), cb0 = *(const LAS f32x4*)(SC + 120 - 8 * c8), cb1 = *(const LAS f32x4*)(SC + 124 - 8 * c8);
          float lf[8], lb[8], qf[8], qb[8];
#pragma unroll
          for (int e = 0; e < 8; ++e) { const int j = 8 * c8 + e; const float gv = e < 4 ? g0[e] : g1[e - 4], pv = e < 4 ? p0[e] : p1[e - 4];
              const float df = __expf(gfi - (e < 4 ? cf0[e] : cf1[e - 4])), db = __expf(gbi - (e < 4 ? cb1[3 - e] : cb0[7 - e]));
              lf[e] = i > j ? bfi * gv * df : 0.f; lb[7 - e] = i < j ? bbi * gv * db : 0.f; qf[e] = i >= j ? pv * df : 0.f; qb[7 - e] = i <= j ? pv * db : 0.f; }
          *(LAS f32x4*)(LFp + i * LST + 8 * c8) = (f32x4){lf[0], lf[1], lf[2], lf[3]}; *(LAS f32x4*)(LFp + i * LST + 8 * c8 + 4) = (f32x4){lf[4], lf[5], lf[6], lf[7]};
          *(LAS f32x4*)(LBp + ir * LST + 56 - 8 * c8) = (f32x4){lb[0], lb[1], lb[2], lb[3]}; *(LAS f32x4*)(LBp + ir * LST + 60 - 8 * c8) = (f32x4){lb[4], lb[5], lb[6], lb[7]};
          u32x4 wf, wb; wf.x = cvt_pk_bf16(qf[0], qf[1]); wf.y = cvt_pk_bf16(qf[2], qf[3]); wf.z = cvt_pk_bf16(qf[4], qf[5]); wf.w = cvt_pk_bf16(qf[6], qf[7]);
          wb.x = cvt_pk_bf16(qb[0], qb[1]); wb.y = cvt_pk_bf16(qb[2], qb[3]); wb.z = cvt_pk_bf16(qb[4], qb[5]); wb.w = cvt_pk_bf16(qb[6], qb[7]);
          *(u32x4*)(TQK + ((size_t)unit * 4 + 1) * 4096 + i * 64 + 8 * c8) = wf; *(u32x4*)(TQK + ((size_t)unit * 4 + 3) * 4096 + ir * 64 + 56 - 8 * c8) = wb; }
        LDS_BAR();
#ifndef P3_REP_INV
#define P3_REP_INV 1
#endif
        for (int rep = 0; rep < P3_REP_INV; ++rep) if (F.wave < 2) dn_inverse(F.wave ? LBp : LFp, F.wave ? TBp : TFp, F.lane);
        LDS_BAR();
        for (int it = F.tid; it < 1024; it += NTHR) { const int m = it >> 9, i = (it >> 3) & 63, c8 = it & 7; const LAS float* tp = (m ? TBp : TFp) + i * LST + 8 * c8;
            const f32x4 x0 = *(const LAS f32x4*)tp, x1 = *(const LAS f32x4*)(tp + 4);
            u32x4 w; w.x = cvt_pk_bf16(x0[0], x0[1]); w.y = cvt_pk_bf16(x0[2], x0[3]); w.z = cvt_pk_bf16(x1[0], x1[1]); w.w = cvt_pk_bf16(x1[2], x1[3]);
            *(u32x4*)(TQK + ((size_t)unit * 4 + 2 * m) * 4096 + i * 64 + 8 * c8) = w;
            }
    }
}
constexpr int P4_BUF = 57344, P4_KN = 0, P4_QN = 16384, P4_VN = 32768, P4_T = 40960, P4_QK = 49152, P4_ST = 114688, P4_RT = 131072, P4_VNT = 139264, P4_VDT = 147456, P4_SC = 155648;
__device__ __forceinline__ unsigned off_s(unsigned row, unsigned ch) { return 128u * row + (((ch ^ ((row >> 1) & 7u))) << 4); }
__device__ __forceinline__ unsigned rowread_s(unsigned lane, unsigned rowbase, unsigned s) { return off_s(rowbase + (lane & 31), 2 * s + (lane >> 5)); }
__device__ __forceinline__ void p4_stage(const Frame& F, const bf16* QKVN, const bf16* TQK, const float* GCL, const float* BETAL, int b, int h, int dir, int dvh, int n, int buf) {
    const int tc = dir ? 63 - n : n, t0 = tc * 64; const size_t tokb = (size_t)t0, pl0 = (size_t)((b * 4 + h) * 3) * SEQ; const size_t u3 = (size_t)((b * 4 + h) * 64 + tc);
    LAS unsigned char* B = F.lds + buf * P4_BUF; const int L = F.lane, w = F.wave;
    {
#pragma unroll
      for (int k = 0; k < 2; ++k) { const int q = w + 8 * k, row = 4 * q + (L >> 4), pos = L & 15, ch = pos ^ (((row & 3) << 2) | ((row >> 2) & 3)); const size_t tok = tokb + (dir ? 63 - row : row);
          __builtin_amdgcn_global_load_lds((const unsigned*)(QKVN + (pl0 + SEQ + tok) * 128 + ch * 8), (LAS unsigned*)(B + P4_KN + q * 1024), 16, 0, 0);
          __builtin_amdgcn_global_load_lds((const unsigned*)(QKVN + (pl0 + tok) * 128 + ch * 8), (LAS unsigned*)(B + P4_QN + q * 1024), 16, 0, 0); } }
    { const int row = 8 * w + (L >> 3), pos = L & 7, chs = pos ^ ((row >> 1) & 7); const size_t tok = tokb + (dir ? 63 - row : row);
      __builtin_amdgcn_global_load_lds((const unsigned*)(QKVN + (pl0 + 2 * SEQ + tok) * 128 + dvh * 64 + pos * 8), (LAS unsigned*)(B + P4_VN + w * 1024), 16, 0, 0);
      __builtin_amdgcn_global_load_lds((const unsigned*)(TQK + (u3 * 4 + 2 * dir) * 4096 + row * 64 + chs * 8), (LAS unsigned*)(B + P4_T + w * 1024), 16, 0, 0);
      __builtin_amdgcn_global_load_lds((const unsigned*)(TQK + (u3 * 4 + 2 * dir + 1) * 4096 + row * 64 + chs * 8), (LAS unsigned*)(B + P4_QK + w * 1024), 16, 0, 0); }
    if (w == 0) { const size_t go = (((size_t)dir * BATCH + b) * DH + h) * SEQ + t0; LAS unsigned char* sc = F.lds + P4_SC + buf * 1024;
        __builtin_amdgcn_global_load_lds((const unsigned*)(GCL + go + L), (LAS unsigned*)sc, 4, 0, 0); __builtin_amdgcn_global_load_lds((const unsigned*)(BETAL + go + L), (LAS unsigned*)(sc + 256), 4, 0, 0);
        __builtin_amdgcn_global_load_lds((const unsigned*)((const float*)(F.ws + WS_EDL) + go + L), (LAS unsigned*)(sc + 512), 4, 0, 0); }
}
__device__ __forceinline__ void phase_dnscan(const Frame& F, const Args& a) {
    const bf16* QKVN = (const bf16*)a.out; const bf16* TQK = (const bf16*)(F.ws + WS_TQK); const float* GCL = (const float*)(F.ws + WS_GCL); const float* BETAL = (const float*)(F.ws + WS_BETAL);
    bf16* O = (bf16*)(F.ws + WS_A);
    const int w = F.wave, L = F.lane, hh = L >> 5, l31 = L & 31;
    const int mat = w >> 2, ti = (w >> 1) & 1, tj = w & 1, kt = w >> 1, nt = w & 1;
    for (int unit = F.vcu; unit < BATCH * DH * 4; unit += F.G) {
        const int dvh = unit & 1, dir = (unit >> 1) & 1, h = (unit >> 2) & 3, b = unit >> 4;
        __syncthreads();
        for (int i = F.tid; i < 16384 / 16; i += NTHR) ((LAS u32x4*)(F.lds + P4_ST))[i] = (u32x4){0u, 0u, 0u, 0u};
        p4_stage(F, QKVN, TQK, GCL, BETAL, b, h, dir, dvh, 0, 0);
        f32x16 sacc;
#pragma unroll
        for (int e = 0; e < 16; ++e) sacc[e] = 0.f;
        VM_WAIT(); __syncthreads();
        f32x16 accO; bf16x8 oqk[4], ovn[4];
#pragma unroll
        for (int e = 0; e < 16; ++e) accO[e] = 0.f;
#pragma unroll
        for (int s4 = 0; s4 < 4; ++s4) { oqk[s4] = (bf16x8){0, 0, 0, 0, 0, 0, 0, 0}; ovn[s4] = (bf16x8){0, 0, 0, 0, 0, 0, 0, 0}; }
        auto finish_o = [&](int nprev) {
#pragma unroll
            for (int s4 = 0; s4 < 4; ++s4) accO = __builtin_amdgcn_mfma_f32_32x32x16_bf16(oqk[s4], ovn[s4], accO, 0, 0, 0);
            unsigned dwv = DW, i0v = 32 * ti + 4 * hh; asm volatile("" : "+v"(dwv), "+v"(i0v));
            const int tc = dir ? 63 - nprev : nprev; bf16* op = O + ((size_t)dir * NT + (size_t)b * SEQ + tc * 64) * DW + h * 128 + dvh * 64 + 32 * tj + l31;
#pragma unroll
            for (int e = 0; e < 16; ++e) { const int i = (int)i0v + (e & 3) + 8 * (e >> 2); op[(unsigned)(dir ? 63 - i : i) * dwv] = f2bf(accO[e]); } };
        for (int n = 0; n < 64; ++n) {
            const int cb = n & 1; const LAS unsigned char* B = F.lds + cb * P4_BUF; const LAS float* sc = (const LAS float*)(F.lds + P4_SC + cb * 1024);
            if (n + 1 < 64) p4_stage(F, QKVN, TQK, GCL, BETAL, b, h, dir, dvh, n + 1, cb ^ 1);
            f32x16 acc1;
#pragma unroll
            for (int e = 0; e < 16; ++e) acc1[e] = 0.f;
#pragma unroll
            for (int hb = 0; hb < 2; ++hb) { bf16x8 fa[4], fb[4];
#pragma unroll
              for (int s4 = 0; s4 < 4; ++s4) { const int s8 = 4 * hb + s4; fa[s4] = *(const LAS bf16x8*)(B + (mat ? P4_QN : P4_KN) + rowread_b(L, 32 * ti, s8)); fb[s4] = *(const LAS bf16x8*)(F.lds + P4_ST + rowread_b(L, 32 * tj, s8)); }
              __builtin_amdgcn_sched_barrier(0);
#pragma unroll
              for (int s4 = 0; s4 < 4; ++s4) acc1 = __builtin_amdgcn_mfma_f32_32x32x16_bf16(fa[s4], fb[s4], acc1, 0, 0, 0);
              __builtin_amdgcn_sched_barrier(0); }
            const int ncol = 32 * tj + l31;
            if (mat == 0) {
                bf16 vraw[16];
#pragma unroll
                for (int e = 0; e < 16; ++e) vraw[e] = *(const LAS bf16*)(B + P4_VN + (32 * ti + 8 * (e >> 2) + 4 * hh + (e & 3)) * 128 + ncol * 2);
                __builtin_amdgcn_sched_barrier(0);
#pragma unroll
                for (int rg = 0; rg < 4; ++rg) { float r4[4];
#pragma unroll
                    for (int q = 0; q < 4; ++q) { const int i = 32 * ti + 8 * rg + 4 * hh + q; const float vv = bf2f(vraw[4 * rg + q]);
                        r4[q] = sc[64 + i] * (vv - sc[i] * acc1[4 * rg + q]); }
                    *(LAS unsigned long long*)(F.lds + P4_RT + off_s(ncol, 4 * ti + rg) + 8 * hh) = (unsigned long long)cvt_pk_bf16(r4[0], r4[1]) | ((unsigned long long)cvt_pk_bf16(r4[2], r4[3]) << 32); }
            } else {
#pragma unroll
                for (int e = 0; e < 16; ++e) { const int i = 32 * ti + (e & 3) + 8 * (e >> 2) + 4 * hh; acc1[e] *= sc[i]; }
            }
            LDS_BAR();
            if (mat == 0) {
                f32x16 va;
#pragma unroll
                for (int e = 0; e < 16; ++e) va[e] = 0.f;
                { bf16x8 fa[4], fb[4];
#pragma unroll
                  for (int s4 = 0; s4 < 4; ++s4) { fa[s4] = *(const LAS bf16x8*)(B + P4_T + rowread_s(L, 32 * ti, s4)); fb[s4] = *(const LAS bf16x8*)(F.lds + P4_RT + rowread_s(L, 32 * tj, s4)); }
                  __builtin_amdgcn_sched_barrier(0);
#pragma unroll
                  for (int s4 = 0; s4 < 4; ++s4) va = __builtin_amdgcn_mfma_f32_32x32x16_bf16(fa[s4], fb[s4], va, 0, 0, 0); }
#pragma unroll
                for (int rg = 0; rg < 4; ++rg) { float d4[4];
#pragma unroll
                    for (int q = 0; q < 4; ++q) d4[q] = va[4 * rg + q] * sc[128 + 32 * ti + 8 * rg + 4 * hh + q];
                    const unsigned o8 = off_s(ncol, 4 * ti + rg) + 8 * hh;
                    *(LAS unsigned long long*)(F.lds + P4_VNT + o8) = (unsigned long long)cvt_pk_bf16(va[4 * rg], va[4 * rg + 1]) | ((unsigned long long)cvt_pk_bf16(va[4 * rg + 2], va[4 * rg + 3]) << 32);
                    *(LAS unsigned long long*)(F.lds + P4_VDT + o8) = (unsigned long long)cvt_pk_bf16(d4[0], d4[1]) | ((unsigned long long)cvt_pk_bf16(d4[2], d4[3]) << 32); }
            } else if (n > 0) finish_o(n - 1);
            LDS_BAR();
            if (mat == 1) {
#pragma unroll
                for (int s4 = 0; s4 < 4; ++s4) { oqk[s4] = *(const LAS bf16x8*)(B + P4_QK + rowread_s(L, 32 * ti, s4)); ovn[s4] = *(const LAS bf16x8*)(F.lds + P4_VNT + rowread_s(L, 32 * tj, s4)); }
                accO = acc1;
            }
            { const float egl = sc[63];
#pragma unroll
              for (int e = 0; e < 16; ++e) sacc[e] *= egl;
              const unsigned blk = (L >> 4) & 1, q4 = (L & 15) >> 2, p4 = L & 3;
              bf16x8 fv[4];
#pragma unroll
              for (int s4 = 0; s4 < 4; ++s4) fv[s4] = *(const LAS bf16x8*)(F.lds + P4_VDT + rowread_s(L, 32 * nt, s4));
              v4i16_t tv[8];
              { const unsigned kb = (unsigned)(size_t)(B + P4_KN), a0 = kb + off_b(8 * hh + q4, 4 * kt + 2 * blk + (p4 >> 1)) + 8 * (p4 & 1), a1 = kb + off_b(8 * hh + 4 + q4, 4 * kt + 2 * blk + (p4 >> 1)) + 8 * (p4 & 1);
                asm volatile("ds_read_b64_tr_b16 %0, %8\n\tds_read_b64_tr_b16 %1, %9\n\tds_read_b64_tr_b16 %2, %8 offset:4096\n\tds_read_b64_tr_b16 %3, %9 offset:4096\n\t"
                             "ds_read_b64_tr_b16 %4, %8 offset:8192\n\tds_read_b64_tr_b16 %5, %9 offset:8192\n\tds_read_b64_tr_b16 %6, %8 offset:12288\n\tds_read_b64_tr_b16 %7, %9 offset:12288\n\ts_waitcnt lgkmcnt(0)"
                             : "=&v"(tv[0]), "=&v"(tv[1]), "=&v"(tv[2]), "=&v"(tv[3]), "=&v"(tv[4]), "=&v"(tv[5]), "=&v"(tv[6]), "=&v"(tv[7]) : "v"(a0), "v"(a1) : "memory"); }
#pragma unroll
              for (int s4 = 0; s4 < 4; ++s4) { const v4i16_t t0v = tv[2 * s4], t1v = tv[2 * s4 + 1];
                  bf16x8 af; af[0] = t0v[0]; af[1] = t0v[1]; af[2] = t0v[2]; af[3] = t0v[3]; af[4] = t1v[0]; af[5] = t1v[1]; af[6] = t1v[2]; af[7] = t1v[3];
                  sacc = __builtin_amdgcn_mfma_f32_32x32x16_bf16(af, fv[s4], sacc, 0, 0, 0); }
              const int nn = 32 * nt + l31;
#pragma unroll
              for (int rg = 0; rg < 4; ++rg)
                  *(LAS unsigned long long*)(F.lds + P4_ST + off_b(nn, 4 * kt + rg) + 8 * hh) = (unsigned long long)cvt_pk_bf16(sacc[4 * rg], sacc[4 * rg + 1]) | ((unsigned long long)cvt_pk_bf16(sacc[4 * rg + 2], sacc[4 * rg + 3]) << 32);
            }
            if (mat == 1 && n > 0) asm volatile("s_waitcnt vmcnt(16)" ::: "memory"); else VM_WAIT();
            LDS_BAR();
        }
        if (mat == 1) finish_o(63);
        VM_WAIT();
    }
}
__device__ __forceinline__ void phase_post(const Frame& F, const Args& a) {
    bf16* MIX = (bf16*)(F.ws + WS_MIX); const bf16* O = (const bf16*)(F.ws + WS_A); const bf16* PROJ = (const bf16*)(F.ws + WS_PROJ); const float* ag = a.in[6]; const float* dg = a.in[10];
    const int gw = F.vcu * NWAVES + F.wave, NGW = F.G * NWAVES, lane = F.lane;
    const f32x4 g0 = *(const f32x4*)(ag + lane * 8), g1 = *(const f32x4*)(ag + lane * 8 + 4);
    const f32x4 d0 = *(const f32x4*)(dg + (lane & 15) * 8), d1 = *(const f32x4*)(dg + (lane & 15) * 8 + 4);
    u32x4 nav, nof, nob, nzv;
    if (gw < NT) { nav = *(const u32x4*)(MIX + (size_t)gw * DM + lane * 8); nof = *(const u32x4*)(O + (size_t)gw * DW + lane * 8); nob = *(const u32x4*)(O + ((size_t)NT + gw) * DW + lane * 8); nzv = *(const u32x4*)(PROJ + (size_t)gw * PC + C_DZ + lane * 8); }
    for (int tok = gw; tok < NT; tok += NGW) {
        bf16* mp = MIX + (size_t)tok * DM;
        const u32x4 av = nav, of = nof, ob = nob, zv = nzv;
        { const int tn = tok + NGW < NT ? tok + NGW : tok;
          nav = *(const u32x4*)(MIX + (size_t)tn * DM + lane * 8); nof = *(const u32x4*)(O + (size_t)tn * DW + lane * 8); nob = *(const u32x4*)(O + ((size_t)NT + tn) * DW + lane * 8); nzv = *(const u32x4*)(PROJ + (size_t)tn * PC + C_DZ + lane * 8); }
        float x[8]; float ss = 0.f;
#pragma unroll
        for (int e = 0; e < 4; ++e) { x[2 * e] = __builtin_bit_cast(float, av[e] << 16); x[2 * e + 1] = __builtin_bit_cast(float, av[e] & 0xffff0000u); ss += x[2 * e] * x[2 * e] + x[2 * e + 1] * x[2 * e + 1]; }
        const float rstd = rsqrtf(wave_sum(ss) * (1.f / 512) + EPS);
        u32x4 w; w.x = cvt_pk_bf16(x[0] * rstd * g0[0], x[1] * rstd * g0[1]); w.y = cvt_pk_bf16(x[2] * rstd * g0[2], x[3] * rstd * g0[3]); w.z = cvt_pk_bf16(x[4] * rstd * g1[0], x[5] * rstd * g1[1]); w.w = cvt_pk_bf16(x[6] * rstd * g1[2], x[7] * rstd * g1[3]);
        *(u32x4*)(mp + lane * 8) = w;
        float o[8], z[8]; float s2 = 0.f;
#pragma unroll
        for (int e = 0; e < 4; ++e) { o[2 * e] = __builtin_bit_cast(float, of[e] << 16) + __builtin_bit_cast(float, ob[e] << 16); o[2 * e + 1] = __builtin_bit_cast(float, of[e] & 0xffff0000u) + __builtin_bit_cast(float, ob[e] & 0xffff0000u);
            z[2 * e] = __builtin_bit_cast(float, zv[e] << 16); z[2 * e + 1] = __builtin_bit_cast(float, zv[e] & 0xffff0000u); s2 += o[2 * e] * o[2 * e] + o[2 * e + 1] * o[2 * e + 1]; }
        s2 = row16_sum(s2);
        const float r2 = rsqrtf(s2 * (1.f / 128) + EPS);
        float y[8];
#pragma unroll
        for (int e = 0; e < 8; ++e) y[e] = o[e] * r2 * (e < 4 ? d0[e] : d1[e - 4]) * z[e] * __builtin_amdgcn_rcpf(1.f + __expf(-z[e]));
        u32x4 w2; w2.x = cvt_pk_bf16(y[0], y[1]); w2.y = cvt_pk_bf16(y[2], y[3]); w2.z = cvt_pk_bf16(y[4], y[5]); w2.w = cvt_pk_bf16(y[6], y[7]);
        *(u32x4*)(mp + 512 + lane * 8) = w2;
    }
}

__global__ void __launch_bounds__(NTHR, 2) fwd(Args args) {
    extern __shared__ __attribute__((aligned(16))) unsigned char lds_raw[];
    Frame F; F.lds = (LAS unsigned char*)lds_raw; F.tid = threadIdx.x; F.lane = F.tid & 63; F.wave = __builtin_amdgcn_readfirstlane(F.tid >> 6);
    F.G = gridDim.x; { const int bx = blockIdx.x; F.vcu = (F.G % 8 == 0) ? (bx % 8) * (F.G / 8) + bx / 8 : bx; } F.ws = args.ws;
    gu32* ctl = (gu32*)(F.ws + WS_CTL);
    for (int u = F.tid; u < 128; u += NTHR) ((LAS unsigned*)(F.lds + LDSCTL_OFF))[u] = 0u;
    __syncthreads();
    const int lo = args.ph_lo, hi = args.ph_hi;
    XcdBarrier bar; bar.bar = (unsigned*)ctl + CW_BAR; bar.x = 0; bar.st = nullptr;
    if (hi - lo > 1) bar = xcd_barrier_post((unsigned*)ctl + CW_BAR, (volatile LAS unsigned*)(F.lds + MISC_OFF));
#ifndef PH_MASK
#define PH_MASK 0xffff
#endif
#define IN(k) (((PH_MASK >> (k)) & 1) && lo <= (k) && (k) < hi)
#define SEAM(k) do { if (IN(k) && IN((k) + 1)) xcd_barrier(bar); } while (0)
#ifndef ALIGN1
#define ALIGN1 false
#endif
#ifndef ALIGN6
#define ALIGN6 true
#endif
#ifndef ALIGN8
#define ALIGN8 true
#endif
#ifndef ALIGN9
#define ALIGN9 true
#endif
#ifndef DBL_MASK
#define DBL_MASK 0
#endif
#define DBL(k) (((DBL_MASK >> (k)) & 1) != 0)
    bf16* XN = (bf16*)(F.ws + WS_A); bf16* X2B = (bf16*)(F.ws + WS_A); bf16* PROJ = (bf16*)(F.ws + WS_PROJ); bf16* MIX = (bf16*)(F.ws + WS_MIX);
    bf16* HID = (bf16*)(F.ws + WS_HID); bf16* Y = (bf16*)(F.ws + WS_Y); float* SSQ2 = (float*)(F.ws + WS_SSQ2);
    if (IN(0)) { phase0(F, args); if (DBL(0)) { xcd_barrier(bar); phase0(F, args); } } SEAM(0);
    if (IN(1)) {
        LAS float* gains = (LAS float*)(F.lds + TAB_OFF);
        if (F.tid < 64) gains[F.tid] = args.in[3][F.tid] * (0.125f * LOG2E); else if (F.tid < 128) gains[F.tid] = args.in[4][F.tid - 64];
        __syncthreads();
        pg8::Gemm g{XN, (const bf16*)(F.ws + WS_WIN), DM, 0, DM, 0}; pg8::StaticOrder S; S.init(NT, PC + 256, F.G, (int)blockIdx.x);
        pg8::gemm_phase<EpiInProjF, pg8::StaticOrder, pg8::DenseA, ALIGN1>(F.lds, g, S, pg8::DenseA{DM}, EpiInProjF{PROJ, gains, (float*)(F.ws + WS_DAB)});
    } SEAM(1);
    if (IN(2)) { phase_na(F, args); if (DBL(2)) { xcd_barrier(bar); phase_na(F, args); } }
    __syncthreads();
    if (IN(3)) { phase_dnprep(F, args); if (DBL(3)) { xcd_barrier(bar); phase_dnprep(F, args); } } SEAM(3);
    if (IN(4)) { phase_dnscan(F, args); if (DBL(4)) { xcd_barrier(bar); phase_dnscan(F, args); } } SEAM(4);
    if (IN(5)) { phase_post(F, args); } SEAM(5);
    if (IN(6)) {
        pg8::Gemm g{MIX, (const bf16*)(F.ws + WS_WO), DM, 0, DM, 0}; pg8::StaticOrder S; S.init(NT, DM, F.G, (int)blockIdx.x);
        pg8::gemm_phase<EpiOutF, pg8::StaticOrder, pg8::DenseA, ALIGN6>(F.lds, g, S, pg8::DenseA{DM}, EpiOutF{args.in[0], args.out, X2B, SSQ2});
    } SEAM(6);
    if (IN(7)) {
        pg8::Gemm g{X2B, (const bf16*)(F.ws + WS_WR), DM, 0, DM, 0}; pg8::StaticOrder S; S.init(NT, 256, F.G, (int)blockIdx.x);
        EpiRouterF E{SSQ2, args.in[14], args.in[16], (int*)(F.ws + WS_TOKE), (float*)(F.ws + WS_TOKG), (float*)(F.ws + WS_RSTD2), (int*)(F.ws + WS_BIDX), (unsigned*)ctl + CW_CNT};
        pg8::gemm_phase<EpiRouterF, pg8::StaticOrder, pg8::DenseA, false>(F.lds, g, S, pg8::DenseA{DM}, E);
    } SEAM(7);
    if (IN(8)) {
        const int n = moe_setup1(F);
        pg8::Gemm g{X2B, (const bf16*)(F.ws + WS_WGU), DM, (size_t)512 * DM * 2, DM, 0};
        MoeSched S{(const LAS int*)(F.lds + TAB_OFF + TB_UT), n};
        const LAS unsigned* t0 = (const LAS unsigned*)(F.lds + TAB_OFF + TB_T);
        pg8::gemm_phase<EpiMoe1F, MoeSched, pg8::GatherA, ALIGN8>(F.lds, g, S, pg8::GatherA{t0}, EpiMoe1F{HID, (const LAS float*)(t0 + 6 * 256), t0 + 12 * 256, (const LAS float*)(t0 + 18 * 256)});
    } SEAM(8);
    if (IN(9)) {
        const int n = moe_setup2(F);
        pg8::Gemm g{HID, (const bf16*)(F.ws + WS_WD), 2 * DE, (size_t)DM * DE * 2, DE, 4};
        MoeSched S{(const LAS int*)(F.lds + TAB_OFF + TB_UT), n};
        pg8::gemm_phase<EpiMoe2F, MoeSched, pg8::DenseA, ALIGN9>(F.lds, g, S, pg8::DenseA{2 * DE}, EpiMoe2F{X2B, args.out, (const LAS unsigned*)(F.lds + TAB_OFF + TB_T)});
    }
#undef IN
#undef SEAM
}


extern "C" void kernel_launch(void* const* d_in, const int* in_sizes, int n_in, void* d_out, int out_size, void* d_ws, size_t ws_size, hipStream_t stream) {
    static int grid = 0;
    if (grid == 0) {
        if (n_in != 20 || in_sizes[0] != NT * DM || out_size != NT * DM || ws_size < WS_END2) { fprintf(stderr, "kernel_launch: unexpected n_in %d / sizes / ws_size %zu (need %zu)\n", n_in, ws_size, (size_t)WS_END2); grid = -1; return; }
        int dev = 0, cus = 0, per_cu = 0;
        if (hipGetDevice(&dev) != hipSuccess || hipDeviceGetAttribute(&cus, hipDeviceAttributeMultiprocessorCount, dev) != hipSuccess) { grid = -1; return; }
        if (hipFuncSetAttribute((const void*)fwd, hipFuncAttributeMaxDynamicSharedMemorySize, LDS_BYTES) != hipSuccess) { fprintf(stderr, "kernel_launch: hipFuncSetAttribute failed\n"); grid = -1; return; }
        if (hipOccupancyMaxActiveBlocksPerMultiprocessor(&per_cu, (const void*)fwd, NTHR, LDS_BYTES) != hipSuccess || per_cu < 1) fprintf(stderr, "kernel_launch: occupancy query says %d\n", per_cu);
        (void)hipGetLastError();
        grid = cus;
    }
    if (grid < 0) return;
    (void)hipMemsetAsync((unsigned char*)d_ws + WS_CTL, 0, 1 * MiB, stream);
    Args a{}; for (int i = 0; i < 20; ++i) a.in[i] = (const float*)d_in[i]; a.out = (float*)d_out; a.ws = (unsigned char*)d_ws;
#define FWD(lo_, hi_) do { a.ph_lo = (lo_); a.ph_hi = (hi_); hipLaunchKernelGGL(fwd, dim3(grid), dim3(NTHR), LDS_BYTES, stream, a); } while (0)
#if defined(PROBE_EXTRA)
    for (int k = 0; k < 10; ++k) { FWD(k, k + 1); if (k == PROBE_EXTRA) FWD(k, k + 1); }
#else
    FWD(0, 10);
#endif
}
```

```cpp
#include <hip/hip_runtime.h>
#include <cstdio>
#include <cstdint>

typedef unsigned short bf16;
typedef unsigned u32x4 __attribute__((ext_vector_type(4)));
typedef float f32x4 __attribute__((ext_vector_type(4)));

constexpr int BATCH = 16, SEQ = 4096, DM = 1024, NT = BATCH * SEQ;
constexpr int GW = 64, ROWS = SEQ / GW, KH = 8, KW = 16;
constexpr int AH = 8, ADH = 64, AW = 512;
constexpr int DH = 4, DHD = 128, DW = 512, DCONV = 5, DCHUNK = 64;
constexpr int INC = 3600, PC = 3584;
constexpr int NG = 8, EPG = 8, NE = 64, DE = 256;
constexpr float EPS = 1e-6f;
constexpr float LOG2E = 1.4426950408889634f;
constexpr int C_AQ = 0, C_AK = 512, C_AV = 1024, C_DQ = 1536, C_DK = 2048, C_DV = 2560, C_DZ = 3072;

constexpr size_t MiB = 1ull << 20;
constexpr size_t WS_CTL   = 0;
constexpr size_t WS_WIN   = 1 * MiB;
constexpr size_t WS_WO    = 8 * MiB + 512 * 1024;
constexpr size_t WS_WR    = 10 * MiB + 512 * 1024;
constexpr size_t WS_WGU   = 11 * MiB;
constexpr size_t WS_WD    = 75 * MiB;
constexpr size_t WS_A     = 107 * MiB;
constexpr size_t WS_PROJ  = 235 * MiB;
constexpr size_t WS_MIX   = 683 * MiB;
constexpr size_t WS_TQK   = 811 * MiB;
constexpr size_t WS_DAB   = 939 * MiB;
constexpr size_t WS_G     = 943 * MiB;
constexpr size_t WS_BETA  = 945 * MiB;
constexpr size_t WS_TOKE  = 947 * MiB;
constexpr size_t WS_TOKG  = 948 * MiB;
constexpr size_t WS_RSTD2 = 949 * MiB;
constexpr size_t WS_BIDX  = 950 * MiB;
constexpr size_t WS_END   = 966 * MiB;
constexpr size_t WS_HID   = WS_PROJ;
constexpr size_t WS_Y     = WS_PROJ + 80 * MiB;
constexpr int CW_CNT = 1024;

__device__ __forceinline__ float bf2f(bf16 v) { return __builtin_bit_cast(float, (unsigned)v << 16); }
__device__ __forceinline__ bf16 f2bf(float f) { unsigned u = __builtin_bit_cast(unsigned, f); return (bf16)((u + 0x7fffu + ((u >> 16) & 1u)) >> 16); }
template <int CTRL> __device__ __forceinline__ float dpp_f(float v) { return __builtin_bit_cast(float, __builtin_amdgcn_update_dpp(0, __builtin_bit_cast(int, v), CTRL, 0xf, 0xf, false)); }
__device__ __forceinline__ float row16_sum(float v) {
    v += dpp_f<0xB1>(v);
    v += dpp_f<0x4E>(v);
    v += dpp_f<0x141>(v);
    v += dpp_f<0x140>(v);
    return v;
}
__device__ __forceinline__ float wave_sum(float v) {
    const int b = __builtin_bit_cast(int, row16_sum(v));
    return (__builtin_bit_cast(float, __builtin_amdgcn_readlane(b, 0)) + __builtin_bit_cast(float, __builtin_amdgcn_readlane(b, 16))) + (__builtin_bit_cast(float, __builtin_amdgcn_readlane(b, 32)) + __builtin_bit_cast(float, __builtin_amdgcn_readlane(b, 48)));
}
__device__ __forceinline__ float silu_f(float x) { return x / (1.f + __expf(-x)); }
__device__ __forceinline__ float sigmoid_f(float x) { return 1.f / (1.f + __expf(-x)); }
__device__ __forceinline__ float softplus_f(float x) { return fmaxf(x, 0.f) + log1pf(__expf(-fabsf(x))); }

#define LAS __attribute__((address_space(3)))
#define GAS __attribute__((address_space(1)))
typedef short bf16x8 __attribute__((ext_vector_type(8)));
typedef GAS unsigned gu32;
constexpr int NWAVES = 8, NTHR = 512;
constexpr int LDS_BYTES = 163840, RING_BYTES = 131072, LDSCTL_OFF = 163328, MISC_OFF = LDSCTL_OFF + 64, TAB_OFF = 132096;
constexpr size_t WS_SSQ2 = 966 * MiB;
constexpr size_t WS_EDL  = 970 * MiB;
constexpr size_t WS_GCR  = 972 * MiB;
constexpr size_t WS_END2 = 974 * MiB;
constexpr int CW_TMO = 0, CW_BAR = 4096;
constexpr int CW_PCNT = 1280;
constexpr size_t WS_R2T = WS_CTL + 256 * 1024;
constexpr size_t WS_TOKP = WS_TOKE;
#define RLX_AGENT __ATOMIC_RELAXED, __HIP_MEMORY_SCOPE_AGENT
#define LDS_WAIT() asm volatile("s_waitcnt lgkmcnt(0)" ::: "memory")
#define VM_WAIT() asm volatile("s_waitcnt vmcnt(0)" ::: "memory")
#define LDS_BAR() do { asm volatile("s_waitcnt lgkmcnt(0)" ::: "memory"); __builtin_amdgcn_s_barrier(); asm volatile("" ::: "memory"); } while (0)
__device__ __forceinline__ unsigned pk2(float lo, float hi) { return (unsigned)f2bf(lo) | ((unsigned)f2bf(hi) << 16); }
typedef float f32x2_t __attribute__((ext_vector_type(2)));
typedef __bf16 bf16x2_t __attribute__((ext_vector_type(2)));
__device__ __forceinline__ unsigned cvt_pk_bf16_asm(float lo, float hi) { unsigned r; asm volatile("v_cvt_pk_bf16_f32 %0, %1, %2" : "=v"(r) : "v"(lo), "v"(hi)); return r; }
__device__ __forceinline__ unsigned cvt_pk_bf16(float lo, float hi) { const f32x2_t v = {lo, hi}; const bf16x2_t b = __builtin_convertvector(v, bf16x2_t); return __builtin_bit_cast(unsigned, b); }

#define XB_TMO      128
#define XB_XCNT(j)  (256  + 64 * (j))
#define XB_XSUB(j)  (1280 + 64 * (j))
#define XB_XGEN(j)  (2304 + 64 * (j))
#define XB_TOP      3328
#define XB_TOPGEN   3392
#define XCD_BAR_WORDS 3456
#define XB_SPIN_CAP (1u << 22)
__device__ __forceinline__ unsigned xb_ld(unsigned* p)              { return __hip_atomic_load(p, __ATOMIC_RELAXED, __HIP_MEMORY_SCOPE_AGENT); }
__device__ __forceinline__ unsigned xb_add(unsigned* p, unsigned v) { return __hip_atomic_fetch_add(p, v, __ATOMIC_RELAXED, __HIP_MEMORY_SCOPE_AGENT); }
__device__ __forceinline__ unsigned xb_xcc_id() { return (unsigned)__builtin_amdgcn_s_getreg((3 << 11) | 20) & 0xFu; }
#define XB_SPIN(cond, bar) do { unsigned _sp = 0; while (cond) { __builtin_amdgcn_s_sleep(1); \
    if ((++_sp & 255u) == 0u) { if (xb_ld(&(bar)[XB_TMO])) break; if (_sp > XB_SPIN_CAP) { atomicAdd(&(bar)[XB_TMO], 1u); break; } } } } while (0)
struct XcdBarrier { unsigned* bar; unsigned x; volatile LAS unsigned* st; };
__device__ __forceinline__ XcdBarrier xcd_barrier_post(unsigned* bar, volatile LAS unsigned* st) {
    XcdBarrier b; b.bar = bar; b.x = xb_xcc_id(); b.st = st;
    if (threadIdx.x == 0) (void)xb_add(&bar[XB_XCNT(b.x)], 1u);
    return b;
}
__device__ __forceinline__ void xcd_barrier_complete(unsigned* bar, unsigned x, unsigned& nloc, unsigned& nx) {
    const unsigned G = gridDim.x * gridDim.y * gridDim.z;
    unsigned sum, cnt, mine, sp = 0u;
    for (;;) {
        sum = 0u; cnt = 0u; mine = 0u;
#pragma unroll
        for (unsigned j = 0; j < 16; ++j) { const unsigned c = xb_ld(&bar[XB_XCNT(j)]); sum += c; cnt += (c > 0u) ? 1u : 0u; mine = (j == x) ? c : mine; }
        if (sum == G) break;
        __builtin_amdgcn_s_sleep(1);
        if ((++sp & 255u) == 0u) { if (xb_ld(&bar[XB_TMO])) break; if (sp > XB_SPIN_CAP) { atomicAdd(&bar[XB_TMO], 1u); break; } }
    }
    nloc = mine > 0u ? mine : 1u; nx = cnt > 0u ? cnt : 1u;
}
__device__ __forceinline__ void xcd_barrier(const XcdBarrier& b) {
    asm volatile("s_waitcnt vmcnt(0)" ::: "memory");
    __syncthreads();
    if (threadIdx.x == 0) {
        unsigned* bar = b.bar;
        __builtin_amdgcn_s_waitcnt(0);
        unsigned nloc = b.st[0], nx = b.st[1];
        if (nloc == 0u) { xcd_barrier_complete(bar, b.x, nloc, nx); b.st[0] = nloc; b.st[1] = nx; }
        const unsigned old = xb_add(&bar[XB_XSUB(b.x)], 1u);
        const unsigned gen = old / nloc;
        if (old + 1u == (gen + 1u) * nloc) {
            __builtin_amdgcn_fence(__ATOMIC_RELEASE, "agent");
            asm volatile("s_waitcnt vmcnt(0)" ::: "memory");
            const unsigned og = xb_add(&bar[XB_TOP], 1u);
            const unsigned tg = og / nx;
            if (og + 1u == (tg + 1u) * nx) xb_add(&bar[XB_TOPGEN], 1u);
            else XB_SPIN(xb_ld(&bar[XB_TOPGEN]) == tg, bar);
            __builtin_amdgcn_fence(__ATOMIC_ACQUIRE, "agent");
            xb_add(&bar[XB_XGEN(b.x)], 1u);
            asm volatile("s_waitcnt vmcnt(0)" ::: "memory");
        } else {
            XB_SPIN(xb_ld(&bar[XB_XGEN(b.x)]) == gen, bar);
            __builtin_amdgcn_fence(__ATOMIC_ACQUIRE, "agent");
            asm volatile("s_waitcnt vmcnt(0)" ::: "memory");
        }
    }
    __syncthreads();
}

namespace pg8 {
constexpr int BM = 256, BK = 64, HALF = 128, HTB = HALF * BK * 2, NXCD = 8, WGM = 8;
__host__ __device__ __forceinline__ int lds_byte(int r, int c) { const int st = (r >> 4) * 2 + (c >> 5), rr = r & 15, cc = c & 31, ob = rr * 64 + cc * 2; return st * 1024 + (ob ^ (((ob >> 9) & 1) << 5)); }
__host__ __device__ __forceinline__ void stage_rc(int b, int& R, int& C) { const int st = b / 1024, sb = b % 1024, swz = sb ^ (((sb >> 9) & 1) << 5); R = (st >> 1) * 16 + swz / 64; C = (st & 1) * 32 + (swz % 64) / 2; }
__host__ __device__ __forceinline__ int perm32(int rho) { const int n = rho >> 4, i = rho & 15; return 8 * (i >> 2) + 4 * n + (i & 3); }
struct Unit { int pm, pn, e, ts, e2; };
struct Gemm { const bf16* A; const bf16* Bt; int K; size_t bstride; int ldb, bsplit; };
struct StaticOrder {
    int nM, nN, nwg, G, c;
    __device__ void init(int M, int N, int G_, int c_) { nM = M / BM; nN = N / BM; nwg = nM * nN; G = G_; c = c_; }
    __device__ bool next(int i, Unit& u) const {
        const long L = (long)i * G + c; if (L >= nwg) return false;
        int wgid = (int)L; { const int q = nwg / NXCD, r = nwg % NXCD, xcd = wgid % NXCD, off = wgid / NXCD; wgid = (xcd < r ? xcd * (q + 1) : r * (q + 1) + (xcd - r) * q) + off; }
        const int nig = WGM * nN, gid = wgid / nig, fm = gid * WGM, gsz = (nM - fm) < WGM ? (nM - fm) : WGM;
        u.pm = fm + ((wgid % nig) % gsz); u.pn = (wgid % nig) / gsz; u.e = 0; u.ts = 0; u.e2 = 0; return true;
    }
};
struct DenseA { int K; __device__ __forceinline__ unsigned rowoff(const Unit& u, int h, int R) const { return (unsigned)(u.pm * BM + h * HALF + R) * (unsigned)(K * 2); } };
struct GatherA { const LAS unsigned* tab; __device__ __forceinline__ unsigned rowoff(const Unit& u, int h, int R) const { return tab[u.ts * BM + h * HALF + R]; } };

template <class Epi, class Sched, class AMap, bool ALIGN_EPI>
__device__ __forceinline__ void gemm_phase(LAS unsigned char* lds, const Gemm g, const Sched& S, const AMap& AM, const Epi& E) {
    const int tid = threadIdx.x, wid = __builtin_amdgcn_readfirstlane(tid >> 6), lane = tid & 63, wr = wid >> 2, wc = wid & 3, fr = lane & 15, fq = lane >> 4;
    const int K = g.K, nt = K / BK;
    unsigned voffB[2];
#pragma unroll
    for (int i = 0; i < 2; ++i) { int R, C; stage_rc(tid * 16 + i * 8192, R, C); const int Rb = Epi::PERM ? ((R & ~31) + perm32(R & 31)) : R;
        voffB[i] = (unsigned)(Rb * g.ldb + C) * 2u; }
    const size_t kstep = (size_t)(BK * 2);
    const size_t hstep = (size_t)HALF * g.ldb * 2;
    const int bsplit = g.bsplit;
    const size_t tstep = 2 * hstep;
    const unsigned ldsw = (unsigned)wid * 1024u;
    const int aoff = lds_byte(wr * 64 + fr, fq * 8), boff = lds_byte(wc * 32 + fr, fq * 8);
    const char* const Ab = (const char*)g.A;
#define PG8_SA(b, h) (((b) * 2 + (h)) * HTB)
#define PG8_SB(b, h) ((4 + (b) * 2 + (h)) * HTB)
#define PG8_STAGE(bufoff, gbase, voff) do { _Pragma("unroll") for (int _i = 0; _i < 2; ++_i) \
        __builtin_amdgcn_global_load_lds((const unsigned*)((const char*)(gbase) + (voff)[_i]), (LAS unsigned*)(lds + (bufoff) + ldsw + _i * 8192), 16, 0, 0); } while (0)
#define PG8_LDA(dst, b, h) do { _Pragma("unroll") for (int m = 0; m < 4; ++m) _Pragma("unroll") for (int k = 0; k < 2; ++k) dst[m][k] = *(const LAS bf16x8*)(lds + PG8_SA(b, h) + aoff + m * 2048 + k * 1024); } while (0)
#define PG8_LDB(dst, b, h) do { _Pragma("unroll") for (int n = 0; n < 2; ++n) _Pragma("unroll") for (int k = 0; k < 2; ++k) dst[n][k] = *(const LAS bf16x8*)(lds + PG8_SB(b, h) + boff + n * 2048 + k * 1024); } while (0)
#define PG8_MMA(ai, bj, At, Bt) do { __builtin_amdgcn_s_setprio(1); _Pragma("unroll") for (int m = 0; m < 4; ++m) _Pragma("unroll") for (int n = 0; n < 2; ++n) _Pragma("unroll") for (int k = 0; k < 2; ++k) \
        acc[ai][bj][m][n] = __builtin_amdgcn_mfma_f32_16x16x32_bf16(Bt[n][k], At[m][k], acc[ai][bj][m][n], 0, 0, 0); __builtin_amdgcn_s_setprio(0); } while (0)
#define PG8_WAIT_V(n) asm volatile("s_waitcnt vmcnt(" #n ")" ::: "memory")
#define PG8_WAIT_L(n) asm volatile("s_waitcnt lgkmcnt(" #n ")" ::: "memory")
#define PG8_BAR __builtin_amdgcn_s_barrier()
#define PG8_SCHED __builtin_amdgcn_sched_barrier(0)
    Unit cur, nxt; int ui = 0;
    if (!S.next(0, cur)) return;
    f32x4 acc[2][2][4][2];
#pragma unroll
    for (int a = 0; a < 2; ++a)
#pragma unroll
        for (int b = 0; b < 2; ++b)
#pragma unroll
            for (int m = 0; m < 4; ++m)
#pragma unroll
                for (int n = 0; n < 2; ++n) acc[a][b][m][n] = (f32x4){0.f, 0.f, 0.f, 0.f};
    bf16x8 At[4][2], B0[2][2], B1[2][2];
    unsigned ca[2][2];
#pragma unroll
    for (int i = 0; i < 2; ++i) { int R, C; stage_rc(tid * 16 + i * 8192, R, C);
#pragma unroll
        for (int h = 0; h < 2; ++h) ca[h][i] = AM.rowoff(cur, h, R) + (unsigned)C * 2u; }
    const char* cB = (const char*)g.Bt + (size_t)cur.e * g.bstride + (size_t)cur.pn * tstep;
    const char* cB2 = (const char*)g.Bt + (size_t)cur.e2 * g.bstride + (size_t)cur.pn * tstep;
    PG8_STAGE(PG8_SB(0, 0), cB, voffB); PG8_STAGE(PG8_SB(0, 1), cB + hstep, voffB); PG8_STAGE(PG8_SA(0, 0), Ab, ca[0]); PG8_STAGE(PG8_SA(0, 1), Ab, ca[1]);
    if (wr == 1) PG8_BAR;
    PG8_WAIT_V(2); PG8_BAR;
    PG8_STAGE(PG8_SB(1, 0), cB + kstep, voffB); PG8_STAGE(PG8_SA(1, 0), Ab + kstep, ca[0]); PG8_STAGE(PG8_SB(1, 1), cB + hstep + kstep, voffB);
    PG8_WAIT_V(6); PG8_BAR;
    for (;;) {
        const bool has_next = S.next(ui + 1, nxt);
        const char* nB = has_next ? (const char*)g.Bt + (size_t)nxt.e * g.bstride + (size_t)nxt.pn * tstep : cB;
        for (int t = 0; t < nt; t += 2) {
            const bool last = (t == nt - 2);
            unsigned a2[2][2];
#pragma unroll
            for (int h = 0; h < 2; ++h)
#pragma unroll
                for (int i = 0; i < 2; ++i) a2[h][i] = ca[h][i];
            if (last && has_next) {
                int tq = tid; asm volatile("" : "+v"(tq));
#pragma unroll
                for (int i = 0; i < 2; ++i) { int R, C; stage_rc(tq * 16 + i * 8192, R, C);
#pragma unroll
                    for (int h = 0; h < 2; ++h) a2[h][i] = AM.rowoff(nxt, h, R) + (unsigned)C * 2u; }
            }
            const char* a1 = Ab + (size_t)(t + 1) * kstep;
            const char* a2b = last ? Ab : Ab + (size_t)(t + 2) * kstep;
            const char* b2 = last ? nB : ((bsplit > 0 && t + 2 >= bsplit) ? cB2 + (size_t)(t + 2 - bsplit) * kstep : cB + (size_t)(t + 2) * kstep);
            const char* a3b = a2b + kstep; const char* b3 = b2 + kstep;
            PG8_LDB(B0, 0, 0); PG8_LDB(B1, 0, 1); PG8_SCHED; PG8_LDA(At, 0, 0); PG8_STAGE(PG8_SA(1, 1), a1, ca[1]);
            PG8_WAIT_V(8); PG8_WAIT_L(0); PG8_BAR; PG8_MMA(0, 0, At, B0); PG8_MMA(0, 1, At, B1); PG8_BAR; PG8_SCHED;
            PG8_LDA(At, 0, 1); PG8_STAGE(PG8_SB(0, 0), b2, voffB); PG8_STAGE(PG8_SB(0, 1), b2 + hstep, voffB); PG8_STAGE(PG8_SA(0, 0), a2b, a2[0]);
            PG8_WAIT_V(8); PG8_WAIT_L(0); PG8_BAR; PG8_MMA(1, 0, At, B0); PG8_MMA(1, 1, At, B1); PG8_BAR; PG8_SCHED;
            PG8_LDB(B0, 1, 0); PG8_LDB(B1, 1, 1); PG8_SCHED; PG8_LDA(At, 1, 0); PG8_STAGE(PG8_SA(0, 1), a2b, a2[1]);
            PG8_WAIT_V(8); PG8_WAIT_L(0); PG8_BAR; PG8_MMA(0, 0, At, B0); PG8_MMA(0, 1, At, B1); PG8_BAR; PG8_SCHED;
            PG8_LDA(At, 1, 1); PG8_STAGE(PG8_SB(1, 0), b3, voffB); PG8_STAGE(PG8_SB(1, 1), b3 + hstep, voffB); PG8_STAGE(PG8_SA(1, 0), a3b, a2[0]);
            PG8_WAIT_V(8); PG8_WAIT_L(0); PG8_BAR; PG8_MMA(1, 0, At, B0); PG8_MMA(1, 1, At, B1); PG8_BAR; PG8_SCHED;
            if (last) {
#pragma unroll
                for (int h = 0; h < 2; ++h)
#pragma unroll
                    for (int i = 0; i < 2; ++i) ca[h][i] = a2[h][i];
            }
        }
        if constexpr (ALIGN_EPI) { if (wr == 0) PG8_BAR; }
        if constexpr (!Epi::AFTER_DRAIN) { E(acc, cur, wr, wc, fr, fq); }
        if (!has_next) break;
#pragma unroll
        for (int a = 0; a < 2; ++a)
#pragma unroll
            for (int b = 0; b < 2; ++b)
#pragma unroll
                for (int m = 0; m < 4; ++m)
#pragma unroll
                    for (int n = 0; n < 2; ++n) acc[a][b][m][n] = (f32x4){0.f, 0.f, 0.f, 0.f};
        cur = nxt; cB = nB; cB2 = (const char*)g.Bt + (size_t)cur.e2 * g.bstride + (size_t)cur.pn * tstep; ++ui;
        if constexpr (ALIGN_EPI) { if (wr == 1) PG8_BAR; }
    }
    PG8_WAIT_V(0);
    if constexpr (!ALIGN_EPI) { if (wr == 0) PG8_BAR; }
    PG8_BAR;
    if constexpr (Epi::AFTER_DRAIN) { E.fused(acc, cur, wr, wc, fr, fq, lds, wid, lane); }
#undef PG8_SA
#undef PG8_SB
#undef PG8_STAGE
#undef PG8_LDA
#undef PG8_LDB
#undef PG8_MMA
#undef PG8_WAIT_V
#undef PG8_WAIT_L
#undef PG8_BAR
#undef PG8_SCHED
}
}

struct EpiInProjF { static constexpr bool PERM = true, AFTER_DRAIN = false;
    bf16* proj; const LAS float* gains; float* dab;
    __device__ __forceinline__ void operator()(const f32x4 (&acc)[2][2][4][2], const pg8::Unit& u, int wr, int wc, int fr, int fq) const {
        if (u.pn == 14) {
            if (wc == 0) {
#pragma unroll
                for (int ai = 0; ai < 2; ++ai)
#pragma unroll
                    for (int m = 0; m < 4; ++m) { const int row = u.pm * 256 + ai * 128 + wr * 64 + m * 16 + fr;
#pragma unroll
                        for (int n = 0; n < 2; ++n) { f32x4 t = acc[ai][0][m][n];
#pragma unroll
                            for (int i = 0; i < 4; ++i) t[i] += __shfl_xor(t[i], 32);
                            if (fq < 2) *(f32x4*)(dab + (size_t)row * 16 + 8 * fq + 4 * n) = t; } }
            }
            return;
        }
        const int mode = u.pn < 2 ? 0 : (u.pn < 4 ? 1 : 2);
        float one = 1.f; asm volatile("" : "+v"(one));
        f32x4 gv[2][2];
        if (mode < 2) {
#pragma unroll
            for (int bj = 0; bj < 2; ++bj)
#pragma unroll
                for (int n = 0; n < 2; ++n) gv[bj][n] = *(const LAS f32x4*)(gains + mode * 64 + 32 * bj + 8 * fq + 4 * n);
        }
#pragma unroll
        for (int ai = 0; ai < 2; ++ai)
#pragma unroll
            for (int m = 0; m < 4; ++m) {
                const int row = u.pm * 256 + ai * 128 + wr * 64 + m * 16 + fr;
                f32x4 v[2][2];
#pragma unroll
                for (int bj = 0; bj < 2; ++bj)
#pragma unroll
                    for (int n = 0; n < 2; ++n) v[bj][n] = acc[ai][bj][m][n];
                if (mode >= 2) {
#pragma unroll
                    for (int bj = 0; bj < 2; ++bj)
#pragma unroll
                        for (int n = 0; n < 2; ++n) v[bj][n] = v[bj][n] * one;
                }
                if (mode < 2) {
                    float ss = 0.f;
#pragma unroll
                    for (int bj = 0; bj < 2; ++bj)
#pragma unroll
                        for (int n = 0; n < 2; ++n) ss += (v[bj][n][0] * v[bj][n][0] + v[bj][n][1] * v[bj][n][1]) + (v[bj][n][2] * v[bj][n][2] + v[bj][n][3] * v[bj][n][3]);
                    ss += __shfl_xor(ss, 16); ss += __shfl_xor(ss, 32);
                    const float rstd = rsqrtf(ss * (1.f / 64) + EPS);
#pragma unroll
                    for (int bj = 0; bj < 2; ++bj)
#pragma unroll
                        for (int n = 0; n < 2; ++n) v[bj][n] = v[bj][n] * rstd * gv[bj][n];
                }
                bf16* rp = proj + (size_t)row * PC + u.pn * 256 + wc * 64 + 8 * fq;
#pragma unroll
                for (int bj = 0; bj < 2; ++bj) { u32x4 w; w.x = cvt_pk_bf16_asm(v[bj][0][0], v[bj][0][1]); w.y = cvt_pk_bf16_asm(v[bj][0][2], v[bj][0][3]); w.z = cvt_pk_bf16_asm(v[bj][1][0], v[bj][1][1]); w.w = cvt_pk_bf16_asm(v[bj][1][2], v[bj][1][3]);
                    *(u32x4*)(rp + 32 * bj) = w; }
            }
    }
};
struct EpiOutF { static constexpr bool PERM = true, AFTER_DRAIN = false;
    const float* x; float* out; bf16* x2b; float* ssq2;
    __device__ __forceinline__ void operator()(const f32x4 (&acc)[2][2][4][2], const pg8::Unit& u, int wr, int wc, int fr, int fq) const {
#pragma unroll
        for (int ai = 0; ai < 2; ++ai)
#pragma unroll
            for (int m = 0; m < 4; ++m) {
                const int row = u.pm * 256 + ai * 128 + wr * 64 + m * 16 + fr; float ss = 0.f;
#pragma unroll
                for (int bj = 0; bj < 2; ++bj) { const size_t off = (size_t)row * DM + u.pn * 256 + bj * 128 + wc * 32 + 8 * fq;
                    const f32x4 r0 = *(const f32x4*)(x + off) + acc[ai][bj][m][0], r1 = *(const f32x4*)(x + off + 4) + acc[ai][bj][m][1];
                    ss += (r0[0] * r0[0] + r0[1] * r0[1]) + (r0[2] * r0[2] + r0[3] * r0[3]) + (r1[0] * r1[0] + r1[1] * r1[1]) + (r1[2] * r1[2] + r1[3] * r1[3]);
                    u32x4 w; w.x = cvt_pk_bf16_asm(r0[0], r0[1]); w.y = cvt_pk_bf16_asm(r0[2], r0[3]); w.z = cvt_pk_bf16_asm(r1[0], r1[1]); w.w = cvt_pk_bf16_asm(r1[2], r1[3]);
                    *(u32x4*)(x2b + off) = w; }
                ss += __shfl_xor(ss, 16); ss += __shfl_xor(ss, 32);
                if (fq == 0) ssq2[(size_t)(u.pn * 4 + wc) * NT + row] = ss;
            }
    }
};
struct EpiRouterF { static constexpr bool PERM = true, AFTER_DRAIN = true;
    const float* ssq2; const float* bg; const float* be; int* toke; float* tokg; float* rstd2; int* bidx; unsigned* cnt;
    __device__ __forceinline__ void fused(const f32x4 (&acc)[2][2][4][2], const pg8::Unit& u, int wr, int wc, int fr, int fq, LAS unsigned char* lds, int wid, int lane) const {
        LAS float* LG = (LAS float*)lds;
        LAS unsigned* cl = (LAS unsigned*)(lds + 80 * 1024);
        LAS unsigned* clp = cl + 128;
        const int tid = threadIdx.x;
        if (tid < 128) cl[tid] = 0u;
        if (tid < 448) clp[tid] = 0u;
        if (wc == 0) {
#pragma unroll
            for (int ai = 0; ai < 2; ++ai)
#pragma unroll
                for (int m = 0; m < 4; ++m) { const int r = ai * 128 + wr * 64 + m * 16 + fr;
#pragma unroll
                    for (int bj = 0; bj < 2; ++bj)
#pragma unroll
                        for (int n = 0; n < 2; ++n)
#pragma unroll
                            for (int i = 0; i < 4; ++i) LG[r * 73 + 32 * bj + 8 * fq + 4 * n + i] = acc[ai][bj][m][n][i]; }
        } else if (wc == 1 && fq == 0) {
#pragma unroll
            for (int ai = 0; ai < 2; ++ai)
#pragma unroll
                for (int m = 0; m < 4; ++m) { const int r = ai * 128 + wr * 64 + m * 16 + fr;
#pragma unroll
                    for (int n = 0; n < 2; ++n)
#pragma unroll
                        for (int i = 0; i < 4; ++i) LG[r * 73 + 64 + 4 * n + i] = acc[ai][0][m][n][i]; }
        }
        __syncthreads();
        int e0 = 0, e1 = 0, pb = 0, slo = 0; unsigned r0 = 0, r1 = 0, rp = 0; const int tok = u.pm * 256 + tid;
        if (tid < 256) {
            float ss = 0.f;
#pragma unroll
            for (int p = 0; p < 16; ++p) ss += ssq2[(size_t)p * NT + tok];
            const float rstd = rsqrtf(ss * (1.f / DM) + EPS);
            const LAS float* lg = LG + tid * 73;
            float gl[8];
#pragma unroll
            for (int n = 0; n < 8; ++n) gl[n] = lg[64 + n] * rstd + bg[n];
            int gs = 0; float gm = gl[0];
#pragma unroll
            for (int n = 1; n < 8; ++n) if (gl[n] > gm) { gm = gl[n]; gs = n; }
            float den = 0.f;
#pragma unroll
            for (int n = 0; n < 8; ++n) den += __expf(gl[n] - gm);
            const float gp = 1.f / den;
            float el[8];
#pragma unroll
            for (int n = 0; n < 8; ++n) el[n] = lg[gs * 8 + n] * rstd + be[gs * 8 + n];
            int i1 = 0; float v1 = el[0];
#pragma unroll
            for (int n = 1; n < 8; ++n) if (el[n] > v1) { v1 = el[n]; i1 = n; }
            int i2 = 0; float v2 = -3.0e38f;
#pragma unroll
            for (int n = 0; n < 8; ++n) if (n != i1 && el[n] > v2) { v2 = el[n]; i2 = n; }
            const float ex = __expf(v2 - v1), p1 = 1.f / (1.f + ex), p2 = ex * p1;
            e0 = gs * 8 + i1; e1 = gs * 8 + i2;
            tokg[tok * 2] = gp * p1; tokg[tok * 2 + 1] = gp * p2; rstd2[tok] = rstd;
            r0 = __hip_atomic_fetch_add(cl + e0, 1u, __ATOMIC_RELAXED, __HIP_MEMORY_SCOPE_WORKGROUP);
            r1 = __hip_atomic_fetch_add(cl + e1, 1u, __ATOMIC_RELAXED, __HIP_MEMORY_SCOPE_WORKGROUP);
            { const int lo = i1 < i2 ? i1 : i2, hi = i1 < i2 ? i2 : i1; slo = i1 < i2 ? 0 : 1; pb = gs * 28 + (lo * (15 - lo)) / 2 + (hi - lo - 1); }
            rp = __hip_atomic_fetch_add(clp + pb, 1u, __ATOMIC_RELAXED, __HIP_MEMORY_SCOPE_WORKGROUP);
        }
        __syncthreads();
        if (tid < 64) { const unsigned c = cl[tid]; cl[64 + tid] = c ? __hip_atomic_fetch_add(cnt + tid, c, __ATOMIC_RELAXED, __HIP_MEMORY_SCOPE_AGENT) : 0u; }
        else if (tid >= 256 && tid < 256 + 224) { const int q = tid - 256; const unsigned c = clp[q]; clp[224 + q] = c ? __hip_atomic_fetch_add(cnt + (CW_PCNT - CW_CNT) + q, c, __ATOMIC_RELAXED, __HIP_MEMORY_SCOPE_AGENT) : 0u; }
        __syncthreads();
        if (tid < 256) { bidx[(size_t)e0 * 65536 + cl[64 + e0] + r0] = tok; bidx[(size_t)e1 * 65536 + cl[64 + e1] + r1] = tok | (1 << 16);
            toke[tok] = (int)(clp[224 + pb] + rp) | (pb << 16) | (slo << 24); }
    }
};
struct EpiMoe1F { static constexpr bool PERM = true, AFTER_DRAIN = false;
    bf16* hid2; const LAS float* rscale; const LAS unsigned* dest; const LAS float* gate;
    __device__ __forceinline__ void operator()(const f32x4 (&acc)[2][2][4][2], const pg8::Unit& u, int wr, int wc, int fr, int fq) const {
#pragma unroll
        for (int ai = 0; ai < 2; ++ai)
#pragma unroll
            for (int m = 0; m < 4; ++m) { const int r = ai * 128 + wr * 64 + m * 16 + fr; const float rs = rscale[u.ts * 256 + r], gt = gate[u.ts * 256 + r]; const unsigned d = dest[u.ts * 256 + r];
                float h[8];
#pragma unroll
                for (int n = 0; n < 2; ++n)
#pragma unroll
                    for (int i = 0; i < 4; ++i) { const float gv = acc[ai][0][m][n][i] * rs, up = acc[ai][1][m][n][i] * rs; h[4 * n + i] = gv * up * gt * __builtin_amdgcn_rcpf(1.f + __expf(-gv)); }
                u32x4 w; w.x = cvt_pk_bf16_asm(h[0], h[1]); w.y = cvt_pk_bf16_asm(h[2], h[3]); w.z = cvt_pk_bf16_asm(h[4], h[5]); w.w = cvt_pk_bf16_asm(h[6], h[7]);
                if (d != 0xffffffffu) *(u32x4*)((char*)hid2 + d + (unsigned)((u.pn * 128 + wc * 32 + 8 * fq) * 2)) = w;
                __builtin_amdgcn_sched_barrier(0); }
    }
};
struct EpiMoe2F { static constexpr bool PERM = true, AFTER_DRAIN = false;
    const bf16* x2b; float* out; const LAS unsigned* tokp1;
    __device__ __forceinline__ void operator()(const f32x4 (&acc)[2][2][4][2], const pg8::Unit& u, int wr, int wc, int fr, int fq) const {
#pragma unroll
        for (int ai = 0; ai < 2; ++ai) {
            unsigned off0[4]; u32x4 xr[4][2];
#pragma unroll
            for (int m = 0; m < 4; ++m) { const unsigned t1 = tokp1[u.ts * 256 + ai * 128 + wr * 64 + m * 16 + fr];
                off0[m] = t1 ? (t1 - 1u) * (unsigned)DM + (unsigned)(u.pn * 256 + wc * 32 + 8 * fq) : 0xffffffffu;
#pragma unroll
                for (int bj = 0; bj < 2; ++bj) xr[m][bj] = *(const u32x4*)(x2b + (t1 ? off0[m] + bj * 128 : 0u)); }
#pragma unroll
            for (int m = 0; m < 4; ++m) if (off0[m] != 0xffffffffu) {
#pragma unroll
                for (int bj = 0; bj < 2; ++bj) { const unsigned off = off0[m] + bj * 128; const u32x4 x = xr[m][bj];
                    f32x4 o0, o1; o0[0] = __builtin_bit_cast(float, x.x << 16); o0[1] = __builtin_bit_cast(float, x.x & 0xffff0000u); o0[2] = __builtin_bit_cast(float, x.y << 16); o0[3] = __builtin_bit_cast(float, x.y & 0xffff0000u);
                    o1[0] = __builtin_bit_cast(float, x.z << 16); o1[1] = __builtin_bit_cast(float, x.z & 0xffff0000u); o1[2] = __builtin_bit_cast(float, x.w << 16); o1[3] = __builtin_bit_cast(float, x.w & 0xffff0000u);
                    __builtin_nontemporal_store(o0 + acc[ai][bj][m][0], (f32x4*)(out + off)); __builtin_nontemporal_store(o1 + acc[ai][bj][m][1], (f32x4*)(out + off + 4)); } }
            __builtin_amdgcn_sched_barrier(0); }
    }
};
struct MoeSched { const LAS int* tab; int n;
    __device__ __forceinline__ bool next(int i, pg8::Unit& u) const { if (i >= n) return false;
        u.pm = __builtin_amdgcn_readfirstlane(tab[8 * i]); u.pn = __builtin_amdgcn_readfirstlane(tab[8 * i + 1]); u.e = __builtin_amdgcn_readfirstlane(tab[8 * i + 2]); u.ts = __builtin_amdgcn_readfirstlane(tab[8 * i + 3]);
        u.e2 = __builtin_amdgcn_readfirstlane(tab[8 * i + 4]); return true; }
};

struct Args { const float* in[20]; float* out; unsigned char* ws; int ph_lo, ph_hi; };
struct Frame { LAS unsigned char* lds; int tid, lane, wave, vcu, G; unsigned char* ws; };

template <class RowMap>
__device__ __forceinline__ void p0_transpose_item(const float* W, int ldw, int k0, int n0, const float* ksc, bf16* dst, int Kd, const RowMap& rm, LAS float* scr, int lane) {
    const int kr = lane >> 4, nq = lane & 15;
    f32x4 tv[16];
#pragma unroll
    for (int i = 0; i < 16; ++i) tv[i] = *(const f32x4*)(W + (size_t)(k0 + 4 * i + kr) * ldw + n0 + 4 * nq);
    if (ksc) {
#pragma unroll
        for (int i = 0; i < 16; ++i) tv[i] = tv[i] * ksc[k0 + 4 * i + kr]; }
#pragma unroll
    for (int i = 0; i < 16; ++i) { LAS float* d = scr + (4 * i + kr) * 65 + 4 * nq; d[0] = tv[i][0]; d[1] = tv[i][1]; d[2] = tv[i][2]; d[3] = tv[i][3]; }
    LDS_WAIT(); asm volatile("" ::: "memory");
    const int c = lane & 7;
#pragma unroll
    for (int j = 0; j < 8; ++j) { const int n = (lane >> 3) + 8 * j; const LAS float* sp = scr + (8 * c) * 65 + n;
        u32x4 o; o.x = cvt_pk_bf16(sp[0 * 65], sp[1 * 65]); o.y = cvt_pk_bf16(sp[2 * 65], sp[3 * 65]); o.z = cvt_pk_bf16(sp[4 * 65], sp[5 * 65]); o.w = cvt_pk_bf16(sp[6 * 65], sp[7 * 65]);
        *(u32x4*)(dst + (size_t)rm(n0 + n) * Kd + k0 + 8 * c) = o; }
    LDS_WAIT(); asm volatile("" ::: "memory");
}
struct RmIn  { __device__ __forceinline__ int operator()(int n) const { const int pn = n >> 8, lc = n & 255; return pn * 256 + 128 * ((lc >> 5) & 1) + 32 * (lc >> 6) + (lc & 31); } };
struct RmId  { int off; __device__ __forceinline__ int operator()(int n) const { return off + n; } };
struct RmGU  { int e, u; __device__ __forceinline__ int operator()(int n) const { return e * 512 + 256 * (n >> 7) + 128 * u + (n & 127); } };

__device__ __forceinline__ void phase0(const Frame& F, const Args& a) {
    const float* x = a.in[0]; const float* ln1_g = a.in[1]; const float* w_in = a.in[2];
    const float* w_out = a.in[11]; const float* ln2_g = a.in[12]; const float* wg_r = a.in[13]; const float* we_r = a.in[15];
    const float* w_gate = a.in[17]; const float* w_up = a.in[18]; const float* w_down = a.in[19];
    bf16* WinT = (bf16*)(F.ws + WS_WIN); bf16* WoT = (bf16*)(F.ws + WS_WO); bf16* WrT = (bf16*)(F.ws + WS_WR); bf16* WguT = (bf16*)(F.ws + WS_WGU); bf16* WdT = (bf16*)(F.ws + WS_WD);
    bf16* XN = (bf16*)(F.ws + WS_A);
    LAS float* scr = (LAS float*)(F.lds + F.wave * 16640);
    const int gw = F.vcu * NWAVES + F.wave, NGW = F.G * NWAVES;
    constexpr int I_IN = 16 * 56, I_O = 16 * 16, I_G = 64 * 16 * 4, I_D = 64 * 4 * 16, I_R = 512;
    constexpr int NITEMS = I_IN + I_O + 2 * I_G + I_D + I_R;
#ifndef P0_REP_ITEMS
#define P0_REP_ITEMS 1
#endif
#ifndef P0_REP_ROWS
#define P0_REP_ROWS 1
#endif
#ifndef P0_NOITEMS
    for (int rep = 0; rep < P0_REP_ITEMS; ++rep)
    for (int it = gw; it < NITEMS; it += NGW) {
        int r = it;
        if (r < I_IN) { p0_transpose_item(w_in, INC, 64 * (r / 56), 64 * (r % 56), nullptr, WinT, DM, RmIn{}, scr, F.lane); continue; } r -= I_IN;
        if (r < I_O) { p0_transpose_item(w_out, DM, 64 * (r / 16), 64 * (r % 16), nullptr, WoT, DM, RmId{0}, scr, F.lane); continue; } r -= I_O;
        if (r < 2 * I_G) { const int u = r / I_G; r -= u * I_G; const int e = r / 64, q = r % 64;
            p0_transpose_item((u ? w_up : w_gate) + (size_t)e * DM * DE, DE, 64 * (q / 4), 64 * (q % 4), ln2_g, WguT, DM, RmGU{e, u}, scr, F.lane); continue; } r -= 2 * I_G;
        if (r < I_D) { const int e = r / 64, q = r % 64; p0_transpose_item(w_down + (size_t)e * DE * DM, DM, 64 * (q / 16), 64 * (q % 16), nullptr, WdT, DE, RmId{e * DM}, scr, F.lane); continue; } r -= I_D;
        if (r >= 256) {
            r -= 256; unsigned w[8];
#pragma unroll
            for (int j = 0; j < 8; ++j) { float v0 = 0.f, v1 = 0.f; const int k = F.lane * 16 + 2 * j;
                if (r < 32) { v0 = w_in[(size_t)k * INC + PC + (r & 15)]; v1 = w_in[(size_t)(k + 1) * INC + PC + (r & 15)];
                    if (r >= 16) { v0 -= __builtin_bit_cast(float, (unsigned)f2bf(v0) << 16); v1 -= __builtin_bit_cast(float, (unsigned)f2bf(v1) << 16); } }
                w[j] = pk2(v0, v1); }
            u32x4* dp = (u32x4*)(WinT + (size_t)(PC + r) * DM + F.lane * 16);
            dp[0] = (u32x4){w[0], w[1], w[2], w[3]}; dp[1] = (u32x4){w[4], w[5], w[6], w[7]};
            continue; }
        {
            const float* src = nullptr; int ld = 0, col = 0;
            if (r < 32) { src = we_r; ld = 64; col = r; } else if (r >= 128 && r < 160) { src = we_r; ld = 64; col = 32 + (r - 128); } else if (r >= 32 && r < 40) { src = wg_r; ld = 8; col = r - 32; }
            unsigned w[8];
#pragma unroll
            for (int j = 0; j < 8; ++j) { const int k = F.lane * 16 + 2 * j; float v0 = 0.f, v1 = 0.f; if (src) { v0 = src[(size_t)k * ld + col] * ln2_g[k]; v1 = src[(size_t)(k + 1) * ld + col] * ln2_g[k + 1]; } w[j] = pk2(v0, v1); }
            u32x4* dp = (u32x4*)(WrT + (size_t)r * DM + F.lane * 16);
            dp[0] = (u32x4){w[0], w[1], w[2], w[3]}; dp[1] = (u32x4){w[4], w[5], w[6], w[7]};
        }
    }
#endif
#ifndef P0_NOROWS
    {
    f32x4 gq[4];
#pragma unroll
    for (int j = 0; j < 4; ++j) gq[j] = ((const f32x4*)ln1_g + F.lane)[64 * j];
    f32x4 nx[4], ny[4];
    if (gw < NT) { const f32x4* xr = (const f32x4*)(x + (size_t)gw * DM) + F.lane;
#pragma unroll
        for (int j = 0; j < 4; ++j) nx[j] = xr[64 * j]; }
    if (gw + NGW < NT) { const f32x4* xr = (const f32x4*)(x + (size_t)(gw + NGW) * DM) + F.lane;
#pragma unroll
        for (int j = 0; j < 4; ++j) ny[j] = xr[64 * j]; }
    for (int rep = 0; rep < P0_REP_ROWS; ++rep)
    for (int m = gw; m < NT; m += NGW) {
        f32x4 v[4]; float s = 0.f;
#pragma unroll
        for (int j = 0; j < 4; ++j) { v[j] = nx[j]; s += (v[j].x * v[j].x + v[j].y * v[j].y) + (v[j].z * v[j].z + v[j].w * v[j].w); }
#pragma unroll
        for (int j = 0; j < 4; ++j) nx[j] = ny[j];
        if (m + 2 * NGW < NT) { const f32x4* xr = (const f32x4*)(x + (size_t)(m + 2 * NGW) * DM) + F.lane;
#pragma unroll
            for (int j = 0; j < 4; ++j) ny[j] = xr[64 * j]; }
        const float rstd = rsqrtf(wave_sum(s) * (1.f / DM) + EPS);
        unsigned long long* o8 = (unsigned long long*)(XN + (size_t)m * DM) + F.lane;
#pragma unroll
        for (int j = 0; j < 4; ++j) { v[j] = v[j] * rstd * gq[j];
            o8[64 * j] = (unsigned long long)cvt_pk_bf16(v[j].x, v[j].y) | ((unsigned long long)cvt_pk_bf16(v[j].z, v[j].w) << 32); }
    }
    }
#endif
}

constexpr int TB_PRE = 0  , TB_UT = 512  , TB_PT = 1024  , TB_T = 2048  ;
__device__ __forceinline__ void moe_prefixes(const Frame& F) {
    const unsigned* cnt = (const unsigned*)(F.ws + WS_CTL) + CW_CNT; const unsigned* pcnt = (const unsigned*)(F.ws + WS_CTL) + CW_PCNT;
    LAS int* pre = (LAS int*)(F.lds + TAB_OFF + TB_PRE); LAS int* pt = (LAS int*)(F.lds + TAB_OFF + TB_PT);
    if (F.tid < 64) pre[F.tid] = (int)((__hip_atomic_load(cnt + F.tid, RLX_AGENT) + 255u) >> 8);
    else if (F.tid >= 128 && F.tid < 128 + 224) pt[F.tid - 128] = (int)((__hip_atomic_load(pcnt + (F.tid - 128), RLX_AGENT) + 255u) >> 8);
    __syncthreads();
    if (F.tid == 0) { int s = 0; for (int e = 0; e < 64; ++e) { const int t = pre[e]; pre[e] = s; s += t; } pre[64] = s; }
    if (F.tid == 64) { int s = 0; for (int q = 0; q < 224; ++q) { const int t = pt[q]; pt[q] = s; s += t; } pt[224] = s; }
    __syncthreads();
}
__device__ __forceinline__ int moe_setup1(const Frame& F) {
    const unsigned* cnt = (const unsigned*)(F.ws + WS_CTL) + CW_CNT;
    LAS int* pre = (LAS int*)(F.lds + TAB_OFF + TB_PRE); LAS int* pt = (LAS int*)(F.lds + TAB_OFF + TB_PT); LAS int* ut = (LAS int*)(F.lds + TAB_OFF + TB_UT);
    LAS unsigned* t0 = (LAS unsigned*)(F.lds + TAB_OFF + TB_T); LAS float* t1 = (LAS float*)(t0 + 6 * 256); LAS unsigned* t2 = t0 + 12 * 256; LAS float* t3 = (LAS float*)(t0 + 18 * 256);
    const int* bidx = (const int*)(F.ws + WS_BIDX); const float* rstd2 = (const float*)(F.ws + WS_RSTD2); const float* tokg = (const float*)(F.ws + WS_TOKG); const int* tokp = (const int*)(F.ws + WS_TOKP);
    unsigned* r2t = (unsigned*)(F.ws + WS_R2T);
    moe_prefixes(F);
    for (int tok = F.vcu * NTHR + F.tid; tok < NT; tok += F.G * NTHR) { const int tp = tokp[tok]; r2t[256 * pt[(tp >> 16) & 0xff] + (tp & 0xffff)] = (unsigned)tok + 1u; }
    const int total = pre[64] * 2;
    int n = 0; for (int i = 0; i < 6; ++i) if ((long)i * F.G + F.vcu < total) n = i + 1;
    if (F.tid < n) { const int L = F.tid * F.G + F.vcu; const int rtg = L >> 1, pn = L & 1; int e = 0; for (int q = 0; q < 64; ++q) if (pre[q + 1] <= rtg) e = q + 1;
        ut[8 * F.tid] = rtg; ut[8 * F.tid + 1] = pn; ut[8 * F.tid + 2] = e; ut[8 * F.tid + 3] = F.tid; ut[8 * F.tid + 4] = e; }
    __syncthreads();
    { int ts3[3]; bool val3[3]; int tp3[3]; float rs3[3], g3[3];
#pragma unroll
      for (int k = 0; k < 3; ++k) { const int x = F.tid + NTHR * k; ts3[k] = 0; val3[k] = false;
          if (x < n * 256) { const int i = x >> 8, r = x & 255, rtg = ut[8 * i], e = ut[8 * i + 2]; const int idx = (rtg - pre[e]) * 256 + r; const int c = (int)__hip_atomic_load(cnt + e, RLX_AGENT);
              val3[k] = idx < c; ts3[k] = bidx[(size_t)e * 65536 + (val3[k] ? idx : 0)]; } }
#pragma unroll
      for (int k = 0; k < 3; ++k) { const int tok = ts3[k] & 0xffff, slot = ts3[k] >> 16; tp3[k] = tokp[tok]; rs3[k] = rstd2[tok]; g3[k] = tokg[tok * 2 + slot]; }
#pragma unroll
      for (int k = 0; k < 3; ++k) { const int x = F.tid + NTHR * k;
          if (x < n * 256) { const int tok = ts3[k] & 0xffff, slot = ts3[k] >> 16, tp = tp3[k];
              t0[x] = (unsigned)tok * (unsigned)(DM * 2); t1[x] = val3[k] ? rs3[k] : 0.f;
              t2[x] = val3[k] ? (unsigned)(256 * pt[(tp >> 16) & 0xff] + (tp & 0xffff)) * 1024u + (slot == ((tp >> 24) & 1) ? 0u : 512u) : 0xffffffffu;
              t3[x] = g3[k]; } } }
    __syncthreads();
    return n;
}
__device__ __forceinline__ int moe_setup2(const Frame& F) {
    LAS int* pt = (LAS int*)(F.lds + TAB_OFF + TB_PT); LAS int* ut = (LAS int*)(F.lds + TAB_OFF + TB_UT); LAS unsigned* t0 = (LAS unsigned*)(F.lds + TAB_OFF + TB_T);
    const unsigned* r2t = (const unsigned*)(F.ws + WS_R2T);
    moe_prefixes(F);
    const int total = pt[224] * 4;
    int n = 0; for (int i = 0; i < 8; ++i) if ((long)i * F.G + F.vcu < total) n = i + 1;
    if (F.tid < n) { const int L = F.tid * F.G + F.vcu; const int rtg = L >> 2, pn = L & 3; int pb = 0; for (int q = 0; q < 224; ++q) if (pt[q + 1] <= rtg) pb = q + 1;
        const int gs = pb / 28, pi = pb - 28 * gs; int lo = 0; for (int l = 0; l < 7; ++l) if (pi >= (l * (15 - l)) / 2) lo = l; const int hi = lo + 1 + pi - (lo * (15 - lo)) / 2;
        ut[8 * F.tid] = rtg; ut[8 * F.tid + 1] = pn; ut[8 * F.tid + 2] = gs * 8 + lo; ut[8 * F.tid + 3] = F.tid; ut[8 * F.tid + 4] = gs * 8 + hi; }
    __syncthreads();
    { unsigned v4[4];
#pragma unroll
      for (int k = 0; k < 4; ++k) { const int x = F.tid + NTHR * k; v4[k] = 0u; if (x < n * 256) v4[k] = r2t[(size_t)ut[8 * (x >> 8)] * 256 + (x & 255)]; }
#pragma unroll
      for (int k = 0; k < 4; ++k) { const int x = F.tid + NTHR * k; if (x < n * 256) t0[x] = v4[k]; } }
    __syncthreads();
    return n;
}

typedef short v4i16_t __attribute__((ext_vector_type(4)));
constexpr int NA_SLOT = 16384, NA_NSLOT = 9, NA_MRG = NA_NSLOT * NA_SLOT, NA_MRGL = NA_MRG + 8192, NA_BT = NA_MRGL + 1024;
__device__ __forceinline__ int na_swz(int key) { return ((key >> 1) & 3) << 1; }
__device__ __forceinline__ void na_stage_row(const Frame& F, const bf16* pbh, int bandrow) {
    const int key = 8 * F.wave + (F.lane >> 3), c = (F.lane & 7) ^ na_swz(key);
    const bf16* src = pbh + (size_t)(bandrow * GW + key) * PC + c * 8;
    LAS unsigned char* dst = F.lds + (bandrow % NA_NSLOT) * NA_SLOT + F.wave * 1024;
    __builtin_amdgcn_global_load_lds((const unsigned*)(src + C_AK), (LAS unsigned*)dst, 16, 0, 0);
    __builtin_amdgcn_global_load_lds((const unsigned*)(src + C_AV), (LAS unsigned*)(dst + 8192), 16, 0, 0);
}
__device__ __forceinline__ void phase_na(const Frame& F, const Args& a) {
    const bf16* PROJ = (const bf16*)(F.ws + WS_PROJ); bf16* MIX = (bf16*)(F.ws + WS_MIX); const float* rpb = a.in[5];
    const int j = F.wave & 3, bh = F.wave >> 2, g = F.lane >> 4, li = F.lane & 15, c = 16 * j + li;
    const int ks0 = j == 0 ? 0 : (j == 1 ? 8 : (j == 2 ? 24 : 32));
    int c0 = c - KW / 2; c0 = c0 < 0 ? 0 : (c0 > GW - KW ? GW - KW : c0);
    LAS float* bt = (LAS float*)(F.lds + NA_BT);
    for (int unit = F.vcu; unit < BATCH * AH * 2; unit += F.G) {
        const int b = unit >> 4, h = (unit >> 1) & 7, rs = (unit & 1) * 32;
        const bf16* pbh = PROJ + (size_t)b * SEQ * PC + h * ADH;
        float mq = fabsf(a.in[3][F.lane]), mk = fabsf(a.in[4][F.lane]);
#pragma unroll
        for (int o = 1; o < 64; o <<= 1) { mq = fmaxf(mq, __shfl_xor(mq, o)); mk = fmaxf(mk, __shfl_xor(mk, o)); }
        float mb = 0.f; for (int i = F.lane; i < 15 * 31; i += 64) mb = fmaxf(mb, fabsf(rpb[h * 465 + i]));
#pragma unroll
        for (int o = 1; o < 64; o <<= 1) mb = fmaxf(mb, __shfl_xor(mb, o));
        const float cshift = 64.f * 0.125f * LOG2E * mq * mk + mb * LOG2E;
        __syncthreads();
        for (int i = F.tid; i < 15 * 31; i += NTHR) bt[i] = rpb[h * 465 + i] * LOG2E - cshift;
        int r0 = rs - KH / 2; r0 = r0 < 0 ? 0 : (r0 > ROWS - KH ? ROWS - KH : r0);
        for (int i = 0; i < KH; ++i) na_stage_row(F, pbh, r0 + i);
        VM_WAIT(); __syncthreads();
        const int pkey = 8 * F.wave + (F.lane >> 3), pch = (F.lane & 7) ^ na_swz(pkey);
        auto r0_of = [](int r) { int v = r - KH / 2; return v < 0 ? 0 : (v > ROWS - KH ? ROWS - KH : v); };
        u32x4 pk = {0u, 0u, 0u, 0u}, pv = {0u, 0u, 0u, 0u};
        if (rs + 1 < rs + 32 && r0_of(rs + 1) != r0_of(rs)) { const bf16* src = pbh + (size_t)((r0_of(rs + 1) + KH - 1) * GW + pkey) * PC + pch * 8; pk = *(const u32x4*)(src + C_AK); pv = *(const u32x4*)(src + C_AV); }
        float bias[8][4]; int prev_ro = -100;
        bf16x8 qn[2];
#pragma unroll
        for (int ks = 0; ks < 2; ++ks) qn[ks] = *(const bf16x8*)(PROJ + ((size_t)b * SEQ + rs * GW + c) * PC + C_AQ + h * ADH + 32 * ks + 8 * g);
        for (int r = rs; r < rs + 32; ++r) {
            r0 = r - KH / 2; r0 = r0 < 0 ? 0 : (r0 > ROWS - KH ? ROWS - KH : r0);
            if (r + 1 < rs + 32 && r0_of(r + 1) != r0) { LAS unsigned char* dst = F.lds + ((r0_of(r + 1) + KH - 1) % NA_NSLOT) * NA_SLOT + F.wave * 1024 + F.lane * 16;
                *(LAS u32x4*)dst = pk; *(LAS u32x4*)(dst + 8192) = pv; }
            if (r + 2 < rs + 32 && r0_of(r + 2) != r0_of(r + 1)) { const bf16* src = pbh + (size_t)((r0_of(r + 2) + KH - 1) * GW + pkey) * PC + pch * 8; pk = *(const u32x4*)(src + C_AK); pv = *(const u32x4*)(src + C_AV); }
            const int ro = r0 - r + (KH - 1) + 4 * bh;
            if (ro != prev_ro) { prev_ro = ro;
#pragma unroll
                for (int i4 = 0; i4 < 4; ++i4)
#pragma unroll
                    for (int t = 0; t < 2; ++t)
#pragma unroll
                        for (int q = 0; q < 4; ++q) { const int kc = ks0 + 16 * t + 4 * g + q; const bool valid = kc >= c0 && kc < c0 + KW;
                            bias[i4 * 2 + t][q] = valid ? bt[(ro + i4) * 31 + (kc - c + KW - 1)] : -1.0e30f; } }
            const size_t qtok = (size_t)b * SEQ + r * GW + c;
            bf16x8 qf[2]; qf[0] = qn[0]; qf[1] = qn[1];
            { const size_t ntok = qtok + (r + 1 < rs + 32 ? GW : 0);
#pragma unroll
              for (int ks = 0; ks < 2; ++ks) qn[ks] = *(const bf16x8*)(PROJ + ntok * PC + C_AQ + h * ADH + 32 * ks + 8 * g); }
            f32x4 sacc[8];
#pragma unroll
            for (int i4 = 0; i4 < 4; ++i4) { const LAS unsigned char* ks_ = F.lds + ((r0 + 4 * bh + i4) % NA_NSLOT) * NA_SLOT;
#pragma unroll
                for (int t = 0; t < 2; ++t) { const int row = ks0 + 16 * t + li; f32x4 acc = {bias[i4 * 2 + t][0], bias[i4 * 2 + t][1], bias[i4 * 2 + t][2], bias[i4 * 2 + t][3]};
#pragma unroll
                    for (int ks = 0; ks < 2; ++ks) { const bf16x8 kf = *(const LAS bf16x8*)(ks_ + row * 128 + (((g + 4 * ks) ^ na_swz(row)) << 4));
                        acc = __builtin_amdgcn_mfma_f32_16x16x32_bf16(kf, qf[ks], acc, 0, 0, 0); }
                    sacc[i4 * 2 + t] = acc; } }
            f32x2_t ls2 = {0.f, 0.f};
#pragma unroll
            for (int x = 0; x < 8; ++x) {
#pragma unroll
                for (int q = 0; q < 4; ++q) sacc[x][q] = __builtin_amdgcn_exp2f(sacc[x][q]);
                ls2 += (f32x2_t){sacc[x][0], sacc[x][1]}; ls2 += (f32x2_t){sacc[x][2], sacc[x][3]}; }
            float lsum = ls2[0] + ls2[1];
            f32x4 oacc[4];
#pragma unroll
            for (int dt = 0; dt < 4; ++dt) oacc[dt] = (f32x4){0.f, 0.f, 0.f, 0.f};
#pragma unroll
            for (int m = 0; m < 4; ++m) {
                const int xa = 2 * m, xb = 2 * m + 1;
                bf16x8 pf; { const unsigned w0 = cvt_pk_bf16(sacc[xa][0], sacc[xa][1]), w1 = cvt_pk_bf16(sacc[xa][2], sacc[xa][3]), w2 = cvt_pk_bf16(sacc[xb][0], sacc[xb][1]), w3 = cvt_pk_bf16(sacc[xb][2], sacc[xb][3]);
                    pf = __builtin_bit_cast(bf16x8, (u32x4){w0, w1, w2, w3}); }
                const LAS unsigned char* va = F.lds + ((r0 + 4 * bh + m) % NA_NSLOT) * NA_SLOT + 8192; const LAS unsigned char* vb = va;
                const int rowa = ks0 + 4 * g + (li >> 2), rowb = ks0 + 16 + 4 * g + (li >> 2);
#pragma unroll
                for (int dt = 0; dt < 4; ++dt) { const int cc = 2 * dt + ((li & 3) >> 1), hb = (li & 1) * 8;
                    const v4i16_t ta = __builtin_amdgcn_ds_read_tr16_b64_v4i16((LAS v4i16_t*)(va + rowa * 128 + ((cc ^ na_swz(rowa)) << 4) + hb));
                    const v4i16_t tb = __builtin_amdgcn_ds_read_tr16_b64_v4i16((LAS v4i16_t*)(vb + rowb * 128 + ((cc ^ na_swz(rowb)) << 4) + hb));
                    bf16x8 vf; vf[0] = ta[0]; vf[1] = ta[1]; vf[2] = ta[2]; vf[3] = ta[3]; vf[4] = tb[0]; vf[5] = tb[1]; vf[6] = tb[2]; vf[7] = tb[3];
                    oacc[dt] = __builtin_amdgcn_mfma_f32_16x16x32_bf16(vf, pf, oacc[dt], 0, 0, 0); }
            }
            LAS unsigned char* mrg = F.lds + NA_MRG + (j * 64 + F.lane) * 32; LAS float* mrl = (LAS float*)(F.lds + NA_MRGL) + j * 64 + F.lane;
            if (bh == 1) {
                u32x4 w0, w1; w0.x = cvt_pk_bf16(oacc[0][0], oacc[0][1]); w0.y = cvt_pk_bf16(oacc[0][2], oacc[0][3]); w0.z = cvt_pk_bf16(oacc[1][0], oacc[1][1]); w0.w = cvt_pk_bf16(oacc[1][2], oacc[1][3]);
                w1.x = cvt_pk_bf16(oacc[2][0], oacc[2][1]); w1.y = cvt_pk_bf16(oacc[2][2], oacc[2][3]); w1.z = cvt_pk_bf16(oacc[3][0], oacc[3][1]); w1.w = cvt_pk_bf16(oacc[3][2], oacc[3][3]);
                *(LAS u32x4*)mrg = w0; *(LAS u32x4*)(mrg + 16) = w1; *mrl = lsum;
            }
            LDS_BAR();
            if (bh == 0) {
                const u32x4 w0 = *(const LAS u32x4*)mrg, w1 = *(const LAS u32x4*)(mrg + 16); lsum += *mrl;
                lsum += __shfl_xor(lsum, 16); lsum += __shfl_xor(lsum, 32);
                const float inv = 1.f / lsum;
                bf16* op = MIX + qtok * DM + h * ADH + 4 * g;
#pragma unroll
                for (int dt = 0; dt < 4; ++dt) { const unsigned pa = dt < 2 ? (dt == 0 ? w0.x : w0.z) : (dt == 2 ? w1.x : w1.z), pb = dt < 2 ? (dt == 0 ? w0.y : w0.w) : (dt == 2 ? w1.y : w1.w);
                    const float o0 = (oacc[dt][0] + __builtin_bit_cast(float, pa << 16)) * inv, o1 = (oacc[dt][1] + __builtin_bit_cast(float, pa & 0xffff0000u)) * inv;
                    const float o2 = (oacc[dt][2] + __builtin_bit_cast(float, pb << 16)) * inv, o3 = (oacc[dt][3] + __builtin_bit_cast(float, pb & 0xffff0000u)) * inv;
                    *(unsigned long long*)(op + 16 * dt) = (unsigned long long)cvt_pk_bf16(o0, o1) | ((unsigned long long)cvt_pk_bf16(o2, o3) << 32); }
            }
            LDS_BAR();
        }
    }
}


typedef float f32x16 __attribute__((ext_vector_type(16)));
constexpr size_t WS_GCL = WS_G, WS_BETAL = WS_BETA;
constexpr int P3_QN = 0, P3_KN = 16384, P3_LF = 32768, P3_LB = P3_LF + 17408, P3_TF = P3_LB + 17408, P3_TB = P3_TF + 17408, P3_CW = P3_TB + 17408, P3_SC = P3_CW + 7680, P3_RAW = P3_SC + 1024, LST = 68;
__device__ __forceinline__ unsigned off_b(unsigned row, unsigned ch) { return 256u * row + 16u * (ch ^ (((row & 3) << 2) | ((row >> 2) & 3))); }
__device__ __forceinline__ unsigned rowread_b(unsigned lane, unsigned rowbase, unsigned s) { return off_b(rowbase + (lane & 31), 2 * s + (lane >> 5)); }
__device__ __forceinline__ void dn_inverse(LAS float* LS, LAS float* TS, int lane) {
    for (int i = lane; i < 64 * LST / 4; i += 64) ((LAS f32x4*)TS)[i] = (f32x4){0.f, 0.f, 0.f, 0.f};
    { const int blk = lane >> 4, col = lane & 15; float xa[16];
#pragma unroll
      for (int i = 0; i < 16; ++i) xa[i] = (i == col) ? 1.f : 0.f;
#pragma unroll
      for (int k = 0; k < 16; ++k) { const float xk = xa[k]; TS[(16 * blk + k) * LST + 16 * blk + col] = xk;
#pragma unroll
          for (int i = k + 1; i < 16; ++i) xa[i] -= LS[(16 * blk + i) * LST + 16 * blk + k] * xk; } }
    __builtin_amdgcn_sched_barrier(0);
#pragma unroll
    for (int p = 0; p < 2; ++p) { const int base = 32 * p, r = lane & 15, kq = lane >> 4;
        float a1[4], b1[4];
#pragma unroll
        for (int s4 = 0; s4 < 4; ++s4) { a1[s4] = LS[(base + 16 + r) * LST + base + kq + 4 * s4]; b1[s4] = TS[(base + kq + 4 * s4) * LST + base + r]; }
        const f32x4 a2 = *(const LAS f32x4*)(TS + (base + 16 + r) * LST + base + 16 + 4 * kq);
        __builtin_amdgcn_sched_barrier(0);
        f32x4 M = {0.f, 0.f, 0.f, 0.f};
#pragma unroll
        for (int s4 = 0; s4 < 4; ++s4) M = __builtin_amdgcn_mfma_f32_16x16x4f32(a1[s4], b1[s4], M, 0, 0, 0);
        f32x4 R = {0.f, 0.f, 0.f, 0.f};
#pragma unroll
        for (int s4 = 0; s4 < 4; ++s4) R = __builtin_amdgcn_mfma_f32_16x16x4f32(a2[s4], M[s4], R, 0, 0, 0);
#pragma unroll
        for (int e = 0; e < 4; ++e) TS[(base + 16 + 4 * kq + e) * LST + base + r] = -R[e]; }
    __builtin_amdgcn_sched_barrier(0);
    { const int r = lane & 31, kh = lane >> 5;
      bf16x8 a1[2], b1[2], a2[2];
#pragma unroll
      for (int sx = 0; sx < 2; ++sx) {
          const f32x4 l0 = *(const LAS f32x4*)(LS + (32 + r) * LST + 16 * sx + 8 * kh), l1 = *(const LAS f32x4*)(LS + (32 + r) * LST + 16 * sx + 8 * kh + 4);
          a1[sx] = __builtin_bit_cast(bf16x8, (u32x4){cvt_pk_bf16(l0[0], l0[1]), cvt_pk_bf16(l0[2], l0[3]), cvt_pk_bf16(l1[0], l1[1]), cvt_pk_bf16(l1[2], l1[3])});
          float tb[8];
#pragma unroll
          for (int j = 0; j < 8; ++j) tb[j] = TS[(16 * sx + 8 * kh + j) * LST + r];
          b1[sx] = __builtin_bit_cast(bf16x8, (u32x4){cvt_pk_bf16(tb[0], tb[1]), cvt_pk_bf16(tb[2], tb[3]), cvt_pk_bf16(tb[4], tb[5]), cvt_pk_bf16(tb[6], tb[7])});
          const f32x4 t0 = *(const LAS f32x4*)(TS + (32 + r) * LST + 32 + 16 * sx + 4 * kh), t1 = *(const LAS f32x4*)(TS + (32 + r) * LST + 32 + 16 * sx + 8 + 4 * kh);
          a2[sx] = __builtin_bit_cast(bf16x8, (u32x4){cvt_pk_bf16(t0[0], t0[1]), cvt_pk_bf16(t0[2], t0[3]), cvt_pk_bf16(t1[0], t1[1]), cvt_pk_bf16(t1[2], t1[3])}); }
      __builtin_amdgcn_sched_barrier(0);
      f32x16 M;
#pragma unroll
      for (int e = 0; e < 16; ++e) M[e] = 0.f;
#pragma unroll
      for (int sx = 0; sx < 2; ++sx) M = __builtin_amdgcn_mfma_f32_32x32x16_bf16(a1[sx], b1[sx], M, 0, 0, 0);
      f32x16 R;
#pragma unroll
      for (int e = 0; e < 16; ++e) R[e] = 0.f;
#pragma unroll
      for (int sx = 0; sx < 2; ++sx) { const bf16x8 mb = __builtin_bit_cast(bf16x8, (u32x4){cvt_pk_bf16(M[8 * sx], M[8 * sx + 1]), cvt_pk_bf16(M[8 * sx + 2], M[8 * sx + 3]), cvt_pk_bf16(M[8 * sx + 4], M[8 * sx + 5]), cvt_pk_bf16(M[8 * sx + 6], M[8 * sx + 7])});
          R = __builtin_amdgcn_mfma_f32_32x32x16_bf16(a2[sx], mb, R, 0, 0, 0); }
#pragma unroll
      for (int e = 0; e < 16; ++e) TS[(32 + (e & 3) + 8 * (e >> 2) + 4 * kh) * LST + r] = -R[e]; }
}
__device__ __forceinline__ void phase_dnprep(const Frame& F, const Args& a) {
    const bf16* PROJ = (const bf16*)(F.ws + WS_PROJ); bf16* QKVN = (bf16*)a.out; bf16* TQK = (bf16*)(F.ws + WS_TQK);
    const float* DABp = (const float*)(F.ws + WS_DAB); const float* a_log = a.in[8]; const float* dt_bias = a.in[9]; float* GCL = (float*)(F.ws + WS_GCL); float* BETAL = (float*)(F.ws + WS_BETAL);
    const float* conv_w = a.in[7];
    LAS float* CW = (LAS float*)(F.lds + P3_CW); LAS float* SC = (LAS float*)(F.lds + P3_SC);
    LAS float* LFp = (LAS float*)(F.lds + P3_LF); LAS float* LBp = (LAS float*)(F.lds + P3_LB); LAS float* TFp = (LAS float*)(F.lds + P3_TF); LAS float* TBp = (LAS float*)(F.lds + P3_TB);
    const int hh = F.lane >> 5;
    static_assert(P3_RAW + 68 * 768 <= LDSCTL_OFF, "P3 LDS map");
    const bf16* zsrc = (const bf16*)(F.ws + WS_CTL + 900 * 1024);
    auto stage_raw = [&](int un) { const int tc_ = un & 63, h_ = (un >> 6) & 3, b_ = un >> 8, t0_ = tc_ * 64;
        for (int p = F.wave; p < 51; p += 8) { const int c = 64 * p + F.lane, row = c / 48, cc = c - 48 * row, tt = t0_ - 2 + row;
            const bf16* src = (tt >= 0 && tt < SEQ) ? PROJ + ((size_t)b_ * SEQ + tt) * PC + C_DQ + (cc >> 4) * 512 + h_ * 128 + (cc & 15) * 8 : zsrc;
            __builtin_amdgcn_global_load_lds((const unsigned*)src, (LAS unsigned*)(F.lds + P3_RAW + p * 1024), 16, 0, 0); } };
    const int unit0 = F.vcu * 16, unit_end = (unit0 + 16 < BATCH * DH * 64) ? unit0 + 16 : BATCH * DH * 64;
    if (unit0 >= unit_end) return;
    { const int h = (unit0 >> 6) & 3;
      for (int i = F.tid; i < 3 * 5 * 128; i += NTHR) { const int part = i / 640, tap = (i / 128) % 5, ch = i & 127; CW[i] = conv_w[tap * 1536 + part * 512 + h * 128 + ch]; } }
    stage_raw(unit0);
    float* GCR = (float*)(F.ws + WS_GCR); float* EDLp = (float*)(F.ws + WS_EDL);
    { float pa[4], pb[4];
#pragma unroll
      for (int q4 = 0; q4 < 4; ++q4) { const int q = F.wave + 8 * q4, un = unit0 + (q >> 1), dir = q & 1, tl = dir ? 63 - F.lane : F.lane; pa[q4] = 0.f; pb[q4] = 0.f;
          if (un < unit_end) { const float* dp = DABp + ((size_t)(un >> 8) * SEQ + (un & 63) * 64 + tl) * 16 + dir * 4 + ((un >> 6) & 3); pa[q4] = dp[0]; pb[q4] = dp[8]; } }
#pragma unroll
      for (int q4 = 0; q4 < 4; ++q4) { const int q = F.wave + 8 * q4, un = unit0 + (q >> 1), dir = q & 1, h_ = (un >> 6) & 3, b_ = un >> 8, t0_ = (un & 63) * 64; const size_t go = (((size_t)dir * BATCH + b_) * DH + h_) * SEQ + t0_ + F.lane;
          float gv = -__expf(a_log[dir * 4 + h_]) * softplus_f(pa[q4] + dt_bias[dir * 4 + h_]); const float bv = sigmoid_f(pb[q4]);
#pragma unroll
          for (int o = 1; o < 64; o <<= 1) { const float t = __shfl_up(gv, o); if (F.lane >= o) gv += t; }
          const float glv = __builtin_bit_cast(float, __builtin_amdgcn_readlane(__builtin_bit_cast(int, gv), 63));
          if (un < unit_end) { GCR[go] = gv; GCL[go] = __expf(gv); EDLp[go] = __expf(glv - gv); BETAL[go] = bv; } }
      VM_WAIT(); __syncthreads(); }
    for (int unit = unit0; unit < unit_end; ++unit) {
        const int tc = unit & 63, h = (unit >> 6) & 3, b = unit >> 8, t0 = tc * 64; const size_t tokb = (size_t)b * SEQ + t0;
        if (unit == unit0) VM_WAIT(); else asm volatile("s_waitcnt vmcnt(10)" ::: "memory");
        LDS_BAR();
        if (F.wave == 2) { const size_t gf = (((size_t)b) * DH + h) * SEQ + t0 + F.lane, gb = (((size_t)BATCH + b) * DH + h) * SEQ + t0 + F.lane;
            __builtin_amdgcn_global_load_lds((const unsigned*)(GCR + gf), (LAS unsigned*)(F.lds + P3_SC), 4, 0, 0); __builtin_amdgcn_global_load_lds((const unsigned*)(GCR + gb), (LAS unsigned*)(F.lds + P3_SC + 256), 4, 0, 0);
            __builtin_amdgcn_global_load_lds((const unsigned*)(BETAL + gf), (LAS unsigned*)(F.lds + P3_SC + 512), 4, 0, 0); __builtin_amdgcn_global_load_lds((const unsigned*)(BETAL + gb), (LAS unsigned*)(F.lds + P3_SC + 768), 4, 0, 0);
            asm volatile("" ::: "memory"); }
        { const int tl2 = F.lane >> 4, cg = F.lane & 15, tk = 8 * F.wave + 2 * tl2;
#ifndef P3_REP_CONV
#define P3_REP_CONV 1
#endif
          u32x4 rawall[3][6];
#pragma unroll
          for (int part = 0; part < 3; ++part)
#pragma unroll
              for (int rr = 0; rr < 6; ++rr) rawall[part][rr] = *(const LAS u32x4*)(F.lds + P3_RAW + (tk + rr) * 768 + part * 256 + cg * 16);
          LDS_BAR();
          if (unit + 1 < unit_end) stage_raw(unit + 1);
          asm volatile("" ::: "memory");
#pragma unroll
          for (int part = 0; part < 3; ++part) {
              u32x4 rawp[6];
#pragma unroll
              for (int rr = 0; rr < 6; ++rr) rawp[rr] = rawall[part][rr];
              float o[2][8];
#pragma unroll
              for (int e2 = 0; e2 < 4; ++e2) {
                  float lo[6], hi[6];
#pragma unroll
                  for (int rr = 0; rr < 6; ++rr) { lo[rr] = __builtin_bit_cast(float, rawp[rr][e2] << 16); hi[rr] = __builtin_bit_cast(float, rawp[rr][e2] & 0xffff0000u); }
                  float a0 = 0.f, a1 = 0.f, b0 = 0.f, b1 = 0.f;
#pragma unroll
                  for (int tap = 0; tap < 5; ++tap) { const f32x2_t w01 = *(const LAS f32x2_t*)(CW + (part * 5 + tap) * 128 + 8 * cg + 2 * e2); const float w0 = w01[0], w1 = w01[1];
                      a0 += lo[tap] * w0; a1 += hi[tap] * w1; b0 += lo[tap + 1] * w0; b1 += hi[tap + 1] * w1; }
                  o[0][2 * e2] = a0; o[0][2 * e2 + 1] = a1; o[1][2 * e2] = b0; o[1][2 * e2 + 1] = b1;
                  __builtin_amdgcn_sched_barrier(0); }
#pragma unroll
              for (int u = 0; u < 2; ++u) { float ss = 0.f;
#pragma unroll
                  for (int e = 0; e < 8; ++e) { const float x = o[u][e]; const float y = x * __builtin_amdgcn_rcpf(1.f + __expf(-x)); o[u][e] = y; ss += y * y; }
                  if (part < 2) { ss = row16_sum(ss);
                      const float sc = rsqrtf(ss + EPS) * (part == 0 ? 0.08838834764831845f : 1.f);
#pragma unroll
                      for (int e = 0; e < 8; ++e) o[u][e] *= sc; }
                  u32x4 w; w.x = cvt_pk_bf16(o[u][0], o[u][1]); w.y = cvt_pk_bf16(o[u][2], o[u][3]); w.z = cvt_pk_bf16(o[u][4], o[u][5]); w.w = cvt_pk_bf16(o[u][6], o[u][7]);
                  *(u32x4*)(QKVN + ((size_t)((b * 4 + h) * 3 + part) * SEQ + t0 + tk + u) * 128 + 8 * cg) = w;
                  if (part < 2) *(LAS u32x4*)(F.lds + (part == 0 ? P3_QN : P3_KN) + off_b(tk + u, cg)) = w; }
              __builtin_amdgcn_sched_barrier(0);
          } }
        LDS_BAR();
        { const int mat = F.wave >> 2, ti = (F.wave >> 1) & 1, tj = F.wave & 1;
          f32x16 acc;
#pragma unroll
          for (int e = 0; e < 16; ++e) acc[e] = 0.f;
#pragma unroll
          for (int s8 = 0; s8 < 8; ++s8) { const bf16x8 af = *(const LAS bf16x8*)(F.lds + (mat ? P3_QN : P3_KN) + rowread_b(F.lane, 32 * ti, s8)), bfr = *(const LAS bf16x8*)(F.lds + P3_KN + rowread_b(F.lane, 32 * tj, s8));
              acc = __builtin_amdgcn_mfma_f32_32x32x16_bf16(af, bfr, acc, 0, 0, 0); }
          LAS float* dstp = (mat ? TBp : TFp) + 32 * tj + (F.lane & 31);
#pragma unroll
          for (int e = 0; e < 16; ++e) dstp[(32 * ti + (e & 3) + 8 * (e >> 2) + 4 * hh) * LST] = acc[e]; }
        if (F.wave == 2) { if (unit + 1 < unit_end) asm volatile("s_waitcnt vmcnt(13)" ::: "memory"); else asm volatile("s_waitcnt vmcnt(6)" ::: "memory"); }
        LDS_BAR();
        { const int i = F.tid >> 3, c8 = F.tid & 7, ir = 63 - i;
          const float gfi = SC[i], gbi = SC[64 + ir], bfi = SC[128 + i], bbi = SC[192 + ir];
          const f32x4 g0 = *(const LAS f32x4*)(TFp + i * LST + 8 * c8), g1 = *(const LAS f32x4*)(TFp + i * LST + 8 * c8 + 4), p0 = *(const LAS f32x4*)(TBp + i * LST + 8 * c8), p1 = *(const LAS f32x4*)(TBp + i * LST + 8 * c8 + 4);
          const f32x4 cf0 = *(const LAS f32x4*)(SC + 8 * c8), cf1 = *(const LAS f32x4*)(SC + 8 * c8 + 4), cb0 = *(const LAS f32x4*)(SC + 120 - 8 * c8), cb1 = *(const LAS f32x4*)(SC + 124 - 8 * c8);
          float lf[8], lb[8], qf[8], qb[8];
#pragma unroll
          for (int e = 0; e < 8; ++e) { const int j = 8 * c8 + e; const float gv = e < 4 ? g0[e] : g1[e - 4], pv = e < 4 ? p0[e] : p1[e - 4];
              const float df = __expf(gfi - (e < 4 ? cf0[e] : cf1[e - 4])), db = __expf(gbi - (e < 4 ? cb1[3 - e] : cb0[7 - e]));
              lf[e] = i > j ? bfi * gv * df : 0.f; lb[7 - e] = i < j ? bbi * gv * db : 0.f; qf[e] = i >= j ? pv * df : 0.f; qb[7 - e] = i <= j ? pv * db : 0.f; }
          *(LAS f32x4*)(LFp + i * LST + 8 * c8) = (f32x4){lf[0], lf[1], lf[2], lf[3]}; *(LAS f32x4*)(LFp + i * LST + 8 * c8 + 4) = (f32x4){lf[4], lf[5], lf[6], lf[7]};
          *(LAS f32x4*)(LBp + ir * LST + 56 - 8 * c8) = (f32x4){lb[0], lb[1], lb[2], lb[3]}; *(LAS f32x4*)(LBp + ir * LST + 60 - 8 * c8) = (f32x4){lb[4], lb[5], lb[6], lb[7]};
          u32x4 wf, wb; wf.x = cvt_pk_bf16(qf[0], qf[1]); wf.y = cvt_pk_bf16(qf[2], qf[3]); wf.z = cvt_pk_bf16(qf[4], qf[5]); wf.w = cvt_pk_bf16(qf[6], qf[7]);
          wb.x = cvt_pk_bf16(qb[0], qb[1]); wb.y = cvt_pk_bf16(qb[2], qb[3]); wb.z = cvt_pk_bf16(qb[4], qb[5]); wb.w = cvt_pk_bf16(qb[6], qb[7]);
          *(u32x4*)(TQK + ((size_t)unit * 4 + 1) * 4096 + i * 64 + 8 * c8) = wf; *(u32x4*)(TQK + ((size_t)unit * 4 + 3) * 4096 + ir * 64 + 56 - 8 * c8) = wb; }
        LDS_BAR();
#ifndef P3_REP_INV
#define P3_REP_INV 1
#endif
        for (int rep = 0; rep < P3_REP_INV; ++rep) if (F.wave < 2) dn_inverse(F.wave ? LBp : LFp, F.wave ? TBp : TFp, F.lane);
        LDS_BAR();
        for (int it = F.tid; it < 1024; it += NTHR) { const int m = it >> 9, i = (it >> 3) & 63, c8 = it & 7; const LAS float* tp = (m ? TBp : TFp) + i * LST + 8 * c8;
            const f32x4 x0 = *(const LAS f32x4*)tp, x1 = *(const LAS f32x4*)(tp + 4);
            u32x4 w; w.x = cvt_pk_bf16(x0[0], x0[1]); w.y = cvt_pk_bf16(x0[2], x0[3]); w.z = cvt_pk_bf16(x1[0], x1[1]); w.w = cvt_pk_bf16(x1[2], x1[3]);
            *(u32x4*)(TQK + ((size_t)unit * 4 + 2 * m) * 4096 + i * 64 + 8 * c8) = w;
            }
    }
}
constexpr int P4_BUF = 57344, P4_KN = 0, P4_QN = 16384, P4_VN = 32768, P4_T = 40960, P4_QK = 49152, P4_ST = 114688, P4_RT = 131072, P4_VNT = 139264, P4_VDT = 147456, P4_SC = 155648;
__device__ __forceinline__ unsigned off_s(unsigned row, unsigned ch) { return 128u * row + (((ch ^ ((row >> 1) & 7u))) << 4); }
__device__ __forceinline__ unsigned rowread_s(unsigned lane, unsigned rowbase, unsigned s) { return off_s(rowbase + (lane & 31), 2 * s + (lane >> 5)); }
__device__ __forceinline__ void p4_stage(const Frame& F, const bf16* QKVN, const bf16* TQK, const float* GCL, const float* BETAL, int b, int h, int dir, int dvh, int n, int buf) {
    const int tc = dir ? 63 - n : n, t0 = tc * 64; const size_t tokb = (size_t)t0, pl0 = (size_t)((b * 4 + h) * 3) * SEQ; const size_t u3 = (size_t)((b * 4 + h) * 64 + tc);
    LAS unsigned char* B = F.lds + buf * P4_BUF; const int L = F.lane, w = F.wave;
    {
#pragma unroll
      for (int k = 0; k < 2; ++k) { const int q = w + 8 * k, row = 4 * q + (L >> 4), pos = L & 15, ch = pos ^ (((row & 3) << 2) | ((row >> 2) & 3)); const size_t tok = tokb + (dir ? 63 - row : row);
          __builtin_amdgcn_global_load_lds((const unsigned*)(QKVN + (pl0 + SEQ + tok) * 128 + ch * 8), (LAS unsigned*)(B + P4_KN + q * 1024), 16, 0, 0);
          __builtin_amdgcn_global_load_lds((const unsigned*)(QKVN + (pl0 + tok) * 128 + ch * 8), (LAS unsigned*)(B + P4_QN + q * 1024), 16, 0, 0); } }
    { const int row = 8 * w + (L >> 3), pos = L & 7, chs = pos ^ ((row >> 1) & 7); const size_t tok = tokb + (dir ? 63 - row : row);
      __builtin_amdgcn_global_load_lds((const unsigned*)(QKVN + (pl0 + 2 * SEQ + tok) * 128 + dvh * 64 + pos * 8), (LAS unsigned*)(B + P4_VN + w * 1024), 16, 0, 0);
      __builtin_amdgcn_global_load_lds((const unsigned*)(TQK + (u3 * 4 + 2 * dir) * 4096 + row * 64 + chs * 8), (LAS unsigned*)(B + P4_T + w * 1024), 16, 0, 0);
      __builtin_amdgcn_global_load_lds((const unsigned*)(TQK + (u3 * 4 + 2 * dir + 1) * 4096 + row * 64 + chs * 8), (LAS unsigned*)(B + P4_QK + w * 1024), 16, 0, 0); }
    if (w == 0) { const size_t go = (((size_t)dir * BATCH + b) * DH + h) * SEQ + t0; LAS unsigned char* sc = F.lds + P4_SC + buf * 1024;
        __builtin_amdgcn_global_load_lds((const unsigned*)(GCL + go + L), (LAS unsigned*)sc, 4, 0, 0); __builtin_amdgcn_global_load_lds((const unsigned*)(BETAL + go + L), (LAS unsigned*)(sc + 256), 4, 0, 0);
        __builtin_amdgcn_global_load_lds((const unsigned*)((const float*)(F.ws + WS_EDL) + go + L), (LAS unsigned*)(sc + 512), 4, 0, 0); }
}
__device__ __forceinline__ void phase_dnscan(const Frame& F, const Args& a) {
    const bf16* QKVN = (const bf16*)a.out; const bf16* TQK = (const bf16*)(F.ws + WS_TQK); const float* GCL = (const float*)(F.ws + WS_GCL); const float* BETAL = (const float*)(F.ws + WS_BETAL);
    bf16* O = (bf16*)(F.ws + WS_A);
    const int w = F.wave, L = F.lane, hh = L >> 5, l31 = L & 31;
    const int mat = w >> 2, ti = (w >> 1) & 1, tj = w & 1, kt = w >> 1, nt = w & 1;
    for (int unit = F.vcu; unit < BATCH * DH * 4; unit += F.G) {
        const int dvh = unit & 1, dir = (unit >> 1) & 1, h = (unit >> 2) & 3, b = unit >> 4;
        __syncthreads();
        for (int i = F.tid; i < 16384 / 16; i += NTHR) ((LAS u32x4*)(F.lds + P4_ST))[i] = (u32x4){0u, 0u, 0u, 0u};
        p4_stage(F, QKVN, TQK, GCL, BETAL, b, h, dir, dvh, 0, 0);
        f32x16 sacc;
#pragma unroll
        for (int e = 0; e < 16; ++e) sacc[e] = 0.f;
        VM_WAIT(); __syncthreads();
        f32x16 accO; bf16x8 oqk[4], ovn[4];
#pragma unroll
        for (int e = 0; e < 16; ++e) accO[e] = 0.f;
#pragma unroll
        for (int s4 = 0; s4 < 4; ++s4) { oqk[s4] = (bf16x8){0, 0, 0, 0, 0, 0, 0, 0}; ovn[s4] = (bf16x8){0, 0, 0, 0, 0, 0, 0, 0}; }
        auto finish_o = [&](int nprev) {
#pragma unroll
            for (int s4 = 0; s4 < 4; ++s4) accO = __builtin_amdgcn_mfma_f32_32x32x16_bf16(oqk[s4], ovn[s4], accO, 0, 0, 0);
            unsigned dwv = DW, i0v = 32 * ti + 4 * hh; asm volatile("" : "+v"(dwv), "+v"(i0v));
            const int tc = dir ? 63 - nprev : nprev; bf16* op = O + ((size_t)dir * NT + (size_t)b * SEQ + tc * 64) * DW + h * 128 + dvh * 64 + 32 * tj + l31;
#pragma unroll
            for (int e = 0; e < 16; ++e) { const int i = (int)i0v + (e & 3) + 8 * (e >> 2); op[(unsigned)(dir ? 63 - i : i) * dwv] = f2bf(accO[e]); } };
        for (int n = 0; n < 64; ++n) {
            const int cb = n & 1; const LAS unsigned char* B = F.lds + cb * P4_BUF; const LAS float* sc = (const LAS float*)(F.lds + P4_SC + cb * 1024);
            if (n + 1 < 64) p4_stage(F, QKVN, TQK, GCL, BETAL, b, h, dir, dvh, n + 1, cb ^ 1);
            f32x16 acc1;
#pragma unroll
            for (int e = 0; e < 16; ++e) acc1[e] = 0.f;
#pragma unroll
            for (int hb = 0; hb < 2; ++hb) { bf16x8 fa[4], fb[4];
#pragma unroll
              for (int s4 = 0; s4 < 4; ++s4) { const int s8 = 4 * hb + s4; fa[s4] = *(const LAS bf16x8*)(B + (mat ? P4_QN : P4_KN) + rowread_b(L, 32 * ti, s8)); fb[s4] = *(const LAS bf16x8*)(F.lds + P4_ST + rowread_b(L, 32 * tj, s8)); }
              __builtin_amdgcn_sched_barrier(0);
#pragma unroll
              for (int s4 = 0; s4 < 4; ++s4) acc1 = __builtin_amdgcn_mfma_f32_32x32x16_bf16(fa[s4], fb[s4], acc1, 0, 0, 0);
              __builtin_amdgcn_sched_barrier(0); }
            const int ncol = 32 * tj + l31;
            if (mat == 0) {
                bf16 vraw[16];
#pragma unroll
                for (int e = 0; e < 16; ++e) vraw[e] = *(const LAS bf16*)(B + P4_VN + (32 * ti + 8 * (e >> 2) + 4 * hh + (e & 3)) * 128 + ncol * 2);
                __builtin_amdgcn_sched_barrier(0);
#pragma unroll
                for (int rg = 0; rg < 4; ++rg) { float r4[4];
#pragma unroll
                    for (int q = 0; q < 4; ++q) { const int i = 32 * ti + 8 * rg + 4 * hh + q; const float vv = bf2f(vraw[4 * rg + q]);
                        r4[q] = sc[64 + i] * (vv - sc[i] * acc1[4 * rg + q]); }
                    *(LAS unsigned long long*)(F.lds + P4_RT + off_s(ncol, 4 * ti + rg) + 8 * hh) = (unsigned long long)cvt_pk_bf16(r4[0], r4[1]) | ((unsigned long long)cvt_pk_bf16(r4[2], r4[3]) << 32); }
            } else {
#pragma unroll
                for (int e = 0; e < 16; ++e) { const int i = 32 * ti + (e & 3) + 8 * (e >> 2) + 4 * hh; acc1[e] *= sc[i]; }
            }
            LDS_BAR();
            if (mat == 0) {
                f32x16 va;
#pragma unroll
                for (int e = 0; e < 16; ++e) va[e] = 0.f;
                { bf16x8 fa[4], fb[4];
#pragma unroll
                  for (int s4 = 0; s4 < 4; ++s4) { fa[s4] = *(const LAS bf16x8*)(B + P4_T + rowread_s(L, 32 * ti, s4)); fb[s4] = *(const LAS bf16x8*)(F.lds + P4_RT + rowread_s(L, 32 * tj, s4)); }
                  __builtin_amdgcn_sched_barrier(0);
#pragma unroll
                  for (int s4 = 0; s4 < 4; ++s4) va = __builtin_amdgcn_mfma_f32_32x32x16_bf16(fa[s4], fb[s4], va, 0, 0, 0); }
#pragma unroll
                for (int rg = 0; rg < 4; ++rg) { float d4[4];
#pragma unroll
                    for (int q = 0; q < 4; ++q) d4[q] = va[4 * rg + q] * sc[128 + 32 * ti + 8 * rg + 4 * hh + q];
                    const unsigned o8 = off_s(ncol, 4 * ti + rg) + 8 * hh;
                    *(LAS unsigned long long*)(F.lds + P4_VNT + o8) = (unsigned long long)cvt_pk_bf16(va[4 * rg], va[4 * rg + 1]) | ((unsigned long long)cvt_pk_bf16(va[4 * rg + 2], va[4 * rg + 3]) << 32);
                    *(LAS unsigned long long*)(F.lds + P4_VDT + o8) = (unsigned long long)cvt_pk_bf16(d4[0], d4[1]) | ((unsigned long long)cvt_pk_bf16(d4[2], d4[3]) << 32); }
            } else if (n > 0) finish_o(n - 1);
            LDS_BAR();
            if (mat == 1) {
#pragma unroll
                for (int s4 = 0; s4 < 4; ++s4) { oqk[s4] = *(const LAS bf16x8*)(B + P4_QK + rowread_s(L, 32 * ti, s4)); ovn[s4] = *(const LAS bf16x8*)(F.lds + P4_VNT + rowread_s(L, 32 * tj, s4)); }
                accO = acc1;
            }
            { const float egl = sc[63];
#pragma unroll
              for (int e = 0; e < 16; ++e) sacc[e] *= egl;
              const unsigned blk = (L >> 4) & 1, q4 = (L & 15) >> 2, p4 = L & 3;
              bf16x8 fv[4];
#pragma unroll
              for (int s4 = 0; s4 < 4; ++s4) fv[s4] = *(const LAS bf16x8*)(F.lds + P4_VDT + rowread_s(L, 32 * nt, s4));
              v4i16_t tv[8];
              { const unsigned kb = (unsigned)(size_t)(B + P4_KN), a0 = kb + off_b(8 * hh + q4, 4 * kt + 2 * blk + (p4 >> 1)) + 8 * (p4 & 1), a1 = kb + off_b(8 * hh + 4 + q4, 4 * kt + 2 * blk + (p4 >> 1)) + 8 * (p4 & 1);
                asm volatile("ds_read_b64_tr_b16 %0, %8\n\tds_read_b64_tr_b16 %1, %9\n\tds_read_b64_tr_b16 %2, %8 offset:4096\n\tds_read_b64_tr_b16 %3, %9 offset:4096\n\t"
                             "ds_read_b64_tr_b16 %4, %8 offset:8192\n\tds_read_b64_tr_b16 %5, %9 offset:8192\n\tds_read_b64_tr_b16 %6, %8 offset:12288\n\tds_read_b64_tr_b16 %7, %9 offset:12288\n\ts_waitcnt lgkmcnt(0)"
                             : "=&v"(tv[0]), "=&v"(tv[1]), "=&v"(tv[2]), "=&v"(tv[3]), "=&v"(tv[4]), "=&v"(tv[5]), "=&v"(tv[6]), "=&v"(tv[7]) : "v"(a0), "v"(a1) : "memory"); }
#pragma unroll
              for (int s4 = 0; s4 < 4; ++s4) { const v4i16_t t0v = tv[2 * s4], t1v = tv[2 * s4 + 1];
                  bf16x8 af; af[0] = t0v[0]; af[1] = t0v[1]; af[2] = t0v[2]; af[3] = t0v[3]; af[4] = t1v[0]; af[5] = t1v[1]; af[6] = t1v[2]; af[7] = t1v[3];
                  sacc = __builtin_amdgcn_mfma_f32_32x32x16_bf16(af, fv[s4], sacc, 0, 0, 0); }
              const int nn = 32 * nt + l31;
#pragma unroll
              for (int rg = 0; rg < 4; ++rg)
                  *(LAS unsigned long long*)(F.lds + P4_ST + off_b(nn, 4 * kt + rg) + 8 * hh) = (unsigned long long)cvt_pk_bf16(sacc[4 * rg], sacc[4 * rg + 1]) | ((unsigned long long)cvt_pk_bf16(sacc[4 * rg + 2], sacc[4 * rg + 3]) << 32);
            }
            if (mat == 1 && n > 0) asm volatile("s_waitcnt vmcnt(16)" ::: "memory"); else VM_WAIT();
            LDS_BAR();
        }
        if (mat == 1) finish_o(63);
        VM_WAIT();
    }
}
__device__ __forceinline__ void phase_post(const Frame& F, const Args& a) {
    bf16* MIX = (bf16*)(F.ws + WS_MIX); const bf16* O = (const bf16*)(F.ws + WS_A); const bf16* PROJ = (const bf16*)(F.ws + WS_PROJ); const float* ag = a.in[6]; const float* dg = a.in[10];
    const int gw = F.vcu * NWAVES + F.wave, NGW = F.G * NWAVES, lane = F.lane;
    const f32x4 g0 = *(const f32x4*)(ag + lane * 8), g1 = *(const f32x4*)(ag + lane * 8 + 4);
    const f32x4 d0 = *(const f32x4*)(dg + (lane & 15) * 8), d1 = *(const f32x4*)(dg + (lane & 15) * 8 + 4);
    u32x4 nav, nof, nob, nzv;
    if (gw < NT) { nav = *(const u32x4*)(MIX + (size_t)gw * DM + lane * 8); nof = *(const u32x4*)(O + (size_t)gw * DW + lane * 8); nob = *(const u32x4*)(O + ((size_t)NT + gw) * DW + lane * 8); nzv = *(const u32x4*)(PROJ + (size_t)gw * PC + C_DZ + lane * 8); }
    for (int tok = gw; tok < NT; tok += NGW) {
        bf16* mp = MIX + (size_t)tok * DM;
        const u32x4 av = nav, of = nof, ob = nob, zv = nzv;
        { const int tn = tok + NGW < NT ? tok + NGW : tok;
          nav = *(const u32x4*)(MIX + (size_t)tn * DM + lane * 8); nof = *(const u32x4*)(O + (size_t)tn * DW + lane * 8); nob = *(const u32x4*)(O + ((size_t)NT + tn) * DW + lane * 8); nzv = *(const u32x4*)(PROJ + (size_t)tn * PC + C_DZ + lane * 8); }
        float x[8]; float ss = 0.f;
#pragma unroll
        for (int e = 0; e < 4; ++e) { x[2 * e] = __builtin_bit_cast(float, av[e] << 16); x[2 * e + 1] = __builtin_bit_cast(float, av[e] & 0xffff0000u); ss += x[2 * e] * x[2 * e] + x[2 * e + 1] * x[2 * e + 1]; }
        const float rstd = rsqrtf(wave_sum(ss) * (1.f / 512) + EPS);
        u32x4 w; w.x = cvt_pk_bf16(x[0] * rstd * g0[0], x[1] * rstd * g0[1]); w.y = cvt_pk_bf16(x[2] * rstd * g0[2], x[3] * rstd * g0[3]); w.z = cvt_pk_bf16(x[4] * rstd * g1[0], x[5] * rstd * g1[1]); w.w = cvt_pk_bf16(x[6] * rstd * g1[2], x[7] * rstd * g1[3]);
        *(u32x4*)(mp + lane * 8) = w;
        float o[8], z[8]; float s2 = 0.f;
#pragma unroll
        for (int e = 0; e < 4; ++e) { o[2 * e] = __builtin_bit_cast(float, of[e] << 16) + __builtin_bit_cast(float, ob[e] << 16); o[2 * e + 1] = __builtin_bit_cast(float, of[e] & 0xffff0000u) + __builtin_bit_cast(float, ob[e] & 0xffff0000u);
            z[2 * e] = __builtin_bit_cast(float, zv[e] << 16); z[2 * e + 1] = __builtin_bit_cast(float, zv[e] & 0xffff0000u); s2 += o[2 * e] * o[2 * e] + o[2 * e + 1] * o[2 * e + 1]; }
        s2 = row16_sum(s2);
        const float r2 = rsqrtf(s2 * (1.f / 128) + EPS);
        float y[8];
#pragma unroll
        for (int e = 0; e < 8; ++e) y[e] = o[e] * r2 * (e < 4 ? d0[e] : d1[e - 4]) * z[e] * __builtin_amdgcn_rcpf(1.f + __expf(-z[e]));
        u32x4 w2; w2.x = cvt_pk_bf16(y[0], y[1]); w2.y = cvt_pk_bf16(y[2], y[3]); w2.z = cvt_pk_bf16(y[4], y[5]); w2.w = cvt_pk_bf16(y[6], y[7]);
        *(u32x4*)(mp + 512 + lane * 8) = w2;
    }
}

__global__ void __launch_bounds__(NTHR, 2) fwd(Args args) {
    extern __shared__ __attribute__((aligned(16))) unsigned char lds_raw[];
    Frame F; F.lds = (LAS unsigned char*)lds_raw; F.tid = threadIdx.x; F.lane = F.tid & 63; F.wave = __builtin_amdgcn_readfirstlane(F.tid >> 6);
    F.G = gridDim.x; { const int bx = blockIdx.x; F.vcu = (F.G % 8 == 0) ? (bx % 8) * (F.G / 8) + bx / 8 : bx; } F.ws = args.ws;
    gu32* ctl = (gu32*)(F.ws + WS_CTL);
    for (int u = F.tid; u < 128; u += NTHR) ((LAS unsigned*)(F.lds + LDSCTL_OFF))[u] = 0u;
    __syncthreads();
    const int lo = args.ph_lo, hi = args.ph_hi;
    XcdBarrier bar; bar.bar = (unsigned*)ctl + CW_BAR; bar.x = 0; bar.st = nullptr;
    if (hi - lo > 1) bar = xcd_barrier_post((unsigned*)ctl + CW_BAR, (volatile LAS unsigned*)(F.lds + MISC_OFF));
#ifndef PH_MASK
#define PH_MASK 0xffff
#endif
#define IN(k) (((PH_MASK >> (k)) & 1) && lo <= (k) && (k) < hi)
#define SEAM(k) do { if (IN(k) && IN((k) + 1)) xcd_barrier(bar); } while (0)
#ifndef ALIGN1
#define ALIGN1 false
#endif
#ifndef ALIGN6
#define ALIGN6 true
#endif
#ifndef ALIGN8
#define ALIGN8 true
#endif
#ifndef ALIGN9
#define ALIGN9 true
#endif
#ifndef DBL_MASK
#define DBL_MASK 0
#endif
#define DBL(k) (((DBL_MASK >> (k)) & 1) != 0)
    bf16* XN = (bf16*)(F.ws + WS_A); bf16* X2B = (bf16*)(F.ws + WS_A); bf16* PROJ = (bf16*)(F.ws + WS_PROJ); bf16* MIX = (bf16*)(F.ws + WS_MIX);
    bf16* HID = (bf16*)(F.ws + WS_HID); bf16* Y = (bf16*)(F.ws + WS_Y); float* SSQ2 = (float*)(F.ws + WS_SSQ2);
    if (IN(0)) { phase0(F, args); if (DBL(0)) { xcd_barrier(bar); phase0(F, args); } } SEAM(0);
    if (IN(1)) {
        LAS float* gains = (LAS float*)(F.lds + TAB_OFF);
        if (F.tid < 64) gains[F.tid] = args.in[3][F.tid] * (0.125f * LOG2E); else if (F.tid < 128) gains[F.tid] = args.in[4][F.tid - 64];
        __syncthreads();
        pg8::Gemm g{XN, (const bf16*)(F.ws + WS_WIN), DM, 0, DM, 0}; pg8::StaticOrder S; S.init(NT, PC + 256, F.G, (int)blockIdx.x);
        pg8::gemm_phase<EpiInProjF, pg8::StaticOrder, pg8::DenseA, ALIGN1>(F.lds, g, S, pg8::DenseA{DM}, EpiInProjF{PROJ, gains, (float*)(F.ws + WS_DAB)});
    } SEAM(1);
    if (IN(2)) { phase_na(F, args); if (DBL(2)) { xcd_barrier(bar); phase_na(F, args); } }
    __syncthreads();
    if (IN(3)) { phase_dnprep(F, args); if (DBL(3)) { xcd_barrier(bar); phase_dnprep(F, args); } } SEAM(3);
    if (IN(4)) { phase_dnscan(F, args); if (DBL(4)) { xcd_barrier(bar); phase_dnscan(F, args); } } SEAM(4);
    if (IN(5)) { phase_post(F, args); } SEAM(5);
    if (IN(6)) {
        pg8::Gemm g{MIX, (const bf16*)(F.ws + WS_WO), DM, 0, DM, 0}; pg8::StaticOrder S; S.init(NT, DM, F.G, (int)blockIdx.x);
        pg8::gemm_phase<EpiOutF, pg8::StaticOrder, pg8::DenseA, ALIGN6>(F.lds, g, S, pg8::DenseA{DM}, EpiOutF{args.in[0], args.out, X2B, SSQ2});
    } SEAM(6);
    if (IN(7)) {
        pg8::Gemm g{X2B, (const bf16*)(F.ws + WS_WR), DM, 0, DM, 0}; pg8::StaticOrder S; S.init(NT, 256, F.G, (int)blockIdx.x);
        EpiRouterF E{SSQ2, args.in[14], args.in[16], (int*)(F.ws + WS_TOKE), (float*)(F.ws + WS_TOKG), (float*)(F.ws + WS_RSTD2), (int*)(F.ws + WS_BIDX), (unsigned*)ctl + CW_CNT};
        pg8::gemm_phase<EpiRouterF, pg8::StaticOrder, pg8::DenseA, false>(F.lds, g, S, pg8::DenseA{DM}, E);
    } SEAM(7);
    if (IN(8)) {
        const int n = moe_setup1(F);
        pg8::Gemm g{X2B, (const bf16*)(F.ws + WS_WGU), DM, (size_t)512 * DM * 2, DM, 0};
        MoeSched S{(const LAS int*)(F.lds + TAB_OFF + TB_UT), n};
        const LAS unsigned* t0 = (const LAS unsigned*)(F.lds + TAB_OFF + TB_T);
        pg8::gemm_phase<EpiMoe1F, MoeSched, pg8::GatherA, ALIGN8>(F.lds, g, S, pg8::GatherA{t0}, EpiMoe1F{HID, (const LAS float*)(t0 + 6 * 256), t0 + 12 * 256, (const LAS float*)(t0 + 18 * 256)});
    } SEAM(8);
    if (IN(9)) {
        const int n = moe_setup2(F);
        pg8::Gemm g{HID, (const bf16*)(F.ws + WS_WD), 2 * DE, (size_t)DM * DE * 2, DE, 4};
        MoeSched S{(const LAS int*)(F.lds + TAB_OFF + TB_UT), n};
        pg8::gemm_phase<EpiMoe2F, MoeSched, pg8::DenseA, ALIGN9>(F.lds, g, S, pg8::DenseA{2 * DE}, EpiMoe2F{X2B, args.out, (const LAS unsigned*)(F.lds + TAB_OFF + TB_T)});
    }
#undef IN
#undef SEAM
}


extern "C" void kernel_launch(void* const* d_in, const int* in_sizes, int n_in, void* d_out, int out_size, void* d_ws, size_t ws_size, hipStream_t stream) {
    static int grid = 0;
    if (grid == 0) {
        if (n_in != 20 || in_sizes[0] != NT * DM || out_size != NT * DM || ws_size < WS_END2) { fprintf(stderr, "kernel_launch: unexpected n_in %d / sizes / ws_size %zu (need %zu)\n", n_in, ws_size, (size_t)WS_END2); grid = -1; return; }
        int dev = 0, cus = 0, per_cu = 0;
        if (hipGetDevice(&dev) != hipSuccess || hipDeviceGetAttribute(&cus, hipDeviceAttributeMultiprocessorCount, dev) != hipSuccess) { grid = -1; return; }
        if (hipFuncSetAttribute((const void*)fwd, hipFuncAttributeMaxDynamicSharedMemorySize, LDS_BYTES) != hipSuccess) { fprintf(stderr, "kernel_launch: hipFuncSetAttribute failed\n"); grid = -1; return; }
        if (hipOccupancyMaxActiveBlocksPerMultiprocessor(&per_cu, (const void*)fwd, NTHR, LDS_BYTES) != hipSuccess || per_cu < 1) fprintf(stderr, "kernel_launch: occupancy query says %d\n", per_cu);
        (void)hipGetLastError();
        grid = cus;
    }
    if (grid < 0) return;
    (void)hipMemsetAsync((unsigned char*)d_ws + WS_CTL, 0, 1 * MiB, stream);
    Args a{}; for (int i = 0; i < 20; ++i) a.in[i] = (const float*)d_in[i]; a.out = (float*)d_out; a.ws = (unsigned char*)d_ws;
#define FWD(lo_, hi_) do { a.ph_lo = (lo_); a.ph_hi = (hi_); hipLaunchKernelGGL(fwd, dim3(grid), dim3(NTHR), LDS_BYTES, stream, a); } while (0)
#if defined(PROBE_EXTRA)
    for (int k = 0; k < 10; ++k) { FWD(k, k + 1); if (k == PROBE_EXTRA) FWD(k, k + 1); }
#else
    FWD(0, 10);
#endif
}
```

```cpp
#include <hip/hip_runtime.h>
#include <cstdio>
#include <cstdint>

typedef unsigned short bf16;
typedef unsigned u32x4 __attribute__((ext_vector_type(4)));
typedef float f32x4 __attribute__((ext_vector_type(4)));

constexpr int BATCH = 16, SEQ = 4096, DM = 1024, NT = BATCH * SEQ;
constexpr int GW = 64, ROWS = SEQ / GW, KH = 8, KW = 16;
constexpr int AH = 8, ADH = 64, AW = 512;
constexpr int DH = 4, DHD = 128, DW = 512, DCONV = 5, DCHUNK = 64;
constexpr int INC = 3600, PC = 3584;
constexpr int NG = 8, EPG = 8, NE = 64, DE = 256;
constexpr float EPS = 1e-6f;
constexpr float LOG2E = 1.4426950408889634f;
constexpr int C_AQ = 0, C_AK = 512, C_AV = 1024, C_DQ = 1536, C_DK = 2048, C_DV = 2560, C_DZ = 3072;

constexpr size_t MiB = 1ull << 20;
constexpr size_t WS_CTL   = 0;
constexpr size_t WS_WIN   = 1 * MiB;
constexpr size_t WS_WO    = 8 * MiB + 512 * 1024;
constexpr size_t WS_WR    = 10 * MiB + 512 * 1024;
constexpr size_t WS_WGU   = 11 * MiB;
constexpr size_t WS_WD    = 75 * MiB;
constexpr size_t WS_A     = 107 * MiB;
constexpr size_t WS_PROJ  = 235 * MiB;
constexpr size_t WS_MIX   = 683 * MiB;
constexpr size_t WS_TQK   = 811 * MiB;
constexpr size_t WS_DAB   = 939 * MiB;
constexpr size_t WS_G     = 943 * MiB;
constexpr size_t WS_BETA  = 945 * MiB;
constexpr size_t WS_TOKE  = 947 * MiB;
constexpr size_t WS_TOKG  = 948 * MiB;
constexpr size_t WS_RSTD2 = 949 * MiB;
constexpr size_t WS_BIDX  = 950 * MiB;
constexpr size_t WS_END   = 966 * MiB;
constexpr size_t WS_HID   = WS_PROJ;
constexpr size_t WS_Y     = WS_PROJ + 80 * MiB;
constexpr int CW_CNT = 1024;

__device__ __forceinline__ float bf2f(bf16 v) { return __builtin_bit_cast(float, (unsigned)v << 16); }
__device__ __forceinline__ bf16 f2bf(float f) { unsigned u = __builtin_bit_cast(unsigned, f); return (bf16)((u + 0x7fffu + ((u >> 16) & 1u)) >> 16); }
template <int CTRL> __device__ __forceinline__ float dpp_f(float v) { return __builtin_bit_cast(float, __builtin_amdgcn_update_dpp(0, __builtin_bit_cast(int, v), CTRL, 0xf, 0xf, false)); }
__device__ __forceinline__ float row16_sum(float v) {
    v += dpp_f<0xB1>(v);
    v += dpp_f<0x4E>(v);
    v += dpp_f<0x141>(v);
    v += dpp_f<0x140>(v);
    return v;
}
__device__ __forceinline__ float wave_sum(float v) {
    const int b = __builtin_bit_cast(int, row16_sum(v));
    return (__builtin_bit_cast(float, __builtin_amdgcn_readlane(b, 0)) + __builtin_bit_cast(float, __builtin_amdgcn_readlane(b, 16))) + (__builtin_bit_cast(float, __builtin_amdgcn_readlane(b, 32)) + __builtin_bit_cast(float, __builtin_amdgcn_readlane(b, 48)));
}
__device__ __forceinline__ float silu_f(float x) { return x / (1.f + __expf(-x)); }
__device__ __forceinline__ float sigmoid_f(float x) { return 1.f / (1.f + __expf(-x)); }
__device__ __forceinline__ float softplus_f(float x) { return fmaxf(x, 0.f) + log1pf(__expf(-fabsf(x))); }

#define LAS __attribute__((address_space(3)))
#define GAS __attribute__((address_space(1)))
typedef short bf16x8 __attribute__((ext_vector_type(8)));
typedef GAS unsigned gu32;
constexpr int NWAVES = 8, NTHR = 512;
constexpr int LDS_BYTES = 163840, RING_BYTES = 131072, LDSCTL_OFF = 163328, MISC_OFF = LDSCTL_OFF + 64, TAB_OFF = 132096;
constexpr size_t WS_SSQ2 = 966 * MiB;
constexpr size_t WS_EDL  = 970 * MiB;
constexpr size_t WS_GCR  = 972 * MiB;
constexpr size_t WS_END2 = 974 * MiB;
constexpr int CW_TMO = 0, CW_BAR = 4096;
constexpr int CW_PCNT = 1280;
constexpr size_t WS_R2T = WS_CTL + 256 * 1024;
constexpr size_t WS_TOKP = WS_TOKE;
#define RLX_AGENT __ATOMIC_RELAXED, __HIP_MEMORY_SCOPE_AGENT
#define LDS_WAIT() asm volatile("s_waitcnt lgkmcnt(0)" ::: "memory")
#define VM_WAIT() asm volatile("s_waitcnt vmcnt(0)" ::: "memory")
#define LDS_BAR() do { asm volatile("s_waitcnt lgkmcnt(0)" ::: "memory"); __builtin_amdgcn_s_barrier(); asm volatile("" ::: "memory"); } while (0)
__device__ __forceinline__ unsigned pk2(float lo, float hi) { return (unsigned)f2bf(lo) | ((unsigned)f2bf(hi) << 16); }
typedef float f32x2_t __attribute__((ext_vector_type(2)));
typedef __bf16 bf16x2_t __attribute__((ext_vector_type(2)));
__device__ __forceinline__ unsigned cvt_pk_bf16_asm(float lo, float hi) { unsigned r; asm volatile("v_cvt_pk_bf16_f32 %0, %1, %2" : "=v"(r) : "v"(lo), "v"(hi)); return r; }
__device__ __forceinline__ unsigned cvt_pk_bf16(float lo, float hi) { const f32x2_t v = {lo, hi}; const bf16x2_t b = __builtin_convertvector(v, bf16x2_t); return __builtin_bit_cast(unsigned, b); }

#define XB_TMO      128
#define XB_XCNT(j)  (256  + 64 * (j))
#define XB_XSUB(j)  (1280 + 64 * (j))
#define XB_XGEN(j)  (2304 + 64 * (j))
#define XB_TOP      3328
#define XB_TOPGEN   3392
#define XCD_BAR_WORDS 3456
#define XB_SPIN_CAP (1u << 22)
__device__ __forceinline__ unsigned xb_ld(unsigned* p)              { return __hip_atomic_load(p, __ATOMIC_RELAXED, __HIP_MEMORY_SCOPE_AGENT); }
__device__ __forceinline__ unsigned xb_add(unsigned* p, unsigned v) { return __hip_atomic_fetch_add(p, v, __ATOMIC_RELAXED, __HIP_MEMORY_SCOPE_AGENT); }
__device__ __forceinline__ unsigned xb_xcc_id() { return (unsigned)__builtin_amdgcn_s_getreg((3 << 11) | 20) & 0xFu; }
#define XB_SPIN(cond, bar) do { unsigned _sp = 0; while (cond) { __builtin_amdgcn_s_sleep(1); \
    if ((++_sp & 255u) == 0u) { if (xb_ld(&(bar)[XB_TMO])) break; if (_sp > XB_SPIN_CAP) { atomicAdd(&(bar)[XB_TMO], 1u); break; } } } } while (0)
struct XcdBarrier { unsigned* bar; unsigned x; volatile LAS unsigned* st; };
__device__ __forceinline__ XcdBarrier xcd_barrier_post(unsigned* bar, volatile LAS unsigned* st) {
    XcdBarrier b; b.bar = bar; b.x = xb_xcc_id(); b.st = st;
    if (threadIdx.x == 0) (void)xb_add(&bar[XB_XCNT(b.x)], 1u);
    return b;
}
__device__ __forceinline__ void xcd_barrier_complete(unsigned* bar, unsigned x, unsigned& nloc, unsigned& nx) {
    const unsigned G = gridDim.x * gridDim.y * gridDim.z;
    unsigned sum, cnt, mine, sp = 0u;
    for (;;) {
        sum = 0u; cnt = 0u; mine = 0u;
#pragma unroll
        for (unsigned j = 0; j < 16; ++j) { const unsigned c = xb_ld(&bar[XB_XCNT(j)]); sum += c; cnt += (c > 0u) ? 1u : 0u; mine = (j == x) ? c : mine; }
        if (sum == G) break;
        __builtin_amdgcn_s_sleep(1);
        if ((++sp & 255u) == 0u) { if (xb_ld(&bar[XB_TMO])) break; if (sp > XB_SPIN_CAP) { atomicAdd(&bar[XB_TMO], 1u); break; } }
    }
    nloc = mine > 0u ? mine : 1u; nx = cnt > 0u ? cnt : 1u;
}
__device__ __forceinline__ void xcd_barrier(const XcdBarrier& b) {
    asm volatile("s_waitcnt vmcnt(0)" ::: "memory");
    __syncthreads();
    if (threadIdx.x == 0) {
        unsigned* bar = b.bar;
        __builtin_amdgcn_s_waitcnt(0);
        unsigned nloc = b.st[0], nx = b.st[1];
        if (nloc == 0u) { xcd_barrier_complete(bar, b.x, nloc, nx); b.st[0] = nloc; b.st[1] = nx; }
        const unsigned old = xb_add(&bar[XB_XSUB(b.x)], 1u);
        const unsigned gen = old / nloc;
        if (old + 1u == (gen + 1u) * nloc) {
            __builtin_amdgcn_fence(__ATOMIC_RELEASE, "agent");
            asm volatile("s_waitcnt vmcnt(0)" ::: "memory");
            const unsigned og = xb_add(&bar[XB_TOP], 1u);
            const unsigned tg = og / nx;
            if (og + 1u == (tg + 1u) * nx) xb_add(&bar[XB_TOPGEN], 1u);
            else XB_SPIN(xb_ld(&bar[XB_TOPGEN]) == tg, bar);
            __builtin_amdgcn_fence(__ATOMIC_ACQUIRE, "agent");
            xb_add(&bar[XB_XGEN(b.x)], 1u);
            asm volatile("s_waitcnt vmcnt(0)" ::: "memory");
        } else {
            XB_SPIN(xb_ld(&bar[XB_XGEN(b.x)]) == gen, bar);
            __builtin_amdgcn_fence(__ATOMIC_ACQUIRE, "agent");
            asm volatile("s_waitcnt vmcnt(0)" ::: "memory");
        }
    }
    __syncthreads();
}

namespace pg8 {
constexpr int BM = 256, BK = 64, HALF = 128, HTB = HALF * BK * 2, NXCD = 8, WGM = 8;
__host__ __device__ __forceinline__ int lds_byte(int r, int c) { const int st = (r >> 4) * 2 + (c >> 5), rr = r & 15, cc = c & 31, ob = rr * 64 + cc * 2; return st * 1024 + (ob ^ (((ob >> 9) & 1) << 5)); }
__host__ __device__ __forceinline__ void stage_rc(int b, int& R, int& C) { const int st = b / 1024, sb = b % 1024, swz = sb ^ (((sb >> 9) & 1) << 5); R = (st >> 1) * 16 + swz / 64; C = (st & 1) * 32 + (swz % 64) / 2; }
__host__ __device__ __forceinline__ int perm32(int rho) { const int n = rho >> 4, i = rho & 15; return 8 * (i >> 2) + 4 * n + (i & 3); }
struct Unit { int pm, pn, e, ts, e2; };
struct Gemm { const bf16* A; const bf16* Bt; int K; size_t bstride; int ldb, bsplit; };
struct StaticOrder {
    int nM, nN, nwg, G, c;
    __device__ void init(int M, int N, int G_, int c_) { nM = M / BM; nN = N / BM; nwg = nM * nN; G = G_; c = c_; }
    __device__ bool next(int i, Unit& u) const {
        const long L = (long)i * G + c; if (L >= nwg) return false;
        int wgid = (int)L; { const int q = nwg / NXCD, r = nwg % NXCD, xcd = wgid % NXCD, off = wgid / NXCD; wgid = (xcd < r ? xcd * (q + 1) : r * (q + 1) + (xcd - r) * q) + off; }
        const int nig = WGM * nN, gid = wgid / nig, fm = gid * WGM, gsz = (nM - fm) < WGM ? (nM - fm) : WGM;
        u.pm = fm + ((wgid % nig) % gsz); u.pn = (wgid % nig) / gsz; u.e = 0; u.ts = 0; u.e2 = 0; return true;
    }
};
struct DenseA { int K; __device__ __forceinline__ unsigned rowoff(const Unit& u, int h, int R) const { return (unsigned)(u.pm * BM + h * HALF + R) * (unsigned)(K * 2); } };
struct GatherA { const LAS unsigned* tab; __device__ __forceinline__ unsigned rowoff(const Unit& u, int h, int R) const { return tab[u.ts * BM + h * HALF + R]; } };

template <class Epi, class Sched, class AMap, bool ALIGN_EPI>
__device__ __forceinline__ void gemm_phase(LAS unsigned char* lds, const Gemm g, const Sched& S, const AMap& AM, const Epi& E) {
    const int tid = threadIdx.x, wid = __builtin_amdgcn_readfirstlane(tid >> 6), lane = tid & 63, wr = wid >> 2, wc = wid & 3, fr = lane & 15, fq = lane >> 4;
    const int K = g.K, nt = K / BK;
    unsigned voffB[2];
#pragma unroll
    for (int i = 0; i < 2; ++i) { int R, C; stage_rc(tid * 16 + i * 8192, R, C); const int Rb = Epi::PERM ? ((R & ~31) + perm32(R & 31)) : R;
        voffB[i] = (unsigned)(Rb * g.ldb + C) * 2u; }
    const size_t kstep = (size_t)(BK * 2);
    const size_t hstep = (size_t)HALF * g.ldb * 2;
    const int bsplit = g.bsplit;
    const size_t tstep = 2 * hstep;
    const unsigned ldsw = (unsigned)wid * 1024u;
    const int aoff = lds_byte(wr * 64 + fr, fq * 8), boff = lds_byte(wc * 32 + fr, fq * 8);
    const char* const Ab = (const char*)g.A;
#define PG8_SA(b, h) (((b) * 2 + (h)) * HTB)
#define PG8_SB(b, h) ((4 + (b) * 2 + (h)) * HTB)
#define PG8_STAGE(bufoff, gbase, voff) do { _Pragma("unroll") for (int _i = 0; _i < 2; ++_i) \
        __builtin_amdgcn_global_load_lds((const unsigned*)((const char*)(gbase) + (voff)[_i]), (LAS unsigned*)(lds + (bufoff) + ldsw + _i * 8192), 16, 0, 0); } while (0)
#define PG8_LDA(dst, b, h) do { _Pragma("unroll") for (int m = 0; m < 4; ++m) _Pragma("unroll") for (int k = 0; k < 2; ++k) dst[m][k] = *(const LAS bf16x8*)(lds + PG8_SA(b, h) + aoff + m * 2048 + k * 1024); } while (0)
#define PG8_LDB(dst, b, h) do { _Pragma("unroll") for (int n = 0; n < 2; ++n) _Pragma("unroll") for (int k = 0; k < 2; ++k) dst[n][k] = *(const LAS bf16x8*)(lds + PG8_SB(b, h) + boff + n * 2048 + k * 1024); } while (0)
#define PG8_MMA(ai, bj, At, Bt) do { __builtin_amdgcn_s_setprio(1); _Pragma("unroll") for (int m = 0; m < 4; ++m) _Pragma("unroll") for (int n = 0; n < 2; ++n) _Pragma("unroll") for (int k = 0; k < 2; ++k) \
        acc[ai][bj][m][n] = __builtin_amdgcn_mfma_f32_16x16x32_bf16(Bt[n][k], At[m][k], acc[ai][bj][m][n], 0, 0, 0); __builtin_amdgcn_s_setprio(0); } while (0)
#define PG8_WAIT_V(n) asm volatile("s_waitcnt vmcnt(" #n ")" ::: "memory")
#define PG8_WAIT_L(n) asm volatile("s_waitcnt lgkmcnt(" #n ")" ::: "memory")
#define PG8_BAR __builtin_amdgcn_s_barrier()
#define PG8_SCHED __builtin_amdgcn_sched_barrier(0)
    Unit cur, nxt; int ui = 0;
    if (!S.next(0, cur)) return;
    f32x4 acc[2][2][4][2];
#pragma unroll
    for (int a = 0; a < 2; ++a)
#pragma unroll
        for (int b = 0; b < 2; ++b)
#pragma unroll
            for (int m = 0; m < 4; ++m)
#pragma unroll
                for (int n = 0; n < 2; ++n) acc[a][b][m][n] = (f32x4){0.f, 0.f, 0.f, 0.f};
    bf16x8 At[4][2], B0[2][2], B1[2][2];
    unsigned ca[2][2];
#pragma unroll
    for (int i = 0; i < 2; ++i) { int R, C; stage_rc(tid * 16 + i * 8192, R, C);
#pragma unroll
        for (int h = 0; h < 2; ++h) ca[h][i] = AM.rowoff(cur, h, R) + (unsigned)C * 2u; }
    const char* cB = (const char*)g.Bt + (size_t)cur.e * g.bstride + (size_t)cur.pn * tstep;
    const char* cB2 = (const char*)g.Bt + (size_t)cur.e2 * g.bstride + (size_t)cur.pn * tstep;
    PG8_STAGE(PG8_SB(0, 0), cB, voffB); PG8_STAGE(PG8_SB(0, 1), cB + hstep, voffB); PG8_STAGE(PG8_SA(0, 0), Ab, ca[0]); PG8_STAGE(PG8_SA(0, 1), Ab, ca[1]);
    if (wr == 1) PG8_BAR;
    PG8_WAIT_V(2); PG8_BAR;
    PG8_STAGE(PG8_SB(1, 0), cB + kstep, voffB); PG8_STAGE(PG8_SA(1, 0), Ab + kstep, ca[0]); PG8_STAGE(PG8_SB(1, 1), cB + hstep + kstep, voffB);
    PG8_WAIT_V(6); PG8_BAR;
    for (;;) {
        const bool has_next = S.next(ui + 1, nxt);
        const char* nB = has_next ? (const char*)g.Bt + (size_t)nxt.e * g.bstride + (size_t)nxt.pn * tstep : cB;
        for (int t = 0; t < nt; t += 2) {
            const bool last = (t == nt - 2);
            unsigned a2[2][2];
#pragma unroll
            for (int h = 0; h < 2; ++h)
#pragma unroll
                for (int i = 0; i < 2; ++i) a2[h][i] = ca[h][i];
            if (last && has_next) {
                int tq = tid; asm volatile("" : "+v"(tq));
#pragma unroll
                for (int i = 0; i < 2; ++i) { int R, C; stage_rc(tq * 16 + i * 8192, R, C);
#pragma unroll
                    for (int h = 0; h < 2; ++h) a2[h][i] = AM.rowoff(nxt, h, R) + (unsigned)C * 2u; }
            }
            const char* a1 = Ab + (size_t)(t + 1) * kstep;
            const char* a2b = last ? Ab : Ab + (size_t)(t + 2) * kstep;
            const char* b2 = last ? nB : ((bsplit > 0 && t + 2 >= bsplit) ? cB2 + (size_t)(t + 2 - bsplit) * kstep : cB + (size_t)(t + 2) * kstep);
            const char* a3b = a2b + kstep; const char* b3 = b2 + kstep;
            PG8_LDB(B0, 0, 0); PG8_LDB(B1, 0, 1); PG8_SCHED; PG8_LDA(At, 0, 0); PG8_STAGE(PG8_SA(1, 1), a1, ca[1]);
            PG8_WAIT_V(8); PG8_WAIT_L(0); PG8_BAR; PG8_MMA(0, 0, At, B0); PG8_MMA(0, 1, At, B1); PG8_BAR; PG8_SCHED;
            PG8_LDA(At, 0, 1); PG8_STAGE(PG8_SB(0, 0), b2, voffB); PG8_STAGE(PG8_SB(0, 1), b2 + hstep, voffB); PG8_STAGE(PG8_SA(0, 0), a2b, a2[0]);
            PG8_WAIT_V(8); PG8_WAIT_L(0); PG8_BAR; PG8_MMA(1, 0, At, B0); PG8_MMA(1, 1, At, B1); PG8_BAR; PG8_SCHED;
            PG8_LDB(B0, 1, 0); PG8_LDB(B1, 1, 1); PG8_SCHED; PG8_LDA(At, 1, 0); PG8_STAGE(PG8_SA(0, 1), a2b, a2[1]);
            PG8_WAIT_V(8); PG8_WAIT_L(0); PG8_BAR; PG8_MMA(0, 0, At, B0); PG8_MMA(0, 1, At, B1); PG8_BAR; PG8_SCHED;
            PG8_LDA(At, 1, 1); PG8_STAGE(PG8_SB(1, 0), b3, voffB); PG8_STAGE(PG8_SB(1, 1), b3 + hstep, voffB); PG8_STAGE(PG8_SA(1, 0), a3b, a2[0]);
            PG8_WAIT_V(8); PG8_WAIT_L(0); PG8_BAR; PG8_MMA(1, 0, At, B0); PG8_MMA(1, 1, At, B1); PG8_BAR; PG8_SCHED;
            if (last) {
#pragma unroll
                for (int h = 0; h < 2; ++h)
#pragma unroll
                    for (int i = 0; i < 2; ++i) ca[h][i] = a2[h][i];
            }
        }
        if constexpr (ALIGN_EPI) { if (wr == 0) PG8_BAR; }
        if constexpr (!Epi::AFTER_DRAIN) { E(acc, cur, wr, wc, fr, fq); }
        if (!has_next) break;
#pragma unroll
        for (int a = 0; a < 2; ++a)
#pragma unroll
            for (int b = 0; b < 2; ++b)
#pragma unroll
                for (int m = 0; m < 4; ++m)
#pragma unroll
                    for (int n = 0; n < 2; ++n) acc[a][b][m][n] = (f32x4){0.f, 0.f, 0.f, 0.f};
        cur = nxt; cB = nB; cB2 = (const char*)g.Bt + (size_t)cur.e2 * g.bstride + (size_t)cur.pn * tstep; ++ui;
        if constexpr (ALIGN_EPI) { if (wr == 1) PG8_BAR; }
    }
    PG8_WAIT_V(0);
    if constexpr (!ALIGN_EPI) { if (wr == 0) PG8_BAR; }
    PG8_BAR;
    if constexpr (Epi::AFTER_DRAIN) { E.fused(acc, cur, wr, wc, fr, fq, lds, wid, lane); }
#undef PG8_SA
#undef PG8_SB
#undef PG8_STAGE
#undef PG8_LDA
#undef PG8_LDB
#undef PG8_MMA
#undef PG8_WAIT_V
#undef PG8_WAIT_L
#undef PG8_BAR
#undef PG8_SCHED
}
}

struct EpiInProjF { static constexpr bool PERM = true, AFTER_DRAIN = false;
    bf16* proj; const LAS float* gains; float* dab;
    __device__ __forceinline__ void operator()(const f32x4 (&acc)[2][2][4][2], const pg8::Unit& u, int wr, int wc, int fr, int fq) const {
        if (u.pn == 14) {
            if (wc == 0) {
#pragma unroll
                for (int ai = 0; ai < 2; ++ai)
#pragma unroll
                    for (int m = 0; m < 4; ++m) { const int row = u.pm * 256 + ai * 128 + wr * 64 + m * 16 + fr;
#pragma unroll
                        for (int n = 0; n < 2; ++n) { f32x4 t = acc[ai][0][m][n];
#pragma unroll
                            for (int i = 0; i < 4; ++i) t[i] += __shfl_xor(t[i], 32);
                            if (fq < 2) *(f32x4*)(dab + (size_t)row * 16 + 8 * fq + 4 * n) = t; } }
            }
            return;
        }
        const int mode = u.pn < 2 ? 0 : (u.pn < 4 ? 1 : 2);
        float one = 1.f; asm volatile("" : "+v"(one));
        f32x4 gv[2][2];
        if (mode < 2) {
#pragma unroll
            for (int bj = 0; bj < 2; ++bj)
#pragma unroll
                for (int n = 0; n < 2; ++n) gv[bj][n] = *(const LAS f32x4*)(gains + mode * 64 + 32 * bj + 8 * fq + 4 * n);
        }
#pragma unroll
        for (int ai = 0; ai < 2; ++ai)
#pragma unroll
            for (int m = 0; m < 4; ++m) {
                const int row = u.pm * 256 + ai * 128 + wr * 64 + m * 16 + fr;
                f32x4 v[2][2];
#pragma unroll
                for (int bj = 0; bj < 2; ++bj)
#pragma unroll
                    for (int n = 0; n < 2; ++n) v[bj][n] = acc[ai][bj][m][n];
                if (mode >= 2) {
#pragma unroll
                    for (int bj = 0; bj < 2; ++bj)
#pragma unroll
                        for (int n = 0; n < 2; ++n) v[bj][n] = v[bj][n] * one;
                }
                if (mode < 2) {
                    float ss = 0.f;
#pragma unroll
                    for (int bj = 0; bj < 2; ++bj)
#pragma unroll
                        for (int n = 0; n < 2; ++n) ss += (v[bj][n][0] * v[bj][n][0] + v[bj][n][1] * v[bj][n][1]) + (v[bj][n][2] * v[bj][n][2] + v[bj][n][3] * v[bj][n][3]);
                    ss += __shfl_xor(ss, 16); ss += __shfl_xor(ss, 32);
                    const float rstd = rsqrtf(ss * (1.f / 64) + EPS);
#pragma unroll
                    for (int bj = 0; bj < 2; ++bj)
#pragma unroll
                        for (int n = 0; n < 2; ++n) v[bj][n] = v[bj][n] * rstd * gv[bj][n];
                }
                bf16* rp = proj + (size_t)row * PC + u.pn * 256 + wc * 64 + 8 * fq;
#pragma unroll
                for (int bj = 0; bj < 2; ++bj) { u32x4 w; w.x = cvt_pk_bf16_asm(v[bj][0][0], v[bj][0][1]); w.y = cvt_pk_bf16_asm(v[bj][0][2], v[bj][0][3]); w.z = cvt_pk_bf16_asm(v[bj][1][0], v[bj][1][1]); w.w = cvt_pk_bf16_asm(v[bj][1][2], v[bj][1][3]);
                    *(u32x4*)(rp + 32 * bj) = w; }
            }
    }
};
struct EpiOutF { static constexpr bool PERM = true, AFTER_DRAIN = false;
    const float* x; float* out; bf16* x2b; float* ssq2;
    __device__ __forceinline__ void operator()(const f32x4 (&acc)[2][2][4][2], const pg8::Unit& u, int wr, int wc, int fr, int fq) const {
#pragma unroll
        for (int ai = 0; ai < 2; ++ai)
#pragma unroll
            for (int m = 0; m < 4; ++m) {
                const int row = u.pm * 256 + ai * 128 + wr * 64 + m * 16 + fr; float ss = 0.f;
#pragma unroll
                for (int bj = 0; bj < 2; ++bj) { const size_t off = (size_t)row * DM + u.pn * 256 + bj * 128 + wc * 32 + 8 * fq;
                    const f32x4 r0 = *(const f32x4*)(x + off) + acc[ai][bj][m][0], r1 = *(const f32x4*)(x + off + 4) + acc[ai][bj][m][1];
                    ss += (r0[0] * r0[0] + r0[1] * r0[1]) + (r0[2] * r0[2] + r0[3] * r0[3]) + (r1[0] * r1[0] + r1[1] * r1[1]) + (r1[2] * r1[2] + r1[3] * r1[3]);
                    u32x4 w; w.x = cvt_pk_bf16_asm(r0[0], r0[1]); w.y = cvt_pk_bf16_asm(r0[2], r0[3]); w.z = cvt_pk_bf16_asm(r1[0], r1[1]); w.w = cvt_pk_bf16_asm(r1[2], r1[3]);
                    *(u32x4*)(x2b + off) = w; }
                ss += __shfl_xor(ss, 16); ss += __shfl_xor(ss, 32);
                if (fq == 0) ssq2[(size_t)(u.pn * 4 + wc) * NT + row] = ss;
            }
    }
};
struct EpiRouterF { static constexpr bool PERM = true, AFTER_DRAIN = true;
    const float* ssq2; const float* bg; const float* be; int* toke; float* tokg; float* rstd2; int* bidx; unsigned* cnt;
    __device__ __forceinline__ void fused(const f32x4 (&acc)[2][2][4][2], const pg8::Unit& u, int wr, int wc, int fr, int fq, LAS unsigned char* lds, int wid, int lane) const {
        LAS float* LG = (LAS float*)lds;
        LAS unsigned* cl = (LAS unsigned*)(lds + 80 * 1024);
        LAS unsigned* clp = cl + 128;
        const int tid = threadIdx.x;
        if (tid < 128) cl[tid] = 0u;
        if (tid < 448) clp[tid] = 0u;
        if (wc == 0) {
#pragma unroll
            for (int ai = 0; ai < 2; ++ai)
#pragma unroll
                for (int m = 0; m < 4; ++m) { const int r = ai * 128 + wr * 64 + m * 16 + fr;
#pragma unroll
                    for (int bj = 0; bj < 2; ++bj)
#pragma unroll
                        for (int n = 0; n < 2; ++n)
#pragma unroll
                            for (int i = 0; i < 4; ++i) LG[r * 73 + 32 * bj + 8 * fq + 4 * n + i] = acc[ai][bj][m][n][i]; }
        } else if (wc == 1 && fq == 0) {
#pragma unroll
            for (int ai = 0; ai < 2; ++ai)
#pragma unroll
                for (int m = 0; m < 4; ++m) { const int r = ai * 128 + wr * 64 + m * 16 + fr;
#pragma unroll
                    for (int n = 0; n < 2; ++n)
#pragma unroll
                        for (int i = 0; i < 4; ++i) LG[r * 73 + 64 + 4 * n + i] = acc[ai][0][m][n][i]; }
        }
        __syncthreads();
        int e0 = 0, e1 = 0, pb = 0, slo = 0; unsigned r0 = 0, r1 = 0, rp = 0; const int tok = u.pm * 256 + tid;
        if (tid < 256) {
            float ss = 0.f;
#pragma unroll
            for (int p = 0; p < 16; ++p) ss += ssq2[(size_t)p * NT + tok];
            const float rstd = rsqrtf(ss * (1.f / DM) + EPS);
            const LAS float* lg = LG + tid * 73;
            float gl[8];
#pragma unroll
            for (int n = 0; n < 8; ++n) gl[n] = lg[64 + n] * rstd + bg[n];
            int gs = 0; float gm = gl[0];
#pragma unroll
            for (int n = 1; n < 8; ++n) if (gl[n] > gm) { gm = gl[n]; gs = n; }
            float den = 0.f;
#pragma unroll
            for (int n = 0; n < 8; ++n) den += __expf(gl[n] - gm);
            const float gp = 1.f / den;
            float el[8];
#pragma unroll
            for (int n = 0; n < 8; ++n) el[n] = lg[gs * 8 + n] * rstd + be[gs * 8 + n];
            int i1 = 0; float v1 = el[0];
#pragma unroll
            for (int n = 1; n < 8; ++n) if (el[n] > v1) { v1 = el[n]; i1 = n; }
            int i2 = 0; float v2 = -3.0e38f;
#pragma unroll
            for (int n = 0; n < 8; ++n) if (n != i1 && el[n] > v2) { v2 = el[n]; i2 = n; }
            const float ex = __expf(v2 - v1), p1 = 1.f / (1.f + ex), p2 = ex * p1;
            e0 = gs * 8 + i1; e1 = gs * 8 + i2;
            tokg[tok * 2] = gp * p1; tokg[tok * 2 + 1] = gp * p2; rstd2[tok] = rstd;
            r0 = __hip_atomic_fetch_add(cl + e0, 1u, __ATOMIC_RELAXED, __HIP_MEMORY_SCOPE_WORKGROUP);
            r1 = __hip_atomic_fetch_add(cl + e1, 1u, __ATOMIC_RELAXED, __HIP_MEMORY_SCOPE_WORKGROUP);
            { const int lo = i1 < i2 ? i1 : i2, hi = i1 < i2 ? i2 : i1; slo = i1 < i2 ? 0 : 1; pb = gs * 28 + (lo * (15 - lo)) / 2 + (hi - lo - 1); }
            rp = __hip_atomic_fetch_add(clp + pb, 1u, __ATOMIC_RELAXED, __HIP_MEMORY_SCOPE_WORKGROUP);
        }
        __syncthreads();
        if (tid < 64) { const unsigned c = cl[tid]; cl[64 + tid] = c ? __hip_atomic_fetch_add(cnt + tid, c, __ATOMIC_RELAXED, __HIP_MEMORY_SCOPE_AGENT) : 0u; }
        else if (tid >= 256 && tid < 256 + 224) { const int q = tid - 256; const unsigned c = clp[q]; clp[224 + q] = c ? __hip_atomic_fetch_add(cnt + (CW_PCNT - CW_CNT) + q, c, __ATOMIC_RELAXED, __HIP_MEMORY_SCOPE_AGENT) : 0u; }
        __syncthreads();
        if (tid < 256) { bidx[(size_t)e0 * 65536 + cl[64 + e0] + r0] = tok; bidx[(size_t)e1 * 65536 + cl[64 + e1] + r1] = tok | (1 << 16);
            toke[tok] = (int)(clp[224 + pb] + rp) | (pb << 16) | (slo << 24); }
    }
};
struct EpiMoe1F { static constexpr bool PERM = true, AFTER_DRAIN = false;
    bf16* hid2; const LAS float* rscale; const LAS unsigned* dest; const LAS float* gate;
    __device__ __forceinline__ void operator()(const f32x4 (&acc)[2][2][4][2], const pg8::Unit& u, int wr, int wc, int fr, int fq) const {
#pragma unroll
        for (int ai = 0; ai < 2; ++ai)
#pragma unroll
            for (int m = 0; m < 4; ++m) { const int r = ai * 128 + wr * 64 + m * 16 + fr; const float rs = rscale[u.ts * 256 + r], gt = gate[u.ts * 256 + r]; const unsigned d = dest[u.ts * 256 + r];
                float h[8];
#pragma unroll
                for (int n = 0; n < 2; ++n)
#pragma unroll
                    for (int i = 0; i < 4; ++i) { const float gv = acc[ai][0][m][n][i] * rs, up = acc[ai][1][m][n][i] * rs; h[4 * n + i] = gv * up * gt * __builtin_amdgcn_rcpf(1.f + __expf(-gv)); }
                u32x4 w; w.x = cvt_pk_bf16_asm(h[0], h[1]); w.y = cvt_pk_bf16_asm(h[2], h[3]); w.z = cvt_pk_bf16_asm(h[4], h[5]); w.w = cvt_pk_bf16_asm(h[6], h[7]);
                if (d != 0xffffffffu) *(u32x4*)((char*)hid2 + d + (unsigned)((u.pn * 128 + wc * 32 + 8 * fq) * 2)) = w;
                __builtin_amdgcn_sched_barrier(0); }
    }
};
struct EpiMoe2F { static constexpr bool PERM = true, AFTER_DRAIN = false;
    const bf16* x2b; float* out; const LAS unsigned* tokp1;
    __device__ __forceinline__ void operator()(const f32x4 (&acc)[2][2][4][2], const pg8::Unit& u, int wr, int wc, int fr, int fq) const {
#pragma unroll
        for (int ai = 0; ai < 2; ++ai) {
            unsigned off0[4]; u32x4 xr[4][2];
#pragma unroll
            for (int m = 0; m < 4; ++m) { const unsigned t1 = tokp1[u.ts * 256 + ai * 128 + wr * 64 + m * 16 + fr];
                off0[m] = t1 ? (t1 - 1u) * (unsigned)DM + (unsigned)(u.pn * 256 + wc * 32 + 8 * fq) : 0xffffffffu;
#pragma unroll
                for (int bj = 0; bj < 2; ++bj) xr[m][bj] = *(const u32x4*)(x2b + (t1 ? off0[m] + bj * 128 : 0u)); }
#pragma unroll
            for (int m = 0; m < 4; ++m) if (off0[m] != 0xffffffffu) {
#pragma unroll
                for (int bj = 0; bj < 2; ++bj) { const unsigned off = off0[m] + bj * 128; const u32x4 x = xr[m][bj];
                    f32x4 o0, o1; o0[0] = __builtin_bit_cast(float, x.x << 16); o0[1] = __builtin_bit_cast(float, x.x & 0xffff0000u); o0[2] = __builtin_bit_cast(float, x.y << 16); o0[3] = __builtin_bit_cast(float, x.y & 0xffff0000u);
                    o1[0] = __builtin_bit_cast(float, x.z << 16); o1[1] = __builtin_bit_cast(float, x.z & 0xffff0000u); o1[2] = __builtin_bit_cast(float, x.w << 16); o1[3] = __builtin_bit_cast(float, x.w & 0xffff0000u);
                    __builtin_nontemporal_store(o0 + acc[ai][bj][m][0], (f32x4*)(out + off)); __builtin_nontemporal_store(o1 + acc[ai][bj][m][1], (f32x4*)(out + off + 4)); } }
            __builtin_amdgcn_sched_barrier(0); }
    }
};
struct MoeSched { const LAS int* tab; int n;
    __device__ __forceinline__ bool next(int i, pg8::Unit& u) const { if (i >= n) return false;
        u.pm = __builtin_amdgcn_readfirstlane(tab[8 * i]); u.pn = __builtin_amdgcn_readfirstlane(tab[8 * i + 1]); u.e = __builtin_amdgcn_readfirstlane(tab[8 * i + 2]); u.ts = __builtin_amdgcn_readfirstlane(tab[8 * i + 3]);
        u.e2 = __builtin_amdgcn_readfirstlane(tab[8 * i + 4]); return true; }
};

struct Args { const float* in[20]; float* out; unsigned char* ws; int ph_lo, ph_hi; };
struct Frame { LAS unsigned char* lds; int tid, lane, wave, vcu, G; unsigned char* ws; };

template <class RowMap>
__device__ __forceinline__ void p0_transpose_item(const float* W, int ldw, int k0, int n0, const float* ksc, bf16* dst, int Kd, const RowMap& rm, LAS float* scr, int lane) {
    const int kr = lane >> 4, nq = lane & 15;
    f32x4 tv[16];
#pragma unroll
    for (int i = 0; i < 16; ++i) tv[i] = *(const f32x4*)(W + (size_t)(k0 + 4 * i + kr) * ldw + n0 + 4 * nq);
    if (ksc) {
#pragma unroll
        for (int i = 0; i < 16; ++i) tv[i] = tv[i] * ksc[k0 + 4 * i + kr]; }
#pragma unroll
    for (int i = 0; i < 16; ++i) { LAS float* d = scr + (4 * i + kr) * 65 + 4 * nq; d[0] = tv[i][0]; d[1] = tv[i][1]; d[2] = tv[i][2]; d[3] = tv[i][3]; }
    LDS_WAIT(); asm volatile("" ::: "memory");
    const int c = lane & 7;
#pragma unroll
    for (int j = 0; j < 8; ++j) { const int n = (lane >> 3) + 8 * j; const LAS float* sp = scr + (8 * c) * 65 + n;
        u32x4 o; o.x = cvt_pk_bf16(sp[0 * 65], sp[1 * 65]); o.y = cvt_pk_bf16(sp[2 * 65], sp[3 * 65]); o.z = cvt_pk_bf16(sp[4 * 65], sp[5 * 65]); o.w = cvt_pk_bf16(sp[6 * 65], sp[7 * 65]);
        *(u32x4*)(dst + (size_t)rm(n0 + n) * Kd + k0 + 8 * c) = o; }
    LDS_WAIT(); asm volatile("" ::: "memory");
}
struct RmIn  { __device__ __forceinline__ int operator()(int n) const { const int pn = n >> 8, lc = n & 255; return pn * 256 + 128 * ((lc >> 5) & 1) + 32 * (lc >> 6) + (lc & 31); } };
struct RmId  { int off; __device__ __forceinline__ int operator()(int n) const { return off + n; } };
struct RmGU  { int e, u; __device__ __forceinline__ int operator()(int n) const { return e * 512 + 256 * (n >> 7) + 128 * u + (n & 127); } };

__device__ __forceinline__ void phase0(const Frame& F, const Args& a) {
    const float* x = a.in[0]; const float* ln1_g = a.in[1]; const float* w_in = a.in[2];
    const float* w_out = a.in[11]; const float* ln2_g = a.in[12]; const float* wg_r = a.in[13]; const float* we_r = a.in[15];
    const float* w_gate = a.in[17]; const float* w_up = a.in[18]; const float* w_down = a.in[19];
    bf16* WinT = (bf16*)(F.ws + WS_WIN); bf16* WoT = (bf16*)(F.ws + WS_WO); bf16* WrT = (bf16*)(F.ws + WS_WR); bf16* WguT = (bf16*)(F.ws + WS_WGU); bf16* WdT = (bf16*)(F.ws + WS_WD);
    bf16* XN = (bf16*)(F.ws + WS_A);
    LAS float* scr = (LAS float*)(F.lds + F.wave * 16640);
    const int gw = F.vcu * NWAVES + F.wave, NGW = F.G * NWAVES;
    constexpr int I_IN = 16 * 56, I_O = 16 * 16, I_G = 64 * 16 * 4, I_D = 64 * 4 * 16, I_R = 512;
    constexpr int NITEMS = I_IN + I_O + 2 * I_G + I_D + I_R;
#ifndef P0_REP_ITEMS
#define P0_REP_ITEMS 1
#endif
#ifndef P0_REP_ROWS
#define P0_REP_ROWS 1
#endif
#ifndef P0_NOITEMS
    for (int rep = 0; rep < P0_REP_ITEMS; ++rep)
    for (int it = gw; it < NITEMS; it += NGW) {
        int r = it;
        if (r < I_IN) { p0_transpose_item(w_in, INC, 64 * (r / 56), 64 * (r % 56), nullptr, WinT, DM, RmIn{}, scr, F.lane); continue; } r -= I_IN;
        if (r < I_O) { p0_transpose_item(w_out, DM, 64 * (r / 16), 64 * (r % 16), nullptr, WoT, DM, RmId{0}, scr, F.lane); continue; } r -= I_O;
        if (r < 2 * I_G) { const int u = r / I_G; r -= u * I_G; const int e = r / 64, q = r % 64;
            p0_transpose_item((u ? w_up : w_gate) + (size_t)e * DM * DE, DE, 64 * (q / 4), 64 * (q % 4), ln2_g, WguT, DM, RmGU{e, u}, scr, F.lane); continue; } r -= 2 * I_G;
        if (r < I_D) { const int e = r / 64, q = r % 64; p0_transpose_item(w_down + (size_t)e * DE * DM, DM, 64 * (q / 16), 64 * (q % 16), nullptr, WdT, DE, RmId{e * DM}, scr, F.lane); continue; } r -= I_D;
        if (r >= 256) {
            r -= 256; unsigned w[8];
#pragma unroll
            for (int j = 0; j < 8; ++j) { float v0 = 0.f, v1 = 0.f; const int k = F.lane * 16 + 2 * j;
                if (r < 32) { v0 = w_in[(size_t)k * INC + PC + (r & 15)]; v1 = w_in[(size_t)(k + 1) * INC + PC + (r & 15)];
                    if (r >= 16) { v0 -= __builtin_bit_cast(float, (unsigned)f2bf(v0) << 16); v1 -= __builtin_bit_cast(float, (unsigned)f2bf(v1) << 16); } }
                w[j] = pk2(v0, v1); }
            u32x4* dp = (u32x4*)(WinT + (size_t)(PC + r) * DM + F.lane * 16);
            dp[0] = (u32x4){w[0], w[1], w[2], w[3]}; dp[1] = (u32x4){w[4], w[5], w[6], w[7]};
            continue; }
        {
            const float* src = nullptr; int ld = 0, col = 0;
            if (r < 32) { src = we_r; ld = 64; col = r; } else if (r >= 128 && r < 160) { src = we_r; ld = 64; col = 32 + (r - 128); } else if (r >= 32 && r < 40) { src = wg_r; ld = 8; col = r - 32; }
            unsigned w[8];
#pragma unroll
            for (int j = 0; j < 8; ++j) { const int k = F.lane * 16 + 2 * j; float v0 = 0.f, v1 = 0.f; if (src) { v0 = src[(size_t)k * ld + col] * ln2_g[k]; v1 = src[(size_t)(k + 1) * ld + col] * ln2_g[k + 1]; } w[j] = pk2(v0, v1); }
            u32x4* dp = (u32x4*)(WrT + (size_t)r * DM + F.lane * 16);
            dp[0] = (u32x4){w[0], w[1], w[2], w[3]}; dp[1] = (u32x4){w[4], w[5], w[6], w[7]};
        }
    }
#endif
#ifndef P0_NOROWS
    {
    f32x4 gq[4];
#pragma unroll
    for (int j = 0; j < 4; ++j) gq[j] = ((const f32x4*)ln1_g + F.lane)[64 * j];
    f32x4 nx[4], ny[4];
    if (gw < NT) { const f32x4* xr = (const f32x4*)(x + (size_t)gw * DM) + F.lane;
#pragma unroll
        for (int j = 0; j < 4; ++j) nx[j] = xr[64 * j]; }
    if (gw + NGW < NT) { const f32x4* xr = (const f32x4*)(x + (size_t)(gw + NGW) * DM) + F.lane;
#pragma unroll
        for (int j = 0; j < 4; ++j) ny[j] = xr[64 * j]; }
    for (int rep = 0; rep < P0_REP_ROWS; ++rep)
    for (int m = gw; m < NT; m += NGW) {
        f32x4 v[4]; float s = 0.f;
#pragma unroll
        for (int j = 0; j < 4; ++j) { v[j] = nx[j]; s += (v[j].x * v[j].x + v[j].y * v[j].y) + (v[j].z * v[j].z + v[j].w * v[j].w); }
#pragma unroll
        for (int j = 0; j < 4; ++j) nx[j] = ny[j];
        if (m + 2 * NGW < NT) { const f32x4* xr = (const f32x4*)(x + (size_t)(m + 2 * NGW) * DM) + F.lane;
#pragma unroll
            for (int j = 0; j < 4; ++j) ny[j] = xr[64 * j]; }
        const float rstd = rsqrtf(wave_sum(s) * (1.f / DM) + EPS);
        unsigned long long* o8 = (unsigned long long*)(XN + (size_t)m * DM) + F.lane;
#pragma unroll
        for (int j = 0; j < 4; ++j) { v[j] = v[j] * rstd * gq[j];
            o8[64 * j] = (unsigned long long)cvt_pk_bf16(v[j].x, v[j].y) | ((unsigned long long)cvt_pk_bf16(v[j].z, v[j].w) << 32); }
    }
    }
#endif
}

constexpr int TB_PRE = 0  , TB_UT = 512  , TB_PT = 1024  , TB_T = 2048  ;
__device__ __forceinline__ void moe_prefixes(const Frame& F) {
    const unsigned* cnt = (const unsigned*)(F.ws + WS_CTL) + CW_CNT; const unsigned* pcnt = (const unsigned*)(F.ws + WS_CTL) + CW_PCNT;
    LAS int* pre = (LAS int*)(F.lds + TAB_OFF + TB_PRE); LAS int* pt = (LAS int*)(F.lds + TAB_OFF + TB_PT);
    if (F.tid < 64) pre[F.tid] = (int)((__hip_atomic_load(cnt + F.tid, RLX_AGENT) + 255u) >> 8);
    else if (F.tid >= 128 && F.tid < 128 + 224) pt[F.tid - 128] = (int)((__hip_atomic_load(pcnt + (F.tid - 128), RLX_AGENT) + 255u) >> 8);
    __syncthreads();
    if (F.tid == 0) { int s = 0; for (int e = 0; e < 64; ++e) { const int t = pre[e]; pre[e] = s; s += t; } pre[64] = s; }
    if (F.tid == 64) { int s = 0; for (int q = 0; q < 224; ++q) { const int t = pt[q]; pt[q] = s; s += t; } pt[224] = s; }
    __syncthreads();
}
__device__ __forceinline__ int moe_setup1(const Frame& F) {
    const unsigned* cnt = (const unsigned*)(F.ws + WS_CTL) + CW_CNT;
    LAS int* pre = (LAS int*)(F.lds + TAB_OFF + TB_PRE); LAS int* pt = (LAS int*)(F.lds + TAB_OFF + TB_PT); LAS int* ut = (LAS int*)(F.lds + TAB_OFF + TB_UT);
    LAS unsigned* t0 = (LAS unsigned*)(F.lds + TAB_OFF + TB_T); LAS float* t1 = (LAS float*)(t0 + 6 * 256); LAS unsigned* t2 = t0 + 12 * 256; LAS float* t3 = (LAS float*)(t0 + 18 * 256);
    const int* bidx = (const int*)(F.ws + WS_BIDX); const float* rstd2 = (const float*)(F.ws + WS_RSTD2); const float* tokg = (const float*)(F.ws + WS_TOKG); const int* tokp = (const int*)(F.ws + WS_TOKP);
    unsigned* r2t = (unsigned*)(F.ws + WS_R2T);
    moe_prefixes(F);
    for (int tok = F.vcu * NTHR + F.tid; tok < NT; tok += F.G * NTHR) { const int tp = tokp[tok]; r2t[256 * pt[(tp >> 16) & 0xff] + (tp & 0xffff)] = (unsigned)tok + 1u; }
    const int total = pre[64] * 2;
    int n = 0; for (int i = 0; i < 6; ++i) if ((long)i * F.G + F.vcu < total) n = i + 1;
    if (F.tid < n) { const int L = F.tid * F.G + F.vcu; const int rtg = L >> 1, pn = L & 1; int e = 0; for (int q = 0; q < 64; ++q) if (pre[q + 1] <= rtg) e = q + 1;
        ut[8 * F.tid] = rtg; ut[8 * F.tid + 1] = pn; ut[8 * F.tid + 2] = e; ut[8 * F.tid + 3] = F.tid; ut[8 * F.tid + 4] = e; }
    __syncthreads();
    { int ts3[3]; bool val3[3]; int tp3[3]; float rs3[3], g3[3];
#pragma unroll
      for (int k = 0; k < 3; ++k) { const int x = F.tid + NTHR * k; ts3[k] = 0; val3[k] = false;
          if (x < n * 256) { const int i = x >> 8, r = x & 255, rtg = ut[8 * i], e = ut[8 * i + 2]; const int idx = (rtg - pre[e]) * 256 + r; const int c = (int)__hip_atomic_load(cnt + e, RLX_AGENT);
              val3[k] = idx < c; ts3[k] = bidx[(size_t)e * 65536 + (val3[k] ? idx : 0)]; } }
#pragma unroll
      for (int k = 0; k < 3; ++k) { const int tok = ts3[k] & 0xffff, slot = ts3[k] >> 16; tp3[k] = tokp[tok]; rs3[k] = rstd2[tok]; g3[k] = tokg[tok * 2 + slot]; }
#pragma unroll
      for (int k = 0; k < 3; ++k) { const int x = F.tid + NTHR * k;
          if (x < n * 256) { const int tok = ts3[k] & 0xffff, slot = ts3[k] >> 16, tp = tp3[k];
              t0[x] = (unsigned)tok * (unsigned)(DM * 2); t1[x] = val3[k] ? rs3[k] : 0.f;
              t2[x] = val3[k] ? (unsigned)(256 * pt[(tp >> 16) & 0xff] + (tp & 0xffff)) * 1024u + (slot == ((tp >> 24) & 1) ? 0u : 512u) : 0xffffffffu;
              t3[x] = g3[k]; } } }
    __syncthreads();
    return n;
}
__device__ __forceinline__ int moe_setup2(const Frame& F) {
    LAS int* pt = (LAS int*)(F.lds + TAB_OFF + TB_PT); LAS int* ut = (LAS int*)(F.lds + TAB_OFF + TB_UT); LAS unsigned* t0 = (LAS unsigned*)(F.lds + TAB_OFF + TB_T);
    const unsigned* r2t = (const unsigned*)(F.ws + WS_R2T);
    moe_prefixes(F);
    const int total = pt[224] * 4;
    int n = 0; for (int i = 0; i < 8; ++i) if ((long)i * F.G + F.vcu < total) n = i + 1;
    if (F.tid < n) { const int L = F.tid * F.G + F.vcu; const int rtg = L >> 2, pn = L & 3; int pb = 0; for (int q = 0; q < 224; ++q) if (pt[q + 1] <= rtg) pb = q + 1;
        const int gs = pb / 28, pi = pb - 28 * gs; int lo = 0; for (int l = 0; l < 7; ++l) if (pi >= (l * (15 - l)) / 2) lo = l; const int hi = lo + 1 + pi - (lo * (15 - lo)) / 2;
        ut[8 * F.tid] = rtg; ut[8 * F.tid + 1] = pn; ut[8 * F.tid + 2] = gs * 8 + lo; ut[8 * F.tid + 3] = F.tid; ut[8 * F.tid + 4] = gs * 8 + hi; }
    __syncthreads();
    { unsigned v4[4];
#pragma unroll
      for (int k = 0; k < 4; ++k) { const int x = F.tid + NTHR * k; v4[k] = 0u; if (x < n * 256) v4[k] = r2t[(size_t)ut[8 * (x >> 8)] * 256 + (x & 255)]; }
#pragma unroll
      for (int k = 0; k < 4; ++k) { const int x = F.tid + NTHR * k; if (x < n * 256) t0[x] = v4[k]; } }
    __syncthreads();
    return n;
}

typedef short v4i16_t __attribute__((ext_vector_type(4)));
constexpr int NA_SLOT = 16384, NA_NSLOT = 9, NA_MRG = NA_NSLOT * NA_SLOT, NA_MRGL = NA_MRG + 8192, NA_BT = NA_MRGL + 1024;
__device__ __forceinline__ int na_swz(int key) { return ((key >> 1) & 3) << 1; }
__device__ __forceinline__ void na_stage_row(const Frame& F, const bf16* pbh, int bandrow) {
    const int key = 8 * F.wave + (F.lane >> 3), c = (F.lane & 7) ^ na_swz(key);
    const bf16* src = pbh + (size_t)(bandrow * GW + key) * PC + c * 8;
    LAS unsigned char* dst = F.lds + (bandrow % NA_NSLOT) * NA_SLOT + F.wave * 1024;
    __builtin_amdgcn_global_load_lds((const unsigned*)(src + C_AK), (LAS unsigned*)dst, 16, 0, 0);
    __builtin_amdgcn_global_load_lds((const unsigned*)(src + C_AV), (LAS unsigned*)(dst + 8192), 16, 0, 0);
}
#define NA_LD16(dst, ptr) asm volatile("global_load_dwordx4 %0, %1, off" : "=v"(dst) : "v"(ptr) : "memory")
__device__ __forceinline__ void phase_na(const Frame& F, const Args& a) {
    const bf16* PROJ = (const bf16*)(F.ws + WS_PROJ); bf16* MIX = (bf16*)(F.ws + WS_MIX); const float* rpb = a.in[5];
    const int j = F.wave & 3, bh = F.wave >> 2, g = F.lane >> 4, li = F.lane & 15, c = 16 * j + li;
    const int ks0 = j == 0 ? 0 : (j == 1 ? 8 : (j == 2 ? 24 : 32));
    int c0 = c - KW / 2; c0 = c0 < 0 ? 0 : (c0 > GW - KW ? GW - KW : c0);
    LAS float* bt = (LAS float*)(F.lds + NA_BT);
    for (int unit = F.vcu; unit < BATCH * AH * 2; unit += F.G) {
        const int b = unit >> 4, h = (unit >> 1) & 7, rs = (unit & 1) * 32;
        const bf16* pbh = PROJ + (size_t)b * SEQ * PC + h * ADH;
        float mq = fabsf(a.in[3][F.lane]), mk = fabsf(a.in[4][F.lane]);
#pragma unroll
        for (int o = 1; o < 64; o <<= 1) { mq = fmaxf(mq, __shfl_xor(mq, o)); mk = fmaxf(mk, __shfl_xor(mk, o)); }
        float mb = 0.f; for (int i = F.lane; i < 15 * 31; i += 64) mb = fmaxf(mb, fabsf(rpb[h * 465 + i]));
#pragma unroll
        for (int o = 1; o < 64; o <<= 1) mb = fmaxf(mb, __shfl_xor(mb, o));
        const float cshift = 64.f * 0.125f * LOG2E * mq * mk + mb * LOG2E;
        __syncthreads();
        for (int i = F.tid; i < 15 * 31; i += NTHR) bt[i] = rpb[h * 465 + i] * LOG2E - cshift;
        int r0 = rs - KH / 2; r0 = r0 < 0 ? 0 : (r0 > ROWS - KH ? ROWS - KH : r0);
        for (int i = 0; i < KH; ++i) na_stage_row(F, pbh, r0 + i);
        VM_WAIT(); __syncthreads();
        const int pkey = 8 * F.wave + (F.lane >> 3), pch = (F.lane & 7) ^ na_swz(pkey);
        auto r0_of = [](int r) { int v = r - KH / 2; return v < 0 ? 0 : (v > ROWS - KH ? ROWS - KH : v); };
        u32x4 pk, pv;
        { const bf16* src = pbh + (size_t)((r0_of(rs + 1) + KH - 1) * GW + pkey) * PC + pch * 8; NA_LD16(pk, src + C_AK); NA_LD16(pv, src + C_AV); }
        float bias[8][4]; int prev_ro = -100;
        bf16x8 qn[2];
#pragma unroll
        for (int ks = 0; ks < 2; ++ks) NA_LD16(qn[ks], PROJ + ((size_t)b * SEQ + rs * GW + c) * PC + C_AQ + h * ADH + 32 * ks + 8 * g);
        asm volatile("s_waitcnt vmcnt(0)" : "+v"(pk), "+v"(pv), "+v"(qn[0]), "+v"(qn[1]) :: "memory");
        for (int r = rs; r < rs + 32; ++r) {
            r0 = r - KH / 2; r0 = r0 < 0 ? 0 : (r0 > ROWS - KH ? ROWS - KH : r0);
            if (r + 1 < rs + 32 && r0_of(r + 1) != r0) { LAS unsigned char* dst = F.lds + ((r0_of(r + 1) + KH - 1) % NA_NSLOT) * NA_SLOT + F.wave * 1024 + F.lane * 16;
                *(LAS u32x4*)dst = pk; *(LAS u32x4*)(dst + 8192) = pv; }
            { const bf16* src = pbh + (size_t)((r0_of(r + 2) + KH - 1) * GW + pkey) * PC + pch * 8; NA_LD16(pk, src + C_AK); NA_LD16(pv, src + C_AV); }
            const int ro = r0 - r + (KH - 1) + 4 * bh;
            if (ro != prev_ro) { prev_ro = ro;
#pragma unroll
                for (int i4 = 0; i4 < 4; ++i4)
#pragma unroll
                    for (int t = 0; t < 2; ++t)
#pragma unroll
                        for (int q = 0; q < 4; ++q) { const int kc = ks0 + 16 * t + 4 * g + q; const bool valid = kc >= c0 && kc < c0 + KW;
                            bias[i4 * 2 + t][q] = valid ? bt[(ro + i4) * 31 + (kc - c + KW - 1)] : -1.0e30f; } }
            const size_t qtok = (size_t)b * SEQ + r * GW + c;
            bf16x8 qf[2]; qf[0] = qn[0]; qf[1] = qn[1];
            { const size_t ntok = qtok + (r + 1 < rs + 32 ? GW : 0);
#pragma unroll
              for (int ks = 0; ks < 2; ++ks) NA_LD16(qn[ks], PROJ + ntok * PC + C_AQ + h * ADH + 32 * ks + 8 * g); }
            f32x4 sacc[8];
#pragma unroll
            for (int i4 = 0; i4 < 4; ++i4) { const LAS unsigned char* ks_ = F.lds + ((r0 + 4 * bh + i4) % NA_NSLOT) * NA_SLOT;
#pragma unroll
                for (int t = 0; t < 2; ++t) { const int row = ks0 + 16 * t + li; f32x4 acc = {bias[i4 * 2 + t][0], bias[i4 * 2 + t][1], bias[i4 * 2 + t][2], bias[i4 * 2 + t][3]};
#pragma unroll
                    for (int ks = 0; ks < 2; ++ks) { const bf16x8 kf = *(const LAS bf16x8*)(ks_ + row * 128 + (((g + 4 * ks) ^ na_swz(row)) << 4));
                        acc = __builtin_amdgcn_mfma_f32_16x16x32_bf16(kf, qf[ks], acc, 0, 0, 0); }
                    sacc[i4 * 2 + t] = acc; } }
            f32x2_t ls2 = {0.f, 0.f};
#pragma unroll
            for (int x = 0; x < 8; ++x) {
#pragma unroll
                for (int q = 0; q < 4; ++q) sacc[x][q] = __builtin_amdgcn_exp2f(sacc[x][q]);
                ls2 += (f32x2_t){sacc[x][0], sacc[x][1]}; ls2 += (f32x2_t){sacc[x][2], sacc[x][3]}; }
            float lsum = ls2[0] + ls2[1];
            f32x4 oacc[4];
#pragma unroll
            for (int dt = 0; dt < 4; ++dt) oacc[dt] = (f32x4){0.f, 0.f, 0.f, 0.f};
#pragma unroll
            for (int m = 0; m < 4; ++m) {
                const int xa = 2 * m, xb = 2 * m + 1;
                bf16x8 pf; { const unsigned w0 = cvt_pk_bf16(sacc[xa][0], sacc[xa][1]), w1 = cvt_pk_bf16(sacc[xa][2], sacc[xa][3]), w2 = cvt_pk_bf16(sacc[xb][0], sacc[xb][1]), w3 = cvt_pk_bf16(sacc[xb][2], sacc[xb][3]);
                    pf = __builtin_bit_cast(bf16x8, (u32x4){w0, w1, w2, w3}); }
                const LAS unsigned char* va = F.lds + ((r0 + 4 * bh + m) % NA_NSLOT) * NA_SLOT + 8192; const LAS unsigned char* vb = va;
                const int rowa = ks0 + 4 * g + (li >> 2), rowb = ks0 + 16 + 4 * g + (li >> 2);
#pragma unroll
                for (int dt = 0; dt < 4; ++dt) { const int cc = 2 * dt + ((li & 3) >> 1), hb = (li & 1) * 8;
                    const v4i16_t ta = __builtin_amdgcn_ds_read_tr16_b64_v4i16((LAS v4i16_t*)(va + rowa * 128 + ((cc ^ na_swz(rowa)) << 4) + hb));
                    const v4i16_t tb = __builtin_amdgcn_ds_read_tr16_b64_v4i16((LAS v4i16_t*)(vb + rowb * 128 + ((cc ^ na_swz(rowb)) << 4) + hb));
                    bf16x8 vf; vf[0] = ta[0]; vf[1] = ta[1]; vf[2] = ta[2]; vf[3] = ta[3]; vf[4] = tb[0]; vf[5] = tb[1]; vf[6] = tb[2]; vf[7] = tb[3];
                    oacc[dt] = __builtin_amdgcn_mfma_f32_16x16x32_bf16(vf, pf, oacc[dt], 0, 0, 0); }
            }
            LAS unsigned char* mrg = F.lds + NA_MRG + (j * 64 + F.lane) * 32; LAS float* mrl = (LAS float*)(F.lds + NA_MRGL) + j * 64 + F.lane;
            if (bh == 1) {
                u32x4 w0, w1; w0.x = cvt_pk_bf16(oacc[0][0], oacc[0][1]); w0.y = cvt_pk_bf16(oacc[0][2], oacc[0][3]); w0.z = cvt_pk_bf16(oacc[1][0], oacc[1][1]); w0.w = cvt_pk_bf16(oacc[1][2], oacc[1][3]);
                w1.x = cvt_pk_bf16(oacc[2][0], oacc[2][1]); w1.y = cvt_pk_bf16(oacc[2][2], oacc[2][3]); w1.z = cvt_pk_bf16(oacc[3][0], oacc[3][1]); w1.w = cvt_pk_bf16(oacc[3][2], oacc[3][3]);
                *(LAS u32x4*)mrg = w0; *(LAS u32x4*)(mrg + 16) = w1; *mrl = lsum;
            }
            LDS_BAR();
            if (bh == 0) {
                const u32x4 w0 = *(const LAS u32x4*)mrg, w1 = *(const LAS u32x4*)(mrg + 16); lsum += *mrl;
                lsum += __shfl_xor(lsum, 16); lsum += __shfl_xor(lsum, 32);
                const float inv = 1.f / lsum;
                bf16* op = MIX + qtok * DM + h * ADH + 4 * g;
#pragma unroll
                for (int dt = 0; dt < 4; ++dt) { const unsigned pa = dt < 2 ? (dt == 0 ? w0.x : w0.z) : (dt == 2 ? w1.x : w1.z), pb = dt < 2 ? (dt == 0 ? w0.y : w0.w) : (dt == 2 ? w1.y : w1.w);
                    const float o0 = (oacc[dt][0] + __builtin_bit_cast(float, pa << 16)) * inv, o1 = (oacc[dt][1] + __builtin_bit_cast(float, pa & 0xffff0000u)) * inv;
                    const float o2 = (oacc[dt][2] + __builtin_bit_cast(float, pb << 16)) * inv, o3 = (oacc[dt][3] + __builtin_bit_cast(float, pb & 0xffff0000u)) * inv;
                    *(unsigned long long*)(op + 16 * dt) = (unsigned long long)cvt_pk_bf16(o0, o1) | ((unsigned long long)cvt_pk_bf16(o2, o3) << 32); }
                asm volatile("s_waitcnt vmcnt(4)" ::: "memory");
            } else asm volatile("s_waitcnt vmcnt(0)" ::: "memory");
            asm volatile("" :: "v"(pk), "v"(pv), "v"(qn[0]), "v"(qn[1]) : "memory");
            LDS_BAR();
        }
    }
}


typedef float f32x16 __attribute__((ext_vector_type(16)));
constexpr size_t WS_GCL = WS_G, WS_BETAL = WS_BETA;
constexpr int P3_QN = 0, P3_KN = 16384, P3_LF = 32768, P3_LB = P3_LF + 17408, P3_TF = P3_LB + 17408, P3_TB = P3_TF + 17408, P3_CW = P3_TB + 17408, P3_SC = P3_CW + 7680, P3_RAW = P3_SC + 1024, LST = 68;
__device__ __forceinline__ unsigned off_b(unsigned row, unsigned ch) { return 256u * row + 16u * (ch ^ (((row & 3) << 2) | ((row >> 2) & 3))); }
__device__ __forceinline__ unsigned rowread_b(unsigned lane, unsigned rowbase, unsigned s) { return off_b(rowbase + (lane & 31), 2 * s + (lane >> 5)); }
__device__ __forceinline__ void dn_inverse(LAS float* LS, LAS float* TS, int lane) {
    for (int i = lane; i < 64 * LST / 4; i += 64) ((LAS f32x4*)TS)[i] = (f32x4){0.f, 0.f, 0.f, 0.f};
    { const int blk = lane >> 4, col = lane & 15; float xa[16];
#pragma unroll
      for (int i = 0; i < 16; ++i) xa[i] = (i == col) ? 1.f : 0.f;
#pragma unroll
      for (int k = 0; k < 16; ++k) { const float xk = xa[k]; TS[(16 * blk + k) * LST + 16 * blk + col] = xk;
#pragma unroll
          for (int i = k + 1; i < 16; ++i) xa[i] -= LS[(16 * blk + i) * LST + 16 * blk + k] * xk; } }
    __builtin_amdgcn_sched_barrier(0);
#pragma unroll
    for (int p = 0; p < 2; ++p) { const int base = 32 * p, r = lane & 15, kq = lane >> 4;
        float a1[4], b1[4];
#pragma unroll
        for (int s4 = 0; s4 < 4; ++s4) { a1[s4] = LS[(base + 16 + r) * LST + base + kq + 4 * s4]; b1[s4] = TS[(base + kq + 4 * s4) * LST + base + r]; }
        const f32x4 a2 = *(const LAS f32x4*)(TS + (base + 16 + r) * LST + base + 16 + 4 * kq);
        __builtin_amdgcn_sched_barrier(0);
        f32x4 M = {0.f, 0.f, 0.f, 0.f};
#pragma unroll
        for (int s4 = 0; s4 < 4; ++s4) M = __builtin_amdgcn_mfma_f32_16x16x4f32(a1[s4], b1[s4], M, 0, 0, 0);
        f32x4 R = {0.f, 0.f, 0.f, 0.f};
#pragma unroll
        for (int s4 = 0; s4 < 4; ++s4) R = __builtin_amdgcn_mfma_f32_16x16x4f32(a2[s4], M[s4], R, 0, 0, 0);
#pragma unroll
        for (int e = 0; e < 4; ++e) TS[(base + 16 + 4 * kq + e) * LST + base + r] = -R[e]; }
    __builtin_amdgcn_sched_barrier(0);
    { const int r = lane & 31, kh = lane >> 5;
      bf16x8 a1[2], b1[2], a2[2];
#pragma unroll
      for (int sx = 0; sx < 2; ++sx) {
          const f32x4 l0 = *(const LAS f32x4*)(LS + (32 + r) * LST + 16 * sx + 8 * kh), l1 = *(const LAS f32x4*)(LS + (32 + r) * LST + 16 * sx + 8 * kh + 4);
          a1[sx] = __builtin_bit_cast(bf16x8, (u32x4){cvt_pk_bf16(l0[0], l0[1]), cvt_pk_bf16(l0[2], l0[3]), cvt_pk_bf16(l1[0], l1[1]), cvt_pk_bf16(l1[2], l1[3])});
          float tb[8];
#pragma unroll
          for (int j = 0; j < 8; ++j) tb[j] = TS[(16 * sx + 8 * kh + j) * LST + r];
          b1[sx] = __builtin_bit_cast(bf16x8, (u32x4){cvt_pk_bf16(tb[0], tb[1]), cvt_pk_bf16(tb[2], tb[3]), cvt_pk_bf16(tb[4], tb[5]), cvt_pk_bf16(tb[6], tb[7])});
          const f32x4 t0 = *(const LAS f32x4*)(TS + (32 + r) * LST + 32 + 16 * sx + 4 * kh), t1 = *(const LAS f32x4*)(TS + (32 + r) * LST + 32 + 16 * sx + 8 + 4 * kh);
          a2[sx] = __builtin_bit_cast(bf16x8, (u32x4){cvt_pk_bf16(t0[0], t0[1]), cvt_pk_bf16(t0[2], t0[3]), cvt_pk_bf16(t1[0], t1[1]), cvt_pk_bf16(t1[2], t1[3])}); }
      __builtin_amdgcn_sched_barrier(0);
      f32x16 M;
#pragma unroll
      for (int e = 0; e < 16; ++e) M[e] = 0.f;
#pragma unroll
      for (int sx = 0; sx < 2; ++sx) M = __builtin_amdgcn_mfma_f32_32x32x16_bf16(a1[sx], b1[sx], M, 0, 0, 0);
      f32x16 R;
#pragma unroll
      for (int e = 0; e < 16; ++e) R[e] = 0.f;
#pragma unroll
      for (int sx = 0; sx < 2; ++sx) { const bf16x8 mb = __builtin_bit_cast(bf16x8, (u32x4){cvt_pk_bf16(M[8 * sx], M[8 * sx + 1]), cvt_pk_bf16(M[8 * sx + 2], M[8 * sx + 3]), cvt_pk_bf16(M[8 * sx + 4], M[8 * sx + 5]), cvt_pk_bf16(M[8 * sx + 6], M[8 * sx + 7])});
          R = __builtin_amdgcn_mfma_f32_32x32x16_bf16(a2[sx], mb, R, 0, 0, 0); }
#pragma unroll
      for (int e = 0; e < 16; ++e) TS[(32 + (e & 3) + 8 * (e >> 2) + 4 * kh) * LST + r] = -R[e]; }
}
__device__ __forceinline__ void phase_dnprep(const Frame& F, const Args& a) {
    const bf16* PROJ = (const bf16*)(F.ws + WS_PROJ); bf16* QKVN = (bf16*)a.out; bf16* TQK = (bf16*)(F.ws + WS_TQK);
    const float* DABp = (const float*)(F.ws + WS_DAB); const float* a_log = a.in[8]; const float* dt_bias = a.in[9]; float* GCL = (float*)(F.ws + WS_GCL); float* BETAL = (float*)(F.ws + WS_BETAL);
    const float* conv_w = a.in[7];
    LAS float* CW = (LAS float*)(F.lds + P3_CW); LAS float* SC = (LAS float*)(F.lds + P3_SC);
    LAS float* LFp = (LAS float*)(F.lds + P3_LF); LAS float* LBp = (LAS float*)(F.lds + P3_LB); LAS float* TFp = (LAS float*)(F.lds + P3_TF); LAS float* TBp = (LAS float*)(F.lds + P3_TB);
    const int hh = F.lane >> 5;
    static_assert(P3_RAW + 68 * 768 <= LDSCTL_OFF, "P3 LDS map");
    const bf16* zsrc = (const bf16*)(F.ws + WS_CTL + 900 * 1024);
    auto stage_raw = [&](int un) { const int tc_ = un & 63, h_ = (un >> 6) & 3, b_ = un >> 8, t0_ = tc_ * 64;
        for (int p = F.wave; p < 51; p += 8) { const int c = 64 * p + F.lane, row = c / 48, cc = c - 48 * row, tt = t0_ - 2 + row;
            const bf16* src = (tt >= 0 && tt < SEQ) ? PROJ + ((size_t)b_ * SEQ + tt) * PC + C_DQ + (cc >> 4) * 512 + h_ * 128 + (cc & 15) * 8 : zsrc;
            __builtin_amdgcn_global_load_lds((const unsigned*)src, (LAS unsigned*)(F.lds + P3_RAW + p * 1024), 16, 0, 0); } };
    const int unit0 = F.vcu * 16, unit_end = (unit0 + 16 < BATCH * DH * 64) ? unit0 + 16 : BATCH * DH * 64;
    if (unit0 >= unit_end) return;
    { const int h = (unit0 >> 6) & 3;
      for (int i = F.tid; i < 3 * 5 * 128; i += NTHR) { const int part = i / 640, tap = (i / 128) % 5, ch = i & 127; CW[i] = conv_w[tap * 1536 + part * 512 + h * 128 + ch]; } }
    stage_raw(unit0);
    float* GCR = (float*)(F.ws + WS_GCR); float* EDLp = (float*)(F.ws + WS_EDL);
    { float pa[4], pb[4];
#pragma unroll
      for (int q4 = 0; q4 < 4; ++q4) { const int q = F.wave + 8 * q4, un = unit0 + (q >> 1), dir = q & 1, tl = dir ? 63 - F.lane : F.lane; pa[q4] = 0.f; pb[q4] = 0.f;
          if (un < unit_end) { const float* dp = DABp + ((size_t)(un >> 8) * SEQ + (un & 63) * 64 + tl) * 16 + dir * 4 + ((un >> 6) & 3); pa[q4] = dp[0]; pb[q4] = dp[8]; } }
#pragma unroll
      for (int q4 = 0; q4 < 4; ++q4) { const int q = F.wave + 8 * q4, un = unit0 + (q >> 1), dir = q & 1, h_ = (un >> 6) & 3, b_ = un >> 8, t0_ = (un & 63) * 64; const size_t go = (((size_t)dir * BATCH + b_) * DH + h_) * SEQ + t0_ + F.lane;
          float gv = -__expf(a_log[dir * 4 + h_]) * softplus_f(pa[q4] + dt_bias[dir * 4 + h_]); const float bv = sigmoid_f(pb[q4]);
#pragma unroll
          for (int o = 1; o < 64; o <<= 1) { const float t = __shfl_up(gv, o); if (F.lane >= o) gv += t; }
          const float glv = __builtin_bit_cast(float, __builtin_amdgcn_readlane(__builtin_bit_cast(int, gv), 63));
          if (un < unit_end) { GCR[go] = gv; GCL[go] = __expf(gv); EDLp[go] = __expf(glv - gv); BETAL[go] = bv; } }
      VM_WAIT(); __syncthreads(); }
    for (int unit = unit0; unit < unit_end; ++unit) {
        const int tc = unit & 63, h = (unit >> 6) & 3, b = unit >> 8, t0 = tc * 64; const size_t tokb = (size_t)b * SEQ + t0;
        if (unit == unit0) VM_WAIT(); else asm volatile("s_waitcnt vmcnt(10)" ::: "memory");
        LDS_BAR();
        if (F.wave == 2) { const size_t gf = (((size_t)b) * DH + h) * SEQ + t0 + F.lane, gb = (((size_t)BATCH + b) * DH + h) * SEQ + t0 + F.lane;
            __builtin_amdgcn_global_load_lds((const unsigned*)(GCR + gf), (LAS unsigned*)(F.lds + P3_SC), 4, 0, 0); __builtin_amdgcn_global_load_lds((const unsigned*)(GCR + gb), (LAS unsigned*)(F.lds + P3_SC + 256), 4, 0, 0);
            __builtin_amdgcn_global_load_lds((const unsigned*)(BETAL + gf), (LAS unsigned*)(F.lds + P3_SC + 512), 4, 0, 0); __builtin_amdgcn_global_load_lds((const unsigned*)(BETAL + gb), (LAS unsigned*)(F.lds + P3_SC + 768), 4, 0, 0);
            asm volatile("" ::: "memory"); }
        { const int tl2 = F.lane >> 4, cg = F.lane & 15, tk = 8 * F.wave + 2 * tl2;
#ifndef P3_REP_CONV
#define P3_REP_CONV 1
#endif
          u32x4 rawall[3][6];
#pragma unroll
          for (int part = 0; part < 3; ++part)
#pragma unroll
              for (int rr = 0; rr < 6; ++rr) rawall[part][rr] = *(const LAS u32x4*)(F.lds + P3_RAW + (tk + rr) * 768 + part * 256 + cg * 16);
          LDS_BAR();
          if (unit + 1 < unit_end) stage_raw(unit + 1);
          asm volatile("" ::: "memory");
#pragma unroll
          for (int part = 0; part < 3; ++part) {
              u32x4 rawp[6];
#pragma unroll
              for (int rr = 0; rr < 6; ++rr) rawp[rr] = rawall[part][rr];
              float o[2][8];
#pragma unroll
              for (int e2 = 0; e2 < 4; ++e2) {
                  float lo[6], hi[6];
#pragma unroll
                  for (int rr = 0; rr < 6; ++rr) { lo[rr] = __builtin_bit_cast(float, rawp[rr][e2] << 16); hi[rr] = __builtin_bit_cast(float, rawp[rr][e2] & 0xffff0000u); }
                  float a0 = 0.f, a1 = 0.f, b0 = 0.f, b1 = 0.f;
#pragma unroll
                  for (int tap = 0; tap < 5; ++tap) { const f32x2_t w01 = *(const LAS f32x2_t*)(CW + (part * 5 + tap) * 128 + 8 * cg + 2 * e2); const float w0 = w01[0], w1 = w01[1];
                      a0 += lo[tap] * w0; a1 += hi[tap] * w1; b0 += lo[tap + 1] * w0; b1 += hi[tap + 1] * w1; }
                  o[0][2 * e2] = a0; o[0][2 * e2 + 1] = a1; o[1][2 * e2] = b0; o[1][2 * e2 + 1] = b1;
                  __builtin_amdgcn_sched_barrier(0); }
#pragma unroll
              for (int u = 0; u < 2; ++u) { float ss = 0.f;
#pragma unroll
                  for (int e = 0; e < 8; ++e) { const float x = o[u][e]; const float y = x * __builtin_amdgcn_rcpf(1.f + __expf(-x)); o[u][e] = y; ss += y * y; }
                  if (part < 2) { ss = row16_sum(ss);
                      const float sc = rsqrtf(ss + EPS) * (part == 0 ? 0.08838834764831845f : 1.f);
#pragma unroll
                      for (int e = 0; e < 8; ++e) o[u][e] *= sc; }
                  u32x4 w; w.x = cvt_pk_bf16(o[u][0], o[u][1]); w.y = cvt_pk_bf16(o[u][2], o[u][3]); w.z = cvt_pk_bf16(o[u][4], o[u][5]); w.w = cvt_pk_bf16(o[u][6], o[u][7]);
                  *(u32x4*)(QKVN + ((size_t)((b * 4 + h) * 3 + part) * SEQ + t0 + tk + u) * 128 + 8 * cg) = w;
                  if (part < 2) *(LAS u32x4*)(F.lds + (part == 0 ? P3_QN : P3_KN) + off_b(tk + u, cg)) = w; }
              __builtin_amdgcn_sched_barrier(0);
          } }
        LDS_BAR();
        { const int mat = F.wave >> 2, ti = (F.wave >> 1) & 1, tj = F.wave & 1;
          f32x16 acc;
#pragma unroll
          for (int e = 0; e < 16; ++e) acc[e] = 0.f;
#pragma unroll
          for (int s8 = 0; s8 < 8; ++s8) { const bf16x8 af = *(const LAS bf16x8*)(F.lds + (mat ? P3_QN : P3_KN) + rowread_b(F.lane, 32 * ti, s8)), bfr = *(const LAS bf16x8*)(F.lds + P3_KN + rowread_b(F.lane, 32 * tj, s8));
              acc = __builtin_amdgcn_mfma_f32_32x32x16_bf16(af, bfr, acc, 0, 0, 0); }
          LAS float* dstp = (mat ? TBp : TFp) + 32 * tj + (F.lane & 31);
#pragma unroll
          for (int e = 0; e < 16; ++e) dstp[(32 * ti + (e & 3) + 8 * (e >> 2) + 4 * hh) * LST] = acc[e]; }
        if (F.wave == 2) { if (unit + 1 < unit_end) asm volatile("s_waitcnt vmcnt(13)" ::: "memory"); else asm volatile("s_waitcnt vmcnt(6)" ::: "memory"); }
        LDS_BAR();
        { const int i = F.tid >> 3, c8 = F.tid & 7, ir = 63 - i;
          const float gfi = SC[i], gbi = SC[64 + ir], bfi = SC[128 + i], bbi = SC[192 + ir];
          const f32x4 g0 = *(const LAS f32x4*)(TFp + i * LST + 8 * c8), g1 = *(const LAS f32x4*)(TFp + i * LST + 8 * c8 + 4), p0 = *(const LAS f32x4*)(TBp + i * LST + 8 * c8), p1 = *(const LAS f32x4*)(TBp + i * LST + 8 * c8 + 4);
          const f32x4 cf0 = *(const LAS f32x4*)(SC + 8 * c8), cf1 = *(const LAS f32x4*)(SC + 8 * c8 + 4), cb0 = *(const LAS f32x4*)(SC + 120 - 8 * c8), cb1 = *(const LAS f32x4*)(SC + 124 - 8 * c8);
          float lf[8], lb[8], qf[8], qb[8];
#pragma unroll
          for (int e = 0; e < 8; ++e) { const int j = 8 * c8 + e; const float gv = e < 4 ? g0[e] : g1[e - 4], pv = e < 4 ? p0[e] : p1[e - 4];
              const float df = __expf(gfi - (e < 4 ? cf0[e] : cf1[e - 4])), db = __expf(gbi - (e < 4 ? cb1[3 - e] : cb0[7 - e]));
              lf[e] = i > j ? bfi * gv * df : 0.f; lb[7 - e] = i < j ? bbi * gv * db : 0.f; qf[e] = i >= j ? pv * df : 0.f; qb[7 - e] = i <= j ? pv * db : 0.f; }
          *(LAS f32x4*)(LFp + i * LST + 8 * c8) = (f32x4){lf[0], lf[1], lf[2], lf[3]}; *(LAS f32x4*)(LFp + i * LST + 8 * c8 + 4) = (f32x4){lf[4], lf[5], lf[6], lf[7]};
          *(LAS f32x4*)(LBp + ir * LST + 56 - 8 * c8) = (f32x4){lb[0], lb[1], lb[2], lb[3]}; *(LAS f32x4*)(LBp + ir * LST + 60 - 8 * c8) = (f32x4){lb[4], lb[5], lb[6], lb[7]};
          u32x4 wf, wb; wf.x = cvt_pk_bf16(qf[0], qf[1]); wf.y = cvt_pk_bf16(qf[2], qf[3]); wf.z = cvt_pk_bf16(qf[4], qf[5]); wf.w = cvt_pk_bf16(qf[6], qf[7]);
          wb.x = cvt_pk_bf16(qb[0], qb[1]); wb.y = cvt_pk_bf16(qb[2], qb[3]); wb.z = cvt_pk_bf16(qb[4], qb[5]); wb.w = cvt_pk_bf16(qb[6], qb[7]);
          *(u32x4*)(TQK + ((size_t)unit * 4 + 1) * 4096 + i * 64 + 8 * c8) = wf; *(u32x4*)(TQK + ((size_t)unit * 4 + 3) * 4096 + ir * 64 + 56 - 8 * c8) = wb; }
        LDS_BAR();
#ifndef P3_REP_INV
#define P3_REP_INV 1
#endif
        for (int rep = 0; rep < P3_REP_INV; ++rep) if (F.wave < 2) dn_inverse(F.wave ? LBp : LFp, F.wave ? TBp : TFp, F.lane);
        LDS_BAR();
        for (int it = F.tid; it < 1024; it += NTHR) { const int m = it >> 9, i = (it >> 3) & 63, c8 = it & 7; const LAS float* tp = (m ? TBp : TFp) + i * LST + 8 * c8;
            const f32x4 x0 = *(const LAS f32x4*)tp, x1 = *(const LAS f32x4*)(tp + 4);
            u32x4 w; w.x = cvt_pk_bf16(x0[0], x0[1]); w.y = cvt_pk_bf16(x0[2], x0[3]); w.z = cvt_pk_bf16(x1[0], x1[1]); w.w = cvt_pk_bf16(x1[2], x1[3]);
            *(u32x4*)(TQK + ((size_t)unit * 4 + 2 * m) * 4096 + i * 64 + 8 * c8) = w;
            }
    }
}
constexpr int P4_BUF = 57344, P4_KN = 0, P4_QN = 16384, P4_VN = 32768, P4_T = 40960, P4_QK = 49152, P4_ST = 114688, P4_RT = 131072, P4_VNT = 139264, P4_VDT = 147456, P4_SC = 155648;
__device__ __forceinline__ unsigned off_s(unsigned row, unsigned ch) { return 128u * row + (((ch ^ ((row >> 1) & 7u))) << 4); }
__device__ __forceinline__ unsigned rowread_s(unsigned lane, unsigned rowbase, unsigned s) { return off_s(rowbase + (lane & 31), 2 * s + (lane >> 5)); }
__device__ __forceinline__ void p4_stage(const Frame& F, const bf16* QKVN, const bf16* TQK, const float* GCL, const float* BETAL, int b, int h, int dir, int dvh, int n, int buf) {
    const int tc = dir ? 63 - n : n, t0 = tc * 64; const size_t tokb = (size_t)t0, pl0 = (size_t)((b * 4 + h) * 3) * SEQ; const size_t u3 = (size_t)((b * 4 + h) * 64 + tc);
    LAS unsigned char* B = F.lds + buf * P4_BUF; const int L = F.lane, w = F.wave;
    {
#pragma unroll
      for (int k = 0; k < 2; ++k) { const int q = w + 8 * k, row = 4 * q + (L >> 4), pos = L & 15, ch = pos ^ (((row & 3) << 2) | ((row >> 2) & 3)); const size_t tok = tokb + (dir ? 63 - row : row);
          __builtin_amdgcn_global_load_lds((const unsigned*)(QKVN + (pl0 + SEQ + tok) * 128 + ch * 8), (LAS unsigned*)(B + P4_KN + q * 1024), 16, 0, 0);
          __builtin_amdgcn_global_load_lds((const unsigned*)(QKVN + (pl0 + tok) * 128 + ch * 8), (LAS unsigned*)(B + P4_QN + q * 1024), 16, 0, 0); } }
    { const int row = 8 * w + (L >> 3), pos = L & 7, chs = pos ^ ((row >> 1) & 7); const size_t tok = tokb + (dir ? 63 - row : row);
      __builtin_amdgcn_global_load_lds((const unsigned*)(QKVN + (pl0 + 2 * SEQ + tok) * 128 + dvh * 64 + pos * 8), (LAS unsigned*)(B + P4_VN + w * 1024), 16, 0, 0);
      __builtin_amdgcn_global_load_lds((const unsigned*)(TQK + (u3 * 4 + 2 * dir) * 4096 + row * 64 + chs * 8), (LAS unsigned*)(B + P4_T + w * 1024), 16, 0, 0);
      __builtin_amdgcn_global_load_lds((const unsigned*)(TQK + (u3 * 4 + 2 * dir + 1) * 4096 + row * 64 + chs * 8), (LAS unsigned*)(B + P4_QK + w * 1024), 16, 0, 0); }
    if (w == 0) { const size_t go = (((size_t)dir * BATCH + b) * DH + h) * SEQ + t0; LAS unsigned char* sc = F.lds + P4_SC + buf * 1024;
        __builtin_amdgcn_global_load_lds((const unsigned*)(GCL + go + L), (LAS unsigned*)sc, 4, 0, 0); __builtin_amdgcn_global_load_lds((const unsigned*)(BETAL + go + L), (LAS unsigned*)(sc + 256), 4, 0, 0);
        __builtin_amdgcn_global_load_lds((const unsigned*)((const float*)(F.ws + WS_EDL) + go + L), (LAS unsigned*)(sc + 512), 4, 0, 0); }
}
__device__ __forceinline__ void phase_dnscan(const Frame& F, const Args& a) {
    const bf16* QKVN = (const bf16*)a.out; const bf16* TQK = (const bf16*)(F.ws + WS_TQK); const float* GCL = (const float*)(F.ws + WS_GCL); const float* BETAL = (const float*)(F.ws + WS_BETAL);
    bf16* O = (bf16*)(F.ws + WS_A);
    const int w = F.wave, L = F.lane, hh = L >> 5, l31 = L & 31;
    const int mat = w >> 2, ti = (w >> 1) & 1, tj = w & 1, kt = w >> 1, nt = w & 1;
    for (int unit = F.vcu; unit < BATCH * DH * 4; unit += F.G) {
        const int dvh = unit & 1, dir = (unit >> 1) & 1, h = (unit >> 2) & 3, b = unit >> 4;
        __syncthreads();
        for (int i = F.tid; i < 16384 / 16; i += NTHR) ((LAS u32x4*)(F.lds + P4_ST))[i] = (u32x4){0u, 0u, 0u, 0u};
        p4_stage(F, QKVN, TQK, GCL, BETAL, b, h, dir, dvh, 0, 0);
        f32x16 sacc;
#pragma unroll
        for (int e = 0; e < 16; ++e) sacc[e] = 0.f;
        VM_WAIT(); __syncthreads();
        f32x16 accO; bf16x8 oqk[4], ovn[4];
#pragma unroll
        for (int e = 0; e < 16; ++e) accO[e] = 0.f;
#pragma unroll
        for (int s4 = 0; s4 < 4; ++s4) { oqk[s4] = (bf16x8){0, 0, 0, 0, 0, 0, 0, 0}; ovn[s4] = (bf16x8){0, 0, 0, 0, 0, 0, 0, 0}; }
        auto finish_o = [&](int nprev) {
#pragma unroll
            for (int s4 = 0; s4 < 4; ++s4) accO = __builtin_amdgcn_mfma_f32_32x32x16_bf16(oqk[s4], ovn[s4], accO, 0, 0, 0);
            unsigned dwv = DW, i0v = 32 * ti + 4 * hh; asm volatile("" : "+v"(dwv), "+v"(i0v));
            const int tc = dir ? 63 - nprev : nprev; bf16* op = O + ((size_t)dir * NT + (size_t)b * SEQ + tc * 64) * DW + h * 128 + dvh * 64 + 32 * tj + l31;
#pragma unroll
            for (int e = 0; e < 16; ++e) { const int i = (int)i0v + (e & 3) + 8 * (e >> 2); op[(unsigned)(dir ? 63 - i : i) * dwv] = f2bf(accO[e]); } };
        for (int n = 0; n < 64; ++n) {
            const int cb = n & 1; const LAS unsigned char* B = F.lds + cb * P4_BUF; const LAS float* sc = (const LAS float*)(F.lds + P4_SC + cb * 1024);
            if (n + 1 < 64) p4_stage(F, QKVN, TQK, GCL, BETAL, b, h, dir, dvh, n + 1, cb ^ 1);
            f32x16 acc1;
#pragma unroll
            for (int e = 0; e < 16; ++e) acc1[e] = 0.f;
#pragma unroll
            for (int hb = 0; hb < 2; ++hb) { bf16x8 fa[4], fb[4];
#pragma unroll
              for (int s4 = 0; s4 < 4; ++s4) { const int s8 = 4 * hb + s4; fa[s4] = *(const LAS bf16x8*)(B + (mat ? P4_QN : P4_KN) + rowread_b(L, 32 * ti, s8)); fb[s4] = *(const LAS bf16x8*)(F.lds + P4_ST + rowread_b(L, 32 * tj, s8)); }
              __builtin_amdgcn_sched_barrier(0);
#pragma unroll
              for (int s4 = 0; s4 < 4; ++s4) acc1 = __builtin_amdgcn_mfma_f32_32x32x16_bf16(fa[s4], fb[s4], acc1, 0, 0, 0);
              __builtin_amdgcn_sched_barrier(0); }
            const int ncol = 32 * tj + l31;
            if (mat == 0) {
                bf16 vraw[16];
#pragma unroll
                for (int e = 0; e < 16; ++e) vraw[e] = *(const LAS bf16*)(B + P4_VN + (32 * ti + 8 * (e >> 2) + 4 * hh + (e & 3)) * 128 + ncol * 2);
                __builtin_amdgcn_sched_barrier(0);
#pragma unroll
                for (int rg = 0; rg < 4; ++rg) { float r4[4];
#pragma unroll
                    for (int q = 0; q < 4; ++q) { const int i = 32 * ti + 8 * rg + 4 * hh + q; const float vv = bf2f(vraw[4 * rg + q]);
                        r4[q] = sc[64 + i] * (vv - sc[i] * acc1[4 * rg + q]); }
                    *(LAS unsigned long long*)(F.lds + P4_RT + off_s(ncol, 4 * ti + rg) + 8 * hh) = (unsigned long long)cvt_pk_bf16(r4[0], r4[1]) | ((unsigned long long)cvt_pk_bf16(r4[2], r4[3]) << 32); }
            } else {
#pragma unroll
                for (int e = 0; e < 16; ++e) { const int i = 32 * ti + (e & 3) + 8 * (e >> 2) + 4 * hh; acc1[e] *= sc[i]; }
            }
            LDS_BAR();
            if (mat == 0) {
                f32x16 va;
#pragma unroll
                for (int e = 0; e < 16; ++e) va[e] = 0.f;
                { bf16x8 fa[4], fb[4];
#pragma unroll
                  for (int s4 = 0; s4 < 4; ++s4) { fa[s4] = *(const LAS bf16x8*)(B + P4_T + rowread_s(L, 32 * ti, s4)); fb[s4] = *(const LAS bf16x8*)(F.lds + P4_RT + rowread_s(L, 32 * tj, s4)); }
                  __builtin_amdgcn_sched_barrier(0);
#pragma unroll
                  for (int s4 = 0; s4 < 4; ++s4) va = __builtin_amdgcn_mfma_f32_32x32x16_bf16(fa[s4], fb[s4], va, 0, 0, 0); }
#pragma unroll
                for (int rg = 0; rg < 4; ++rg) { float d4[4];
#pragma unroll
                    for (int q = 0; q < 4; ++q) d4[q] = va[4 * rg + q] * sc[128 + 32 * ti + 8 * rg + 4 * hh + q];
                    const unsigned o8 = off_s(ncol, 4 * ti + rg) + 8 * hh;
                    *(LAS unsigned long long*)(F.lds + P4_VNT + o8) = (unsigned long long)cvt_pk_bf16(va[4 * rg], va[4 * rg + 1]) | ((unsigned long long)cvt_pk_bf16(va[4 * rg + 2], va[4 * rg + 3]) << 32);
                    *(LAS unsigned long long*)(F.lds + P4_VDT + o8) = (unsigned long long)cvt_pk_bf16(d4[0], d4[1]) | ((unsigned long long)cvt_pk_bf16(d4[2], d4[3]) << 32); }
            } else if (n > 0) finish_o(n - 1);
            LDS_BAR();
            if (mat == 1) {
#pragma unroll
                for (int s4 = 0; s4 < 4; ++s4) { oqk[s4] = *(const LAS bf16x8*)(B + P4_QK + rowread_s(L, 32 * ti, s4)); ovn[s4] = *(const LAS bf16x8*)(F.lds + P4_VNT + rowread_s(L, 32 * tj, s4)); }
                accO = acc1;
            }
            { const float egl = sc[63];
#pragma unroll
              for (int e = 0; e < 16; ++e) sacc[e] *= egl;
              const unsigned blk = (L >> 4) & 1, q4 = (L & 15) >> 2, p4 = L & 3;
              bf16x8 fv[4];
#pragma unroll
              for (int s4 = 0; s4 < 4; ++s4) fv[s4] = *(const LAS bf16x8*)(F.lds + P4_VDT + rowread_s(L, 32 * nt, s4));
              v4i16_t tv[8];
              { const unsigned kb = (unsigned)(size_t)(B + P4_KN), a0 = kb + off_b(8 * hh + q4, 4 * kt + 2 * blk + (p4 >> 1)) + 8 * (p4 & 1), a1 = kb + off_b(8 * hh + 4 + q4, 4 * kt + 2 * blk + (p4 >> 1)) + 8 * (p4 & 1);
                asm volatile("ds_read_b64_tr_b16 %0, %8\n\tds_read_b64_tr_b16 %1, %9\n\tds_read_b64_tr_b16 %2, %8 offset:4096\n\tds_read_b64_tr_b16 %3, %9 offset:4096\n\t"
                             "ds_read_b64_tr_b16 %4, %8 offset:8192\n\tds_read_b64_tr_b16 %5, %9 offset:8192\n\tds_read_b64_tr_b16 %6, %8 offset:12288\n\tds_read_b64_tr_b16 %7, %9 offset:12288\n\ts_waitcnt lgkmcnt(0)"
                             : "=&v"(tv[0]), "=&v"(tv[1]), "=&v"(tv[2]), "=&v"(tv[3]), "=&v"(tv[4]), "=&v"(tv[5]), "=&v"(tv[6]), "=&v"(tv[7]) : "v"(a0), "v"(a1) : "memory"); }
#pragma unroll
              for (int s4 = 0; s4 < 4; ++s4) { const v4i16_t t0v = tv[2 * s4], t1v = tv[2 * s4 + 1];
                  bf16x8 af; af[0] = t0v[0]; af[1] = t0v[1]; af[2] = t0v[2]; af[3] = t0v[3]; af[4] = t1v[0]; af[5] = t1v[1]; af[6] = t1v[2]; af[7] = t1v[3];
                  sacc = __builtin_amdgcn_mfma_f32_32x32x16_bf16(af, fv[s4], sacc, 0, 0, 0); }
              const int nn = 32 * nt + l31;
#pragma unroll
              for (int rg = 0; rg < 4; ++rg)
                  *(LAS unsigned long long*)(F.lds + P4_ST + off_b(nn, 4 * kt + rg) + 8 * hh) = (unsigned long long)cvt_pk_bf16(sacc[4 * rg], sacc[4 * rg + 1]) | ((unsigned long long)cvt_pk_bf16(sacc[4 * rg + 2], sacc[4 * rg + 3]) << 32);
            }
            if (mat == 1 && n > 0) asm volatile("s_waitcnt vmcnt(16)" ::: "memory"); else VM_WAIT();
            LDS_BAR();
        }
        if (mat == 1) finish_o(63);
        VM_WAIT();
    }
}
__device__ __forceinline__ void phase_post(const Frame& F, const Args& a) {
    bf16* MIX = (bf16*)(F.ws + WS_MIX); const bf16* O = (const bf16*)(F.ws + WS_A); const bf16* PROJ = (const bf16*)(F.ws + WS_PROJ); const float* ag = a.in[6]; const float* dg = a.in[10];
    const int gw = F.vcu * NWAVES + F.wave, NGW = F.G * NWAVES, lane = F.lane;
    const f32x4 g0 = *(const f32x4*)(ag + lane * 8), g1 = *(const f32x4*)(ag + lane * 8 + 4);
    const f32x4 d0 = *(const f32x4*)(dg + (lane & 15) * 8), d1 = *(const f32x4*)(dg + (lane & 15) * 8 + 4);
    u32x4 nav, nof, nob, nzv;
    if (gw < NT) { nav = *(const u32x4*)(MIX + (size_t)gw * DM + lane * 8); nof = *(const u32x4*)(O + (size_t)gw * DW + lane * 8); nob = *(const u32x4*)(O + ((size_t)NT + gw) * DW + lane * 8); nzv = *(const u32x4*)(PROJ + (size_t)gw * PC + C_DZ + lane * 8); }
    for (int tok = gw; tok < NT; tok += NGW) {
        bf16* mp = MIX + (size_t)tok * DM;
        const u32x4 av = nav, of = nof, ob = nob, zv = nzv;
        { const int tn = tok + NGW < NT ? tok + NGW : tok;
          nav = *(const u32x4*)(MIX + (size_t)tn * DM + lane * 8); nof = *(const u32x4*)(O + (size_t)tn * DW + lane * 8); nob = *(const u32x4*)(O + ((size_t)NT + tn) * DW + lane * 8); nzv = *(const u32x4*)(PROJ + (size_t)tn * PC + C_DZ + lane * 8); }
        float x[8]; float ss = 0.f;
#pragma unroll
        for (int e = 0; e < 4; ++e) { x[2 * e] = __builtin_bit_cast(float, av[e] << 16); x[2 * e + 1] = __builtin_bit_cast(float, av[e] & 0xffff0000u); ss += x[2 * e] * x[2 * e] + x[2 * e + 1] * x[2 * e + 1]; }
        const float rstd = rsqrtf(wave_sum(ss) * (1.f / 512) + EPS);
        u32x4 w; w.x = cvt_pk_bf16(x[0] * rstd * g0[0], x[1] * rstd * g0[1]); w.y = cvt_pk_bf16(x[2] * rstd * g0[2], x[3] * rstd * g0[3]); w.z = cvt_pk_bf16(x[4] * rstd * g1[0], x[5] * rstd * g1[1]); w.w = cvt_pk_bf16(x[6] * rstd * g1[2], x[7] * rstd * g1[3]);
        *(u32x4*)(mp + lane * 8) = w;
        float o[8], z[8]; float s2 = 0.f;
#pragma unroll
        for (int e = 0; e < 4; ++e) { o[2 * e] = __builtin_bit_cast(float, of[e] << 16) + __builtin_bit_cast(float, ob[e] << 16); o[2 * e + 1] = __builtin_bit_cast(float, of[e] & 0xffff0000u) + __builtin_bit_cast(float, ob[e] & 0xffff0000u);
            z[2 * e] = __builtin_bit_cast(float, zv[e] << 16); z[2 * e + 1] = __builtin_bit_cast(float, zv[e] & 0xffff0000u); s2 += o[2 * e] * o[2 * e] + o[2 * e + 1] * o[2 * e + 1]; }
        s2 = row16_sum(s2);
        const float r2 = rsqrtf(s2 * (1.f / 128) + EPS);
        float y[8];
#pragma unroll
        for (int e = 0; e < 8; ++e) y[e] = o[e] * r2 * (e < 4 ? d0[e] : d1[e - 4]) * z[e] * __builtin_amdgcn_rcpf(1.f + __expf(-z[e]));
        u32x4 w2; w2.x = cvt_pk_bf16(y[0], y[1]); w2.y = cvt_pk_bf16(y[2], y[3]); w2.z = cvt_pk_bf16(y[4], y[5]); w2.w = cvt_pk_bf16(y[6], y[7]);
        *(u32x4*)(mp + 512 + lane * 8) = w2;
    }
}

__global__ void __launch_bounds__(NTHR, 2) fwd(Args args) {
    extern __shared__ __attribute__((aligned(16))) unsigned char lds_raw[];
    Frame F; F.lds = (LAS unsigned char*)lds_raw; F.tid = threadIdx.x; F.lane = F.tid & 63; F.wave = __builtin_amdgcn_readfirstlane(F.tid >> 6);
    F.G = gridDim.x; { const int bx = blockIdx.x; F.vcu = (F.G % 8 == 0) ? (bx % 8) * (F.G / 8) + bx / 8 : bx; } F.ws = args.ws;
    gu32* ctl = (gu32*)(F.ws + WS_CTL);
    for (int u = F.tid; u < 128; u += NTHR) ((LAS unsigned*)(F.lds + LDSCTL_OFF))[u] = 0u;
    __syncthreads();
    const int lo = args.ph_lo, hi = args.ph_hi;
    XcdBarrier bar; bar.bar = (unsigned*)ctl + CW_BAR; bar.x = 0; bar.st = nullptr;
    if (hi - lo > 1) bar = xcd_barrier_post((unsigned*)ctl + CW_BAR, (volatile LAS unsigned*)(F.lds + MISC_OFF));
#ifndef PH_MASK
#define PH_MASK 0xffff
#endif
#define IN(k) (((PH_MASK >> (k)) & 1) && lo <= (k) && (k) < hi)
#define SEAM(k) do { if (IN(k) && IN((k) + 1)) xcd_barrier(bar); } while (0)
#ifndef ALIGN1
#define ALIGN1 false
#endif
#ifndef ALIGN6
#define ALIGN6 true
#endif
#ifndef ALIGN8
#define ALIGN8 true
#endif
#ifndef ALIGN9
#define ALIGN9 true
#endif
#ifndef DBL_MASK
#define DBL_MASK 0
#endif
#define DBL(k) (((DBL_MASK >> (k)) & 1) != 0)
    bf16* XN = (bf16*)(F.ws + WS_A); bf16* X2B = (bf16*)(F.ws + WS_A); bf16* PROJ = (bf16*)(F.ws + WS_PROJ); bf16* MIX = (bf16*)(F.ws + WS_MIX);
    bf16* HID = (bf16*)(F.ws + WS_HID); bf16* Y = (bf16*)(F.ws + WS_Y); float* SSQ2 = (float*)(F.ws + WS_SSQ2);
    if (IN(0)) { phase0(F, args); if (DBL(0)) { xcd_barrier(bar); phase0(F, args); } } SEAM(0);
    if (IN(1)) {
        LAS float* gains = (LAS float*)(F.lds + TAB_OFF);
        if (F.tid < 64) gains[F.tid] = args.in[3][F.tid] * (0.125f * LOG2E); else if (F.tid < 128) gains[F.tid] = args.in[4][F.tid - 64];
        __syncthreads();
        pg8::Gemm g{XN, (const bf16*)(F.ws + WS_WIN), DM, 0, DM, 0}; pg8::StaticOrder S; S.init(NT, PC + 256, F.G, (int)blockIdx.x);
        pg8::gemm_phase<EpiInProjF, pg8::StaticOrder, pg8::DenseA, ALIGN1>(F.lds, g, S, pg8::DenseA{DM}, EpiInProjF{PROJ, gains, (float*)(F.ws + WS_DAB)});
    } SEAM(1);
    if (IN(2)) { phase_na(F, args); if (DBL(2)) { xcd_barrier(bar); phase_na(F, args); } }
    __syncthreads();
    if (IN(3)) { phase_dnprep(F, args); if (DBL(3)) { xcd_barrier(bar); phase_dnprep(F, args); } } SEAM(3);
    if (IN(4)) { phase_dnscan(F, args); if (DBL(4)) { xcd_barrier(bar); phase_dnscan(F, args); } } SEAM(4);
    if (IN(5)) { phase_post(F, args); } SEAM(5);
    if (IN(6)) {
        pg8::Gemm g{MIX, (const bf16*)(F.ws + WS_WO), DM, 0, DM, 0}; pg8::StaticOrder S; S.init(NT, DM, F.G, (int)blockIdx.x);
        pg8::gemm_phase<EpiOutF, pg8::StaticOrder, pg8::DenseA, ALIGN6>(F.lds, g, S, pg8::DenseA{DM}, EpiOutF{args.in[0], args.out, X2B, SSQ2});
    } SEAM(6);
    if (IN(7)) {
        pg8::Gemm g{X2B, (const bf16*)(F.ws + WS_WR), DM, 0, DM, 0}; pg8::StaticOrder S; S.init(NT, 256, F.G, (int)blockIdx.x);
        EpiRouterF E{SSQ2, args.in[14], args.in[16], (int*)(F.ws + WS_TOKE), (float*)(F.ws + WS_TOKG), (float*)(F.ws + WS_RSTD2), (int*)(F.ws + WS_BIDX), (unsigned*)ctl + CW_CNT};
        pg8::gemm_phase<EpiRouterF, pg8::StaticOrder, pg8::DenseA, false>(F.lds, g, S, pg8::DenseA{DM}, E);
    } SEAM(7);
    if (IN(8)) {
        const int n = moe_setup1(F);
        pg8::Gemm g{X2B, (const bf16*)(F.ws + WS_WGU), DM, (size_t)512 * DM * 2, DM, 0};
        MoeSched S{(const LAS int*)(F.lds + TAB_OFF + TB_UT), n};
        const LAS unsigned* t0 = (const LAS unsigned*)(F.lds + TAB_OFF + TB_T);
        pg8::gemm_phase<EpiMoe1F, MoeSched, pg8::GatherA, ALIGN8>(F.lds, g, S, pg8::GatherA{t0}, EpiMoe1F{HID, (const LAS float*)(t0 + 6 * 256), t0 + 12 * 256, (const LAS float*)(t0 + 18 * 256)});
    } SEAM(8);
    if (IN(9)) {
        const int n = moe_setup2(F);
        pg8::Gemm g{HID, (const bf16*)(F.ws + WS_WD), 2 * DE, (size_t)DM * DE * 2, DE, 4};
        MoeSched S{(const LAS int*)(F.lds + TAB_OFF + TB_UT), n};
        pg8::gemm_phase<EpiMoe2F, MoeSched, pg8::DenseA, ALIGN9>(F.lds, g, S, pg8::DenseA{2 * DE}, EpiMoe2F{X2B, args.out, (const LAS unsigned*)(F.lds + TAB_OFF + TB_T)});
    }
#undef IN
#undef SEAM
}


extern "C" void kernel_launch(void* const* d_in, const int* in_sizes, int n_in, void* d_out, int out_size, void* d_ws, size_t ws_size, hipStream_t stream) {
    static int grid = 0;
    if (grid == 0) {
        if (n_in != 20 || in_sizes[0] != NT * DM || out_size != NT * DM || ws_size < WS_END2) { fprintf(stderr, "kernel_launch: unexpected n_in %d / sizes / ws_size %zu (need %zu)\n", n_in, ws_size, (size_t)WS_END2); grid = -1; return; }
        int dev = 0, cus = 0, per_cu = 0;
        if (hipGetDevice(&dev) != hipSuccess || hipDeviceGetAttribute(&cus, hipDeviceAttributeMultiprocessorCount, dev) != hipSuccess) { grid = -1; return; }
        if (hipFuncSetAttribute((const void*)fwd, hipFuncAttributeMaxDynamicSharedMemorySize, LDS_BYTES) != hipSuccess) { fprintf(stderr, "kernel_launch: hipFuncSetAttribute failed\n"); grid = -1; return; }
        if (hipOccupancyMaxActiveBlocksPerMultiprocessor(&per_cu, (const void*)fwd, NTHR, LDS_BYTES) != hipSuccess || per_cu < 1) fprintf(stderr, "kernel_launch: occupancy query says %d\n", per_cu);
        (void)hipGetLastError();
        grid = cus;
    }
    if (grid < 0) return;
    (void)hipMemsetAsync((unsigned char*)d_ws + WS_CTL, 0, 1 * MiB, stream);
    Args a{}; for (int i = 0; i < 20; ++i) a.in[i] = (const float*)d_in[i]; a.out = (float*)d_out; a.ws = (unsigned char*)d_ws;
#define FWD(lo_, hi_) do { a.ph_lo = (lo_); a.ph_hi = (hi_); hipLaunchKernelGGL(fwd, dim3(grid), dim3(NTHR), LDS_BYTES, stream, a); } while (0)
#if defined(PROBE_EXTRA)
    for (int k = 0; k < 10; ++k) { FWD(k, k + 1); if (k == PROBE_EXTRA) FWD(k, k + 1); }
#else
    FWD(0, 10);
#endif
}
```
